# Optimizing an MI355X kernel written in HIP

```python
import jax
import jax.numpy as jnp
from jax import lax
import numpy as np

D_MODEL = 1024
BATCH = 4
SEQ = 8192
DEPTH = 2

CTX_LEN = 256
GRID_W = 64

POOL_WINDOWS = (2, 4, 8, 16)
POOL_WIDTH = 256
POOL_GROUP = POOL_WIDTH // len(POOL_WINDOWS)
SGU_WIDTH = 256
SGU_GROUPS = 4
SGU_GROUP = SGU_WIDTH // SGU_GROUPS
CHUNK = 128
MLA_HEADS = 8
QK_NOPE = 64
QK_ROPE = 32
V_HEAD = 64
Q_LORA = 384
KV_LORA = 256
MLA_WIDTH = MLA_HEADS * V_HEAD
QK_HEAD = QK_NOPE + QK_ROPE
SM_SCALE = QK_HEAD ** -0.5
Q_BLOCK = 128
ROPE_BASE = 10000.0
ROPE_AXIS = QK_ROPE // 2
ROPE_PAIRS = ROPE_AXIS // 2
N_BRANCH = 3
OFF_U = POOL_WIDTH
OFF_V = OFF_U + SGU_WIDTH
OFF_QA = OFF_V + SGU_WIDTH
OFF_KVA = OFF_QA + Q_LORA
OFF_KR = OFF_KVA + KV_LORA
OFF_GATE = OFF_KR + QK_ROPE
IN_WIDTH = OFF_GATE + N_BRANCH * D_MODEL
N_EXPERTS = 16
N_GROUPS = 4
EXPERTS_PER_GROUP = N_EXPERTS // N_GROUPS
TOP_K = 2
D_EXPERT = 512
EPS = 1e-6

kernel_name = "hybrid_pool_sgu_mla_moe_diffusion_trunk"


def rmsnorm(x, g):
    xf = x.astype(jnp.float32)
    y = xf * lax.rsqrt(jnp.mean(xf * xf, axis=-1, keepdims=True) + EPS)
    return (y * g.astype(jnp.float32)).astype(x.dtype)


def adaln(cond, w_mod, b_mod):
    m = jax.nn.silu(cond) @ w_mod + b_mod
    return [a[:, None, :] for a in jnp.split(m, 6, axis=-1)]


def modulate(h, shift, scale):
    return h * (1 + scale) + shift


def axial_rope_tables(n):
    rows = n // GRID_W
    row = jnp.repeat(jnp.arange(rows, dtype=jnp.float32), GRID_W)
    col = jnp.tile(jnp.arange(GRID_W, dtype=jnp.float32), rows)
    inv = ROPE_BASE ** (-(jnp.arange(ROPE_PAIRS, dtype=jnp.float32) * 2.0 / ROPE_AXIS))
    ang_r = row[:, None] * inv
    ang_c = col[:, None] * inv
    ang = jnp.concatenate([ang_r, ang_r, ang_c, ang_c], axis=-1)
    return jnp.cos(ang), jnp.sin(ang)


def apply_rope(x, cos, sin):
    x4 = x.reshape(x.shape[:-1] + (4, ROPE_PAIRS))
    rot = jnp.stack([-x4[..., 1, :], x4[..., 0, :], -x4[..., 3, :], x4[..., 2, :]], axis=-2).reshape(x.shape)
    return (x.astype(jnp.float32) * cos + rot.astype(jnp.float32) * sin).astype(x.dtype)


def split_proj(proj):
    return jnp.split(proj, [OFF_U, OFF_V, OFF_QA, OFF_KVA, OFF_KR, OFF_GATE], axis=-1)


def pool_mixer(p, pool_w, pool_scale):
    bsz, n, _ = p.shape
    pf = p.astype(jnp.float32)
    cs = jnp.concatenate([jnp.zeros_like(pf[:, :1]), jnp.cumsum(pf, axis=1)], axis=1)
    t = jnp.arange(n)
    outs = []
    for gi, w in enumerate(POOL_WINDOWS):
        lo = jnp.clip(t - w // 2, 0, n)
        hi = jnp.clip(t + (w - w // 2), 0, n)
        csg = cs[..., gi * POOL_GROUP:(gi + 1) * POOL_GROUP]
        cnt = (hi - lo).astype(jnp.float32)[None, :, None]
        mean = (jnp.take(csg, hi, axis=1) - jnp.take(csg, lo, axis=1)) / cnt
        outs.append(mean - pf[..., gi * POOL_GROUP:(gi + 1) * POOL_GROUP])
    d = jnp.stack(outs, axis=2).astype(p.dtype)
    y = jnp.einsum('bngc,gcd->bngd', d, pool_w).reshape(bsz, n, POOL_WIDTH)
    return y * pool_scale


def sgu_mixer(u, v, norm_g, ws, b):
    bsz, n, _ = v.shape
    u = jax.nn.gelu(u)
    v = rmsnorm(jax.nn.gelu(v), norm_g)
    vc = v.reshape(bsz, n // CHUNK, CHUNK, SGU_GROUPS, SGU_GROUP)
    mixed = jnp.einsum('gij,bnjgc->bnigc', ws, vc) + b.T[:, :, None]
    return u * mixed.reshape(bsz, n, SGU_WIDTH)


def mla_q(q_a, lp, rope_tabs):
    bsz, n, _ = q_a.shape
    q = (rmsnorm(q_a, lp['qa_norm_g']) @ lp['w_uq']).reshape(bsz, n, MLA_HEADS, QK_HEAD)
    q_nope = rmsnorm(q[..., :QK_NOPE], lp['q_norm_g'][:QK_NOPE])
    q_rope = rmsnorm(q[..., QK_NOPE:], lp['q_norm_g'][QK_NOPE:])
    if rope_tabs is not None:
        cos, sin = rope_tabs
        q_rope = apply_rope(q_rope, cos[:, None, :], sin[:, None, :])
    return q_nope, q_rope


def mla_kv(kv_a, k_r, lp, rope_tabs):
    bsz, n, _ = kv_a.shape
    kv = (rmsnorm(kv_a, lp['kva_norm_g']) @ lp['w_ukv']).reshape(bsz, n, MLA_HEADS, QK_NOPE + V_HEAD)
    k_nope = rmsnorm(kv[..., :QK_NOPE], lp['k_norm_g'][:QK_NOPE])
    v = kv[..., QK_NOPE:]
    k_rope = rmsnorm(k_r, lp['k_norm_g'][QK_NOPE:])
    if rope_tabs is not None:
        cos, sin = rope_tabs
        k_rope = apply_rope(k_rope, cos, sin)
    return (k_nope, k_rope, v)


def attend(q_nope, q_rope, k_nope, k_rope, v):
    bsz, n, heads, _ = q_nope.shape
    nb = n // Q_BLOCK

    def blocks(a):
        return a.reshape((bsz, nb, Q_BLOCK) + a.shape[2:]).swapaxes(0, 1)

    def one(args):
        qn, qr = args
        s = jnp.einsum('bqhd,bkhd->bhqk', qn, k_nope) + jnp.einsum('bqhr,bkr->bhqk', qr, k_rope)
        p = jax.nn.softmax(s.astype(jnp.float32) * SM_SCALE, axis=-1).astype(v.dtype)
        return jnp.einsum('bhqk,bkhd->bqhd', p, v)

    o = lax.map(one, (blocks(q_nope), blocks(q_rope)))
    return o.swapaxes(0, 1).reshape(bsz, n, heads * V_HEAD)


def hybrid_mixer(p, u, v, q_a, g, keys, lp, rope_tabs):
    y_pool = pool_mixer(p, lp['pool_w'], lp['pool_scale'])
    y_sgu = sgu_mixer(u, v, lp['sgu_norm_g'], lp['sgu_ws'], lp['sgu_b'])
    q_nope, q_rope = mla_q(q_a, lp, rope_tabs)
    y_att = attend(q_nope, q_rope, *keys)
    gp, gs, ga = jnp.split(jax.nn.sigmoid(g + lp['b_gate']), N_BRANCH, axis=-1)
    merged = (gp * (y_pool @ lp['w_br_pool'])
              + gs * (y_sgu @ lp['w_br_sgu'])
              + ga * (y_att @ lp['w_br_mla']))
    return merged @ lp['w_out']


def moe(h, router_w, router_b, w_gate, w_up, w_down):
    shp = h.shape
    t = h.reshape(-1, shp[-1])
    scores = jax.nn.sigmoid((t @ router_w).astype(jnp.float32))
    sel = scores + router_b.astype(jnp.float32)
    grp_score = lax.top_k(sel.reshape(-1, N_GROUPS, EXPERTS_PER_GROUP), 2)[0].sum(-1)
    best = jnp.argmax(grp_score, axis=-1)
    in_grp = (jnp.arange(N_EXPERTS) // EXPERTS_PER_GROUP)[None, :] == best[:, None]
    _, idx = lax.top_k(jnp.where(in_grp, sel, -jnp.inf), TOP_K)
    w = jnp.take_along_axis(scores, idx, axis=-1)
    w = w / jnp.sum(w, axis=-1, keepdims=True)
    gate = jnp.sum(jax.nn.one_hot(idx, N_EXPERTS, dtype=jnp.float32) * w[..., None], axis=-2).astype(t.dtype)
    y = jnp.zeros_like(t)
    for e in range(N_EXPERTS):
        a = jax.nn.silu(t @ w_gate[e]) * (t @ w_up[e])
        y = y + gate[:, e:e + 1] * (a @ w_down[e])
    return y.reshape(shp)


def setup_inputs(seed: int = 0) -> dict:
    key = jax.random.key(seed)
    ks = jax.random.split(key, 32)
    f32 = jnp.float32
    L, D = DEPTH, D_MODEL

    def nrm(k, shape, scale):
        return jax.random.normal(k, shape, f32) * scale

    def gain(k, shape):
        return 1.0 + 0.05 * jax.random.normal(k, shape, f32)

    return {
        "x": nrm(ks[0], (BATCH, SEQ, D), 1.0),
        "c": nrm(ks[1], (BATCH, D), 1.0),
        "ctx": nrm(ks[2], (BATCH, CTX_LEN, D), 1.0),
        "c_ctx": nrm(ks[3], (D,), 1.0),
        "w_mod": nrm(ks[4], (L, D, 6 * D), 0.5 * D ** -0.5),
        "b_mod": nrm(ks[5], (L, 6 * D), 0.02),
        "norm1_g": gain(ks[6], (L, D)),
        "norm2_g": gain(ks[7], (L, D)),
        "w_in": nrm(ks[8], (L, D, IN_WIDTH), D ** -0.5),
        "pool_w": nrm(ks[9], (L, len(POOL_WINDOWS), POOL_GROUP, POOL_GROUP), POOL_GROUP ** -0.5),
        "pool_scale": gain(ks[10], (L, POOL_WIDTH)),
        "sgu_norm_g": gain(ks[11], (L, SGU_WIDTH)),
        "sgu_ws": nrm(ks[12], (L, SGU_GROUPS, CHUNK, CHUNK), CHUNK ** -0.5),
        "sgu_b": gain(ks[13], (L, SGU_GROUPS, CHUNK)),
        "qa_norm_g": gain(ks[14], (L, Q_LORA)),
        "w_uq": nrm(ks[15], (L, Q_LORA, MLA_HEADS * QK_HEAD), Q_LORA ** -0.5),
        "kva_norm_g": gain(ks[16], (L, KV_LORA)),
        "w_ukv": nrm(ks[17], (L, KV_LORA, MLA_HEADS * (QK_NOPE + V_HEAD)), KV_LORA ** -0.5),
        "q_norm_g": gain(ks[18], (L, QK_HEAD)),
        "k_norm_g": gain(ks[19], (L, QK_HEAD)),
        "w_br_pool": nrm(ks[20], (L, POOL_WIDTH, D), POOL_WIDTH ** -0.5),
        "w_br_sgu": nrm(ks[21], (L, SGU_WIDTH, D), SGU_WIDTH ** -0.5),
        "w_br_mla": nrm(ks[22], (L, MLA_WIDTH, D), MLA_WIDTH ** -0.5),
        "b_gate": nrm(ks[23], (L, N_BRANCH * D), 0.02),
        "w_out": nrm(ks[24], (L, D, D), D ** -0.5),
        "router_w": nrm(ks[25], (D, N_EXPERTS), D ** -0.5),
        "router_b": nrm(ks[26], (N_EXPERTS,), 0.01),
        "w_e_gate": nrm(ks[27], (L, N_EXPERTS, D, D_EXPERT), D ** -0.5),
        "w_e_up": nrm(ks[28], (L, N_EXPERTS, D, D_EXPERT), D ** -0.5),
        "w_e_down": nrm(ks[29], (L, N_EXPERTS, D_EXPERT, D), D_EXPERT ** -0.5),
    }


def reference(x, c, ctx, c_ctx, w_mod, b_mod, norm1_g, norm2_g, w_in, pool_w, pool_scale,
              sgu_norm_g, sgu_ws, sgu_b, qa_norm_g, w_uq, kva_norm_g, w_ukv, q_norm_g, k_norm_g,
              w_br_pool, w_br_sgu, w_br_mla, b_gate, w_out, router_w, router_b,
              w_e_gate, w_e_up, w_e_down):
    n_lat = x.shape[1]
    rope_tabs = axial_rope_tables(n_lat)
    x_lat, x_ctx = x, ctx
    for l in range(DEPTH):
        last = l == DEPTH - 1
        lp = dict(w_in=w_in[l], pool_w=pool_w[l], pool_scale=pool_scale[l], sgu_norm_g=sgu_norm_g[l],
                  sgu_ws=sgu_ws[l], sgu_b=sgu_b[l], qa_norm_g=qa_norm_g[l], w_uq=w_uq[l],
                  kva_norm_g=kva_norm_g[l], w_ukv=w_ukv[l], q_norm_g=q_norm_g[l], k_norm_g=k_norm_g[l],
                  w_br_pool=w_br_pool[l], w_br_sgu=w_br_sgu[l], w_br_mla=w_br_mla[l],
                  b_gate=b_gate[l], w_out=w_out[l])
        sh1, sc1, g1, sh2, sc2, g2 = adaln(c, w_mod[l], b_mod[l])
        csh1, csc1, cg1, csh2, csc2, cg2 = adaln(c_ctx[None, :], w_mod[l], b_mod[l])

        hc = modulate(rmsnorm(x_ctx, norm1_g[l]), csh1, csc1)
        if last:
            kv_cols = hc @ lp['w_in'][:, OFF_KVA:OFF_GATE]
            kv_a_c, k_r_c = kv_cols[..., :KV_LORA], kv_cols[..., KV_LORA:]
        else:
            pc, uc, vc, qac, kv_a_c, k_r_c, gc = split_proj(hc @ lp['w_in'])
        ctx_keys = mla_kv(kv_a_c, k_r_c, lp, None)

        h = modulate(rmsnorm(x_lat, norm1_g[l]), sh1, sc1)
        p, u, v, q_a, kv_a, k_r, g = split_proj(h @ lp['w_in'])
        lat_keys = mla_kv(kv_a, k_r, lp, rope_tabs)
        keys = tuple(jnp.concatenate([a, b], axis=1) for a, b in zip(lat_keys, ctx_keys))
        x_lat = x_lat + g1 * hybrid_mixer(p, u, v, q_a, g, keys, lp, rope_tabs)
        h2 = modulate(rmsnorm(x_lat, norm2_g[l]), sh2, sc2)
        x_lat = x_lat + g2 * moe(h2, router_w, router_b, w_e_gate[l], w_e_up[l], w_e_down[l])

        if not last:
            x_ctx = x_ctx + cg1 * hybrid_mixer(pc, uc, vc, qac, gc, ctx_keys, lp, None)
            hc2 = modulate(rmsnorm(x_ctx, norm2_g[l]), csh2, csc2)
            x_ctx = x_ctx + cg2 * moe(hc2, router_w, router_b, w_e_gate[l], w_e_up[l], w_e_down[l])
    return x_lat
```

```cpp
#include <hip/hip_runtime.h>
#include <cstdio>
#include <cstdint>
#ifndef MK_N_LAUNCHES
#define MK_N_LAUNCHES 1
#endif

constexpr int DM = 1024, NB = 4, SEQ = 8192, CTXL = 256, DEPTH = 2;
constexpr int NLAT = NB * SEQ;
constexpr int NCTX = NB * CTXL;
constexpr int MROWS = NLAT + NCTX;
constexpr int NKEY = SEQ + CTXL;
constexpr int NH = 8, QKN = 64, QKR = 32, QKH = 96, VH = 64;
constexpr int QLORA = 384, KVLORA = 256;
constexpr int INW_SRC = 4512, INW = 4608;
constexpr int C_P = 0, C_U = 256, C_V = 512, C_QA = 768, C_KR = 1152, C_PAD = 1184, C_KVA = 1280, C_GATE = 1536, C_ATT = 768;
constexpr int NE = 16, DE = 512;
constexpr float EPS = 1e-6f;
constexpr int MOE_ROWS = 2 * MROWS + 16 * 256;

constexpr size_t MiB = 1u << 20;
constexpr size_t WS_CTL = 0, CTL_ZERO_BYTES = 1 * MiB;
constexpr size_t WS_MOD = 1 * MiB;
constexpr size_t WS_ROPE = 1 * MiB + 256 * 1024;
constexpr size_t WS_RKV = 1 * MiB + 384 * 1024;
constexpr size_t WS_RT = 2 * MiB;
constexpr size_t WS_POS = 2 * MiB + 640 * 1024;
constexpr size_t WS_WR = 3 * MiB;
constexpr size_t WS_CB = 3 * MiB + 704 * 1024;
constexpr size_t WS_TOK = 3 * MiB + 720 * 1024;
constexpr size_t WS_XC = 4 * MiB;
constexpr size_t WS_W = 8 * MiB, W_LAYER = 15 * MiB;
constexpr size_t W_IN = 0, W_UQ = W_IN + (size_t)INW * DM * 2, W_UKV = W_UQ + (size_t)768 * QLORA * 2, W_BP = W_UKV + (size_t)1024 * KVLORA * 2,
                 W_BS = W_BP + (size_t)DM * 256 * 2, W_BM = W_BS + (size_t)DM * 256 * 2, W_OUT = W_BM + (size_t)DM * 512 * 2, W_END = W_OUT + (size_t)DM * DM * 2;
static_assert(W_END <= W_LAYER, "weights per layer");
constexpr size_t WS_XN = 38 * MiB;
constexpr size_t WS_K = 104 * MiB;
constexpr size_t WS_V = 154 * MiB;
constexpr size_t WS_PROJ = 188 * MiB;
constexpr size_t WS_XS = WS_PROJ;
constexpr size_t WS_ACT = WS_PROJ + 140 * MiB;
constexpr size_t WS_WGU = WS_PROJ + 210 * MiB;
constexpr size_t WS_WDN = WS_PROJ + 242 * MiB;
constexpr size_t WS_END = WS_PROJ + 297 * MiB;
static_assert(WS_K + (size_t)NB * NH * NKEY * 96 * 2 <= WS_V && WS_V + (size_t)NB * NH * NKEY * 64 * 2 <= WS_PROJ && WS_XN + (size_t)MROWS * DM * 2 <= WS_K, "ws map");
static_assert((size_t)MOE_ROWS * DM * 2 <= 140 * MiB && (size_t)MOE_ROWS * DE * 2 <= 70 * MiB && WS_WDN + (size_t)NE * DM * DE * 2 <= WS_END && (size_t)MROWS * INW * 2 <= 297 * MiB, "ws map 2");
constexpr int CW_BAR = 4096;
constexpr int CW_CNT = 1024;
constexpr int CW_CUR = 1536;

constexpr int LDS_BYTES = 147456;
constexpr int MISC_OFF = 141312;
namespace pg8 {
#define PG8_LAS __attribute__((address_space(3)))
typedef unsigned short bf16_t;
typedef short bf16x8 __attribute__((ext_vector_type(8)));
typedef float f32x4 __attribute__((ext_vector_type(4)));
typedef unsigned u32x4 __attribute__((ext_vector_type(4)));
typedef unsigned u32x2 __attribute__((ext_vector_type(2)));
constexpr int BM = 256, BK = 64, HALF = 128, HTB = HALF * BK * 2, STAGE_BYTES = 8 * HTB, NXCD = 8, WGM = 8;

__host__ __device__ __forceinline__ int lds_byte(int r, int c) { const int st = (r >> 4) * 2 + (c >> 5), rr = r & 15, cc = c & 31, ob = rr * 64 + cc * 2; return st * 1024 + (ob ^ (((ob >> 9) & 1) << 5)); }
__host__ __device__ __forceinline__ void stage_rc(int b, int& R, int& C) { const int st = b / 1024, sb = b % 1024, swz = sb ^ (((sb >> 9) & 1) << 5); R = (st >> 1) * 16 + swz / 64; C = (st & 1) * 32 + (swz % 64) / 2; }
__host__ __device__ __forceinline__ int perm32(int rho) { const int n = rho >> 4, i = rho & 15; return 8 * (i >> 2) + 4 * n + (i & 3); }

struct Unit { int pm, pn; };
struct Gemm { const bf16_t* A; const bf16_t* Bt; int lda, K; };

struct StaticOrder {
    static constexpr bool GATHER = false; const int* tok;
    int nM, nN, nwg, G, c;
    __device__ __forceinline__ void init(int M, int N, int G_, int c_) { nM = M / BM; nN = N / BM; nwg = nM * nN; G = G_; c = c_; }
    __device__ __forceinline__ bool next(int i, Unit& u) const {
        const long L = (long)i * G + c; if (L >= nwg) return false;
        int wgid = (int)L; { const int q = nwg / NXCD, r = nwg % NXCD, xcd = wgid % NXCD, off = wgid / NXCD; wgid = (xcd < r ? xcd * (q + 1) : r * (q + 1) + (xcd - r) * q) + off; }
        const int nig = WGM * nN, gid = wgid / nig, fm = gid * WGM, gsz = (nM - fm) < WGM ? (nM - fm) : WGM;
        const int w = wgid % nig;
        if (gsz == WGM) { u.pm = fm + (w & 7); u.pn = w >> 3; } else { u.pm = fm + (w & 3); u.pn = w >> 2; }
        return true;
    }
    __device__ __forceinline__ size_t acol(const Unit&) const { return 0; }
    __device__ __forceinline__ bool keep_acc(const Unit&) const { return false; }
    __device__ __forceinline__ void a_ready(const Unit&) const {}
    __device__ __forceinline__ void done(const Unit&) const {}
};

struct MergeOrder {
    static constexpr bool GATHER = false; const int* tok; StaticOrder base;
    __device__ __forceinline__ bool next(int i, Unit& u) const { Unit b; if (!base.next(i >> 2, b)) return false; u.pm = b.pm; u.pn = (i & 3) * 8 + b.pn; return true; }
    __device__ __forceinline__ size_t acol(const Unit& u) const { return (size_t)(u.pn >> 3) * 512; }
    __device__ __forceinline__ bool keep_acc(const Unit& u) const { return (u.pn >> 3) == 2; }
    __device__ __forceinline__ void a_ready(const Unit&) const {}
    __device__ __forceinline__ void done(const Unit&) const {}
};
template <bool GA> struct MoeOrder {
    static constexpr bool GATHER = GA;
    const int* tok; int G, c, nunits; int tb[16];
    __device__ __forceinline__ bool next(int i, Unit& u) const {
        const int L = i * G + c; if (L >= nunits) return false;
        const int pm = L >> 2, pnl = L & 3; int e = 0;
#pragma unroll
        for (int j = 1; j < 16; ++j) e += (pm >= tb[j]) ? 1 : 0;
        u.pm = pm; u.pn = e * 4 + pnl; return true;
    }
    __device__ __forceinline__ size_t acol(const Unit&) const { return 0; }
    __device__ __forceinline__ bool keep_acc(const Unit&) const { return false; }
    __device__ __forceinline__ void a_ready(const Unit&) const {}
    __device__ __forceinline__ void done(const Unit&) const {}
};

typedef float f32x2_t __attribute__((ext_vector_type(2))); typedef __bf16 bf16x2_t __attribute__((ext_vector_type(2)));
__device__ __forceinline__ unsigned cvt_pk_bf16(float lo, float hi) { const f32x2_t v = {lo, hi}; return __builtin_bit_cast(unsigned, __builtin_convertvector(v, bf16x2_t)); }
__device__ __forceinline__ u32x4 pack8(const f32x4 a, const f32x4 b) { u32x4 w; w.x = cvt_pk_bf16(a[0], a[1]); w.y = cvt_pk_bf16(a[2], a[3]); w.z = cvt_pk_bf16(b[0], b[1]); w.w = cvt_pk_bf16(b[2], b[3]); return w; }
__device__ __forceinline__ void unpack8(const u32x4 w, f32x4& a, f32x4& b) {
    a[0] = __uint_as_float(w.x << 16); a[1] = __uint_as_float(w.x & 0xffff0000u); a[2] = __uint_as_float(w.y << 16); a[3] = __uint_as_float(w.y & 0xffff0000u);
    b[0] = __uint_as_float(w.z << 16); b[1] = __uint_as_float(w.z & 0xffff0000u); b[2] = __uint_as_float(w.w << 16); b[3] = __uint_as_float(w.w & 0xffff0000u); }
__device__ __forceinline__ float sigmoidf_fast(float x) { return __builtin_amdgcn_rcpf(1.0f + __builtin_amdgcn_exp2f(-1.4426950408889634f * x)); }
__device__ __forceinline__ f32x4 sigmoid4(const f32x4 v) { f32x4 o; o[0] = sigmoidf_fast(v[0]); o[1] = sigmoidf_fast(v[1]); o[2] = sigmoidf_fast(v[2]); o[3] = sigmoidf_fast(v[3]); return o; }
__device__ __forceinline__ float dot4(const f32x4 v) { return (v[0] * v[0] + v[1] * v[1]) + (v[2] * v[2] + v[3] * v[3]); }


template <class Epi, class Sched>
__device__ __forceinline__ void gemm_phase(PG8_LAS unsigned char* lds, int tid_in, const Gemm g, const Sched& S, const Epi& E) {
    int tid_ = tid_in; asm volatile("" : "+v"(tid_));
    const int tid = tid_, wid = __builtin_amdgcn_readfirstlane(tid >> 6), lane = tid & 63, wr = wid >> 2, wc = wid & 3, fr = lane & 15, fq = lane >> 4;
    constexpr int NB = Epi::NB;
    const int K = g.K, nt = K / BK, lda = g.lda;
    unsigned voffA[2], voffB[2]; int Rv[2]; unsigned cv2[2];
#pragma unroll
    for (int i = 0; i < 2; ++i) { int R, C; stage_rc(tid * 16 + i * 8192, R, C); const int Rb = Epi::PERM ? ((R & ~31) + perm32(R & 31)) : R;
        voffA[i] = (unsigned)(R * lda + C) * 2u; voffB[i] = (unsigned)(Rb * K + C) * 2u; Rv[i] = R; cv2[i] = (unsigned)C * 2u; }
    unsigned goC[2][2] = {{0u, 0u}, {0u, 0u}}, goN[2][2] = {{0u, 0u}, {0u, 0u}};
#define PG8_LOADGO(go, u) do { if constexpr (Sched::GATHER) { _Pragma("unroll") for (int _h = 0; _h < 2; ++_h) _Pragma("unroll") for (int _i = 0; _i < 2; ++_i) \
        go[_h][_i] = (unsigned)S.tok[(u).pm * BM + _h * HALF + Rv[_i]] * (unsigned)(lda * 2) + cv2[_i]; } } while (0)
#define PG8_STAGE_A(bufoff, base, h, go) do { if constexpr (Sched::GATHER) { PG8_STAGE(bufoff, base, go[h]); } else { PG8_STAGE(bufoff, (base) + (h) * hstepA, voffA); } } while (0)
    const size_t kstep = (size_t)(BK * 2);
    const size_t hstepA = (size_t)HALF * lda * 2, hstepB = (size_t)HALF * K * 2;
    const size_t tstepA = 2 * hstepA, tstepB = NB * hstepB;
    const unsigned ldsw = (unsigned)wid * 1024u;
    const int aoff = lds_byte(wr * 64 + fr, fq * 8), boff = lds_byte(wc * 32 + fr, fq * 8);
#define PG8_SA(b, h) (((b) * 2 + (h)) * HTB)
#define PG8_SB(b, h) ((4 + (b) * 2 + (h)) * HTB)
#define PG8_STAGE(bufoff, gbase, voff) do { _Pragma("unroll") for (int _i = 0; _i < 2; ++_i) \
        __builtin_amdgcn_global_load_lds((const unsigned*)((const char*)(gbase) + (voff)[_i]), (PG8_LAS unsigned*)(lds + (bufoff) + ldsw + _i * 8192), 16, 0, 0); } while (0)
#define PG8_LDA(dst, b, h) do { _Pragma("unroll") for (int m = 0; m < 4; ++m) _Pragma("unroll") for (int k = 0; k < 2; ++k) dst[m][k] = *(const PG8_LAS bf16x8*)(lds + PG8_SA(b, h) + aoff + m * 2048 + k * 1024); } while (0)
#define PG8_LDB(dst, b, h) do { _Pragma("unroll") for (int n = 0; n < 2; ++n) _Pragma("unroll") for (int k = 0; k < 2; ++k) dst[n][k] = *(const PG8_LAS bf16x8*)(lds + PG8_SB(b, h) + boff + n * 2048 + k * 1024); } while (0)
#define PG8_MMA(ai, bj, At, Bt) do { __builtin_amdgcn_s_setprio(1); _Pragma("unroll") for (int m = 0; m < 4; ++m) _Pragma("unroll") for (int n = 0; n < 2; ++n) _Pragma("unroll") for (int k = 0; k < 2; ++k) \
        acc[ai][bj][m][n] = __builtin_amdgcn_mfma_f32_16x16x32_bf16(Bt[n][k], At[m][k], acc[ai][bj][m][n], 0, 0, 0); __builtin_amdgcn_s_setprio(0); } while (0)
#define PG8_WAIT_V(n) asm volatile("s_waitcnt vmcnt(" #n ")" ::: "memory")
#define PG8_WAIT_L(n) asm volatile("s_waitcnt lgkmcnt(" #n ")" ::: "memory")
#define PG8_WAIT_VN() do { if constexpr (NB == 2) PG8_WAIT_V(8); else PG8_WAIT_V(6); } while (0)
#define PG8_BAR __builtin_amdgcn_s_barrier()
#define PG8_SCHED __builtin_amdgcn_sched_barrier(0)
    Unit cur, nxt; int ui = 0;
    if (!S.next(0, cur)) return;
    cur.pm = __builtin_amdgcn_readfirstlane(cur.pm); cur.pn = __builtin_amdgcn_readfirstlane(cur.pn);
    f32x4 acc[2][2][4][2];
#pragma unroll
    for (int a = 0; a < 2; ++a)
#pragma unroll
        for (int b = 0; b < 2; ++b)
#pragma unroll
            for (int m = 0; m < 4; ++m)
#pragma unroll
                for (int n = 0; n < 2; ++n) acc[a][b][m][n] = (f32x4){0.f, 0.f, 0.f, 0.f};
    bf16x8 At[4][2], B0[2][2], B1[2][2];
    const char* cA = (const char*)g.A + (Sched::GATHER ? (size_t)0 : (size_t)cur.pm * tstepA) + S.acol(cur); const char* cB = (const char*)g.Bt + (size_t)cur.pn * tstepB;
    PG8_LOADGO(goC, cur);
    S.a_ready(cur);
    PG8_STAGE(PG8_SB(0, 0), cB, voffB); if constexpr (NB == 2) PG8_STAGE(PG8_SB(0, 1), cB + hstepB, voffB); PG8_STAGE_A(PG8_SA(0, 0), cA, 0, goC); PG8_STAGE_A(PG8_SA(0, 1), cA, 1, goC);
    if (wr == 1) PG8_BAR;
    PG8_WAIT_V(2); PG8_BAR;
    PG8_STAGE(PG8_SB(1, 0), cB + kstep, voffB); PG8_STAGE_A(PG8_SA(1, 0), cA + kstep, 0, goC); if constexpr (NB == 2) PG8_STAGE(PG8_SB(1, 1), cB + hstepB + kstep, voffB);
    if constexpr (NB == 2) PG8_WAIT_V(6); else PG8_WAIT_V(4);
    PG8_BAR;
    for (;;) {
        bool has_next = S.next(ui + 1, nxt);
        has_next = __builtin_amdgcn_readfirstlane((int)has_next) != 0; nxt.pm = __builtin_amdgcn_readfirstlane(nxt.pm); nxt.pn = __builtin_amdgcn_readfirstlane(nxt.pn);
        if constexpr (Sched::GATHER) { if (has_next) { PG8_LOADGO(goN, nxt); } else { _Pragma("unroll") for (int _h = 0; _h < 2; ++_h) _Pragma("unroll") for (int _i = 0; _i < 2; ++_i) goN[_h][_i] = goC[_h][_i]; } }
        const char* nA = Sched::GATHER ? (const char*)g.A : (has_next ? (const char*)g.A + (size_t)nxt.pm * tstepA + S.acol(nxt) : cA); const char* nB = has_next ? (const char*)g.Bt + (size_t)nxt.pn * tstepB : cB;
#pragma unroll 1
        for (int t = 0; t < nt; t += 2) {
            const bool last = (t == nt - 2);
            const char* a1 = cA + (size_t)(t + 1) * kstep;
            const char* a2 = last ? nA : cA + (size_t)(t + 2) * kstep; const char* b2 = last ? nB : cB + (size_t)(t + 2) * kstep;
            const char* a3 = a2 + kstep; const char* b3 = b2 + kstep;
            unsigned s2[2][2];
#pragma unroll
            for (int _h = 0; _h < 2; ++_h)
#pragma unroll
                for (int _i = 0; _i < 2; ++_i) s2[_h][_i] = last ? goN[_h][_i] : goC[_h][_i];
            if (last && has_next) S.a_ready(nxt);
            if constexpr (Epi::HOOKS) { if (t == 4 || t == 8) E.hook(acc, cur, t, wr, wc, fr, fq); }
            PG8_LDB(B0, 0, 0); if constexpr (NB == 2) PG8_LDB(B1, 0, 1); PG8_SCHED; PG8_LDA(At, 0, 0); PG8_STAGE_A(PG8_SA(1, 1), a1, 1, goC);
            PG8_WAIT_VN(); PG8_WAIT_L(0); PG8_BAR; PG8_MMA(0, 0, At, B0); if constexpr (NB == 2) PG8_MMA(0, 1, At, B1); PG8_BAR; PG8_SCHED;
            PG8_LDA(At, 0, 1); PG8_STAGE(PG8_SB(0, 0), b2, voffB); if constexpr (NB == 2) PG8_STAGE(PG8_SB(0, 1), b2 + hstepB, voffB); PG8_STAGE_A(PG8_SA(0, 0), a2, 0, s2);
            PG8_WAIT_VN(); PG8_WAIT_L(0); PG8_BAR; PG8_MMA(1, 0, At, B0); if constexpr (NB == 2) PG8_MMA(1, 1, At, B1); PG8_BAR; PG8_SCHED;
            PG8_LDB(B0, 1, 0); if constexpr (NB == 2) PG8_LDB(B1, 1, 1); PG8_SCHED; PG8_LDA(At, 1, 0); PG8_STAGE_A(PG8_SA(0, 1), a2, 1, s2);
            PG8_WAIT_VN(); PG8_WAIT_L(0); PG8_BAR; PG8_MMA(0, 0, At, B0); if constexpr (NB == 2) PG8_MMA(0, 1, At, B1); PG8_BAR; PG8_SCHED;
            PG8_LDA(At, 1, 1); PG8_STAGE(PG8_SB(1, 0), b3, voffB); if constexpr (NB == 2) PG8_STAGE(PG8_SB(1, 1), b3 + hstepB, voffB); PG8_STAGE_A(PG8_SA(1, 0), a3, 0, s2);
            PG8_WAIT_VN(); PG8_WAIT_L(0); PG8_BAR; PG8_MMA(1, 0, At, B0); if constexpr (NB == 2) PG8_MMA(1, 1, At, B1); PG8_BAR; PG8_SCHED;
        }
        if (wr == 0) PG8_BAR;
        const bool keep = S.keep_acc(cur);
        if (!keep) E(acc, cur, wr, wc, fr, fq);
        S.done(cur);
        if (!has_next) break;
        if (!keep)
#pragma unroll
        for (int a = 0; a < 2; ++a)
#pragma unroll
            for (int b = 0; b < 2; ++b)
#pragma unroll
                for (int m = 0; m < 4; ++m)
#pragma unroll
                    for (int n = 0; n < 2; ++n) acc[a][b][m][n] = (f32x4){0.f, 0.f, 0.f, 0.f};
        cur = nxt; cA = nA; cB = nB; ++ui;
        if constexpr (Sched::GATHER) { _Pragma("unroll") for (int _h = 0; _h < 2; ++_h) _Pragma("unroll") for (int _i = 0; _i < 2; ++_i) goC[_h][_i] = goN[_h][_i]; }
        if (wr == 1) PG8_BAR;
    }
    PG8_WAIT_V(0);
    PG8_BAR;
#undef PG8_SA
#undef PG8_SB
#undef PG8_STAGE
#undef PG8_STAGE_A
#undef PG8_LOADGO
#undef PG8_LDA
#undef PG8_LDB
#undef PG8_MMA
#undef PG8_WAIT_V
#undef PG8_WAIT_L
#undef PG8_WAIT_VN
#undef PG8_BAR
#undef PG8_SCHED
}
}
namespace pg8 {
constexpr float QSCALE_LOG2 = 0.10206207261596575f * 1.4426950408889634f;
struct EpiNull { static constexpr bool PERM = true, HOOKS = false; static constexpr int NB = 2;
    __device__ __forceinline__ void operator()(const f32x4 (&acc)[2][2][4][2], const Unit&, int, int, int, int) const {
#pragma unroll
        for (int a = 0; a < 2; ++a)
#pragma unroll
            for (int b = 0; b < 2; ++b)
#pragma unroll
                for (int m = 0; m < 4; ++m)
#pragma unroll
                    for (int n = 0; n < 2; ++n) asm volatile("" :: "v"(acc[a][b][m][n])); } };
struct EpiInProj { static constexpr bool PERM = true, HOOKS = false; static constexpr int NB = 2;
    bf16_t* P; const float* bgate; float* RKV; bf16_t* Kb; const float* kng; const float* cosT; const float* sinT;
    __device__ __forceinline__ void operator()(const f32x4 (&acc)[2][2][4][2], const Unit& u, int wr, int wc, int fr, int fq) const {
        asm volatile("" : "+v"(fr), "+v"(fq));
        const int row0 = u.pm * BM + wr * 64 + fr, colt = u.pn * BM + wc * 32 + 8 * fq;
        if (u.pn >= C_GATE / BM) {
            const int gc0 = (u.pn - C_GATE / BM) * BM + wc * 64 + fq * 16;
            f32x4 bv[2][2];
#pragma unroll
            for (int bj = 0; bj < 2; ++bj)
#pragma unroll
                for (int n = 0; n < 2; ++n) bv[bj][n] = *(const f32x4*)(bgate + gc0 + bj * 8 + 4 * n);
            asm volatile("" : "+v"(bv[0][0]), "+v"(bv[0][1]), "+v"(bv[1][0]), "+v"(bv[1][1]));
#pragma unroll
            for (int ai = 0; ai < 2; ++ai)
#pragma unroll
                for (int m = 0; m < 4; ++m) { u32x4 w;
#pragma unroll
                    for (int bj = 0; bj < 2; ++bj)
#pragma unroll
                        for (int n = 0; n < 2; ++n) { const f32x4 s = sigmoid4(acc[ai][bj][m][n] + bv[bj][n]) * 255.0f + 0.5f;
                            w[bj * 2 + n] = (unsigned)s[0] | ((unsigned)s[1] << 8) | ((unsigned)s[2] << 16) | ((unsigned)s[3] << 24); }
                    *(u32x4*)((unsigned char*)P + (size_t)(row0 + ai * HALF + m * 16) * (INW * 2) + C_GATE * 2 + gc0) = w; }
            return;
        }
#pragma unroll
        for (int ai = 0; ai < 2; ++ai)
#pragma unroll
            for (int m = 0; m < 4; ++m) { bf16_t* rowp = P + (size_t)(row0 + ai * HALF + m * 16) * INW + colt;
#pragma unroll
                for (int bj = 0; bj < 2; ++bj) *(u32x4*)(rowp + bj * HALF) = pack8(acc[ai][bj][m][0], acc[ai][bj][m][1]); }
        if (u.pn == C_KVA / BM) {
#pragma unroll
            for (int ai = 0; ai < 2; ++ai)
#pragma unroll
                for (int m = 0; m < 4; ++m) {
                    float ss = (dot4(acc[ai][0][m][0]) + dot4(acc[ai][0][m][1])) + (dot4(acc[ai][1][m][0]) + dot4(acc[ai][1][m][1]));
                    ss += __shfl_xor(ss, 16); ss += __shfl_xor(ss, 32);
                    if (fq == 0) RKV[(size_t)(row0 + ai * HALF + m * 16) * 4 + wc] = ss; }
        }
        if (u.pn == C_KR / BM && wc == 0) {
            const f32x4 g0 = *(const f32x4*)(kng + 8 * fq), g1 = *(const f32x4*)(kng + 8 * fq + 4);
            const bool lat = u.pm < NLAT / BM; const bool first = (fq & 1) == 0;
#pragma unroll
            for (int ai = 0; ai < 2; ++ai)
#pragma unroll
                for (int m = 0; m < 4; ++m) {
                    const int row = row0 + ai * HALF + m * 16;
                    float ss = dot4(acc[ai][1][m][0]) + dot4(acc[ai][1][m][1]);
                    ss += __shfl_xor(ss, 16); ss += __shfl_xor(ss, 32);
                    const float r = rsqrtf(ss * (1.0f / 32.0f) + EPS);
                    f32x4 v0 = acc[ai][1][m][0] * r * g0, v1 = acc[ai][1][m][1] * r * g1, p0, p1;
#pragma unroll
                    for (int e = 0; e < 4; ++e) { p0[e] = __shfl_xor(v0[e], 16); p1[e] = __shfl_xor(v1[e], 16); }
                    if (lat) { const int t = row & (SEQ - 1); const int pos = (fq >> 1) ? (t & 63) : (t >> 6);
                        const f32x4 c0 = *(const f32x4*)(cosT + pos * 8), c1 = *(const f32x4*)(cosT + pos * 8 + 4); f32x4 s0 = *(const f32x4*)(sinT + pos * 8), s1 = *(const f32x4*)(sinT + pos * 8 + 4);
                        if (first) { s0 = -s0; s1 = -s1; }
                        v0 = v0 * c0 + p0 * s0; v1 = v1 * c1 + p1 * s1; }
                    const int b = lat ? (row >> 13) : ((row - NLAT) >> 8), key = lat ? (row & (SEQ - 1)) : (SEQ + ((row - NLAT) & 255));
                    const u32x4 w = pack8(v0, v1);
#pragma unroll
                    for (int h = 0; h < NH; ++h) *(u32x4*)(Kb + ((unsigned)((b * NH + h) * NKEY + key) * (unsigned)QKH + (unsigned)(64 + 8 * fq))) = w;
                    asm volatile("" ::: "memory"); }
        }
    }
};
struct EpiQ { static constexpr bool PERM = true, HOOKS = false; static constexpr int NB = 2;
    bf16_t* Q; const float* qg; const float* cosT; const float* sinT;
    __device__ __forceinline__ void operator()(const f32x4 (&acc)[2][2][4][2], const Unit& u, int wr, int wc, int fr, int fq) const {
        asm volatile("" : "+v"(fr), "+v"(fq));
        const int row0 = u.pm * BM + wr * 64 + fr;
        if (u.pn < 2) {
            const int head = u.pn * 4 + wc;
            f32x4 g[2][2];
#pragma unroll
            for (int bj = 0; bj < 2; ++bj)
#pragma unroll
                for (int n = 0; n < 2; ++n) g[bj][n] = *(const f32x4*)(qg + 32 * bj + 8 * fq + 4 * n);
#pragma unroll
            for (int ai = 0; ai < 2; ++ai)
#pragma unroll
                for (int m = 0; m < 4; ++m) {
                    float ss = (dot4(acc[ai][0][m][0]) + dot4(acc[ai][0][m][1])) + (dot4(acc[ai][1][m][0]) + dot4(acc[ai][1][m][1]));
                    ss += __shfl_xor(ss, 16); ss += __shfl_xor(ss, 32);
                    const float r = rsqrtf(ss * (1.0f / 64.0f) + EPS) * QSCALE_LOG2;
                    bf16_t* rowp = Q + (size_t)(row0 + ai * HALF + m * 16) * 768 + head * QKH + 8 * fq;
#pragma unroll
                    for (int bj = 0; bj < 2; ++bj) *(u32x4*)(rowp + 32 * bj) = pack8(acc[ai][bj][m][0] * r * g[bj][0], acc[ai][bj][m][1] * r * g[bj][1]);
                    asm volatile("" ::: "memory");
                }
        } else {
            const f32x4 g0 = *(const f32x4*)(qg + 64 + 8 * fq), g1 = *(const f32x4*)(qg + 64 + 8 * fq + 4);
            const bool rope = u.pm < NLAT / BM; const bool first = (fq & 1) == 0;
#pragma unroll
            for (int ai = 0; ai < 2; ++ai)
#pragma unroll
                for (int m = 0; m < 4; ++m) {
                    const int row = row0 + ai * HALF + m * 16;
                    f32x4 c0 = {1.f, 1.f, 1.f, 1.f}, c1 = c0, s0 = {0.f, 0.f, 0.f, 0.f}, s1 = s0;
                    if (rope) { const int t = row & (SEQ - 1); const int pos = (fq >> 1) ? (t & 63) : (t >> 6);
                        c0 = *(const f32x4*)(cosT + pos * 8); c1 = *(const f32x4*)(cosT + pos * 8 + 4); s0 = *(const f32x4*)(sinT + pos * 8); s1 = *(const f32x4*)(sinT + pos * 8 + 4);
                        if (first) { s0 = -s0; s1 = -s1; } }
#pragma unroll
                    for (int bj = 0; bj < 2; ++bj) {
                        const int head = 4 * bj + wc;
                        float ss = dot4(acc[ai][bj][m][0]) + dot4(acc[ai][bj][m][1]);
                        ss += __shfl_xor(ss, 16); ss += __shfl_xor(ss, 32);
                        const float r = rsqrtf(ss * (1.0f / 32.0f) + EPS) * QSCALE_LOG2;
                        f32x4 v0 = acc[ai][bj][m][0] * r * g0, v1 = acc[ai][bj][m][1] * r * g1, p0, p1;
#pragma unroll
                        for (int e = 0; e < 4; ++e) { p0[e] = __shfl_xor(v0[e], 16); p1[e] = __shfl_xor(v1[e], 16); }
                        v0 = v0 * c0 + p0 * s0; v1 = v1 * c1 + p1 * s1;
                        *(u32x4*)(Q + (size_t)row * 768 + head * QKH + 64 + 8 * fq) = pack8(v0, v1);
                    }
                    asm volatile("" ::: "memory");
                }
        }
    }
};
struct EpiKV { static constexpr bool PERM = true, HOOKS = false; static constexpr int NB = 2;
    bf16_t* Kb; bf16_t* Vb; const float* kg; const float* RKV;
    __device__ __forceinline__ void operator()(const f32x4 (&acc)[2][2][4][2], const Unit& u, int wr, int wc, int fr, int fq) const {
        asm volatile("" : "+v"(fr), "+v"(fq));
        const int row0 = u.pm * BM + wr * 64 + fr; const int head = 2 * u.pn + (wc & 1);
        const bool lat = u.pm < NLAT / BM;
        if (wc < 2) {
            f32x4 g[2][2];
#pragma unroll
            for (int bj = 0; bj < 2; ++bj) { g[bj][0] = *(const f32x4*)(kg + 32 * bj + 8 * fq); g[bj][1] = *(const f32x4*)(kg + 32 * bj + 8 * fq + 4); }
            asm volatile("" : "+v"(g[0][0]), "+v"(g[0][1]), "+v"(g[1][0]), "+v"(g[1][1]));
#pragma unroll
            for (int ai = 0; ai < 2; ++ai)
#pragma unroll
                for (int m = 0; m < 4; ++m) {
                    const int row = row0 + ai * HALF + m * 16;
                    const int b = lat ? (row >> 13) : ((row - NLAT) >> 8), key = lat ? (row & (SEQ - 1)) : (SEQ + ((row - NLAT) & 255));
                    const unsigned kidx = (unsigned)((b * NH + head) * NKEY + key);
                    float ss = (dot4(acc[ai][0][m][0]) + dot4(acc[ai][0][m][1])) + (dot4(acc[ai][1][m][0]) + dot4(acc[ai][1][m][1]));
                    ss += __shfl_xor(ss, 16); ss += __shfl_xor(ss, 32);
                    const float r = rsqrtf(ss * (1.0f / 64.0f) + EPS);
#pragma unroll
                    for (int bj = 0; bj < 2; ++bj)
                        *(u32x4*)(Kb + (kidx * (unsigned)QKH + (unsigned)(32 * bj + 8 * fq))) = pack8(acc[ai][bj][m][0] * r * g[bj][0], acc[ai][bj][m][1] * r * g[bj][1]);
                }
        } else {
#pragma unroll
            for (int ai = 0; ai < 2; ++ai) {
                f32x4 pr[4];
#pragma unroll
                for (int m = 0; m < 4; ++m) pr[m] = *(const f32x4*)(RKV + (size_t)(row0 + ai * HALF + m * 16) * 4);
                asm volatile("" : "+v"(pr[0]), "+v"(pr[1]), "+v"(pr[2]), "+v"(pr[3]));
#pragma unroll
                for (int m = 0; m < 4; ++m) {
                    const int row = row0 + ai * HALF + m * 16;
                    const int b = lat ? (row >> 13) : ((row - NLAT) >> 8), key = lat ? (row & (SEQ - 1)) : (SEQ + ((row - NLAT) & 255));
                    const unsigned kidx = (unsigned)((b * NH + head) * NKEY + key);
                    const float rk = rsqrtf(((pr[m][0] + pr[m][1]) + (pr[m][2] + pr[m][3])) * (1.0f / 256.0f) + EPS);
#pragma unroll
                    for (int bj = 0; bj < 2; ++bj) *(u32x4*)(Vb + (kidx * (unsigned)VH + (unsigned)(32 * bj + 8 * fq))) = pack8(acc[ai][bj][m][0] * rk, acc[ai][bj][m][1] * rk);
                }
                asm volatile("" ::: "memory");
            }
        }
    }
};
struct EpiMergeF { static constexpr bool PERM = true, HOOKS = false; static constexpr int NB = 1;
    const bf16_t* P; bf16_t* MG; mutable u32x4 run[2][4];
    __device__ __forceinline__ void operator()(const f32x4 (&acc)[2][2][4][2], const Unit& u, int wr, int wc, int fr, int fq) const {
        asm volatile("" : "+v"(fr), "+v"(fq));
        const int seg = u.pn >> 3, pnl = u.pn & 7, gate = seg == 0 ? 1 : seg == 1 ? 0 : 2;
        const int row0 = u.pm * BM + wr * 64 + fr, colt = pnl * HALF + wc * 32 + 8 * fq;
#pragma unroll
        for (int i0 = 0; i0 < 8; i0 += 4) {
            u32x2 gw[4];
#pragma unroll
            for (int k = 0; k < 4; ++k) { const int i = i0 + k; gw[k] = *(const u32x2*)((const unsigned char*)P + (size_t)(row0 + (i >> 2) * HALF + (i & 3) * 16) * (INW * 2) + C_GATE * 2 + DM * gate + colt); }
#pragma unroll
            for (int k = 0; k < 4; ++k) asm volatile("" : "+v"(gw[k]));
#pragma unroll
            for (int k = 0; k < 4; ++k) { const int i = i0 + k, ai = i >> 2, m = i & 3; f32x4 g0, g1;
#pragma unroll
                for (int b = 0; b < 4; ++b) { g0[b] = (float)((gw[k].x >> (8 * b)) & 255u) * (1.0f / 255.0f); g1[b] = (float)((gw[k].y >> (8 * b)) & 255u) * (1.0f / 255.0f); }
                f32x4 v0 = acc[ai][0][m][0] * g0, v1 = acc[ai][0][m][1] * g1;
                if (seg != 0) { f32x4 q0, q1; unpack8(run[ai][m], q0, q1); v0 += q0; v1 += q1; }
                const u32x4 w = pack8(v0, v1); run[ai][m] = w;
                if (seg == 3) *(u32x4*)(MG + (size_t)(row0 + ai * HALF + m * 16) * DM + colt) = w; }
            asm volatile("" ::: "memory");
        }
    }
};
struct EpiOut { static constexpr bool PERM = true, HOOKS = false; static constexpr int NB = 2;
    const float* resL; const float* resC; bf16_t* X1; const float* gvec;
    template <int I0, int N> __device__ __forceinline__ void batch(const f32x4 (&acc)[2][2][4][2], const f32x4 (&gv)[2][2], const float* res, size_t roff0, size_t xoff0) const {
        f32x4 xr[N][2];
#pragma unroll
        for (int k = 0; k < N; ++k) { const int i = I0 + k, ai = i >> 3, m = (i >> 1) & 3, bj = i & 1; const float* p = res + roff0 + (size_t)(ai * HALF + m * 16) * DM + bj * HALF;
            xr[k][0] = *(const f32x4*)p; xr[k][1] = *(const f32x4*)(p + 4); }
#pragma unroll
        for (int k = 0; k < N; ++k) { asm volatile("" : "+v"(xr[k][0])); asm volatile("" : "+v"(xr[k][1])); }
#pragma unroll
        for (int k = 0; k < N; ++k) { const int i = I0 + k, ai = i >> 3, m = (i >> 1) & 3, bj = i & 1;
            *(u32x4*)(X1 + xoff0 + (size_t)(ai * HALF + m * 16) * DM + bj * HALF) = pack8(xr[k][0] + gv[bj][0] * acc[ai][bj][m][0], xr[k][1] + gv[bj][1] * acc[ai][bj][m][1]); }
        asm volatile("" ::: "memory");
    }
    __device__ __forceinline__ void operator()(const f32x4 (&acc)[2][2][4][2], const Unit& u, int wr, int wc, int fr, int fq) const {
        asm volatile("" : "+v"(fr), "+v"(fq));
        const bool lat = u.pm < NLAT / BM;
        const float* res = lat ? resL : resC; const int roff = lat ? 0 : NLAT;
        const int col0 = u.pn * BM + wc * 32 + 8 * fq, mrow = lat ? (u.pm >> 5) : 4;
        const float* gp = gvec + (size_t)mrow * (6 * DM) + col0;
        f32x4 gv[2][2];
#pragma unroll
        for (int bj = 0; bj < 2; ++bj)
#pragma unroll
            for (int n = 0; n < 2; ++n) gv[bj][n] = *(const f32x4*)(gp + bj * HALF + 4 * n);
        const int row = u.pm * BM + wr * 64 + fr;
        const size_t roff0 = (size_t)(row - roff) * DM + col0, xoff0 = (size_t)row * DM + col0;
        batch<0, 2>(acc, gv, res, roff0, xoff0); batch<2, 2>(acc, gv, res, roff0, xoff0); batch<4, 4>(acc, gv, res, roff0, xoff0); batch<8, 8>(acc, gv, res, roff0, xoff0);
    }
};
struct EpiMoe1 { static constexpr bool PERM = true, HOOKS = false; static constexpr int NB = 2;
    bf16_t* ACT;
    __device__ __forceinline__ void operator()(const f32x4 (&acc)[2][2][4][2], const Unit& u, int wr, int wc, int fr, int fq) const {
        asm volatile("" : "+v"(fr), "+v"(fq));
        const int row0 = u.pm * BM + wr * 64 + fr, col = (u.pn & 3) * HALF + wc * 32 + 8 * fq;
#pragma unroll
        for (int ai = 0; ai < 2; ++ai)
#pragma unroll
            for (int m = 0; m < 4; ++m) {
                const f32x4 g0 = acc[ai][0][m][0], g1 = acc[ai][0][m][1];
                const f32x4 a0 = g0 * sigmoid4(g0) * acc[ai][1][m][0], a1 = g1 * sigmoid4(g1) * acc[ai][1][m][1];
                *(u32x4*)(ACT + (size_t)(row0 + ai * HALF + m * 16) * DE + col) = pack8(a0, a1); }
    }
};
struct EpiMoe2 { static constexpr bool PERM = true, HOOKS = false; static constexpr int NB = 2;
    bf16_t* YS;
    __device__ __forceinline__ void operator()(const f32x4 (&acc)[2][2][4][2], const Unit& u, int wr, int wc, int fr, int fq) const {
        asm volatile("" : "+v"(fr), "+v"(fq));
        const int row0 = u.pm * BM + wr * 64 + fr, col = (u.pn & 3) * BM + wc * 32 + 8 * fq;
#pragma unroll
        for (int ai = 0; ai < 2; ++ai)
#pragma unroll
            for (int m = 0; m < 4; ++m)
#pragma unroll
                for (int bj = 0; bj < 2; ++bj) *(u32x4*)(YS + (size_t)(row0 + ai * HALF + m * 16) * DM + col + bj * HALF) = pack8(acc[ai][bj][m][0], acc[ai][bj][m][1]);
    }
};
}
namespace attn {
typedef unsigned short bf16_t;
using bf16x8 = __attribute__((ext_vector_type(8))) short;
using s16x4  = __attribute__((ext_vector_type(4))) short;
using f32x16 = __attribute__((ext_vector_type(16))) float;
using u32x4  = __attribute__((ext_vector_type(4))) unsigned;
constexpr int NW = 8, QBLK = 32, KVBLK = 64;
constexpr float QSCALE = 0.10206207261596575f * 1.4426950408889634f;
constexpr int SHM_V = 16384, SHM_K = 16384, SLOTB = 16384, NSLOT = 3,     SHM_ATTN = NSLOT * SHM_V + NSLOT * SHM_K + NW * 64 * 4;
#define KSWZ(row, colB) ((row) * 256 + ((colB) ^ (((row) & 7) << 4)))
#define SBAR() __builtin_amdgcn_sched_barrier(0)
__device__ __forceinline__ int crow(int r, int hi) { return (r & 3) + 8 * (r >> 2) + 4 * hi; }
__device__ __forceinline__ unsigned cvtpk(float lo, float hi) { unsigned r; asm volatile("v_cvt_pk_bf16_f32 %0, %1, %2" : "=v"(r) : "v"(lo), "v"(hi)); return r; }
__device__ __forceinline__ bf16x8 ld8(const bf16_t* p) { return *reinterpret_cast<const bf16x8*>(p); }

constexpr float PSHIFT = 0.0f;
__device__ __forceinline__ void partialSM(f32x16& p0) {
  for (int r = 0; r < 16; ++r) p0[r] = __builtin_amdgcn_exp2f(p0[r]);
}
typedef float f32x2 __attribute__((ext_vector_type(2)));
__device__ __forceinline__ void finishSM(f32x16& p0, f32x16& p1, f32x2& l_reg, bf16x8& pa0, bf16x8& pa1, bf16x8& pa2, bf16x8& pa3) {
  for (int r = 0; r < 16; ++r) p1[r] = __builtin_amdgcn_exp2f(p1[r]);
#define P2(P, i) ((f32x2){P[2 * (i)], P[2 * (i) + 1]})
  const f32x2 a = ((P2(p0, 0) + P2(p0, 1)) + (P2(p0, 2) + P2(p0, 3))) + ((P2(p0, 4) + P2(p0, 5)) + (P2(p0, 6) + P2(p0, 7)));
  const f32x2 b = ((P2(p1, 0) + P2(p1, 1)) + (P2(p1, 2) + P2(p1, 3))) + ((P2(p1, 4) + P2(p1, 5)) + (P2(p1, 6) + P2(p1, 7)));
  l_reg += a + b;
#undef P2
#define PK4(P, BASE, OUT) do { u32x4 w = {cvtpk(P[BASE + 0], P[BASE + 1]), cvtpk(P[BASE + 2], P[BASE + 3]), cvtpk(P[BASE + 4], P[BASE + 5]), cvtpk(P[BASE + 6], P[BASE + 7])}; \
    OUT = *reinterpret_cast<bf16x8*>(&w); } while (0)
  PK4(p0, 0, pa0); PK4(p0, 8, pa1); PK4(p1, 0, pa2); PK4(p1, 8, pa3);
#undef PK4
}
__device__ __forceinline__ void qkt(f32x16& p0, f32x16& p1, const bf16_t* Ks, const bf16x8* qr, int r32, int hi) {
  for (int r = 0; r < 16; ++r) { p0[r] = 0.0f - PSHIFT; p1[r] = 0.0f - PSHIFT; }
#pragma unroll
  for (int d0 = 0; d0 < 6; ++d0) { int cb = (d0 * 16 + hi * 8) * 2;
    bf16x8 b0 = *reinterpret_cast<const bf16x8*>((const char*)Ks + KSWZ(r32, cb));
    bf16x8 b1 = *reinterpret_cast<const bf16x8*>((const char*)Ks + KSWZ(32 + r32, cb));
    p0 = __builtin_amdgcn_mfma_f32_32x32x16_bf16(b0, qr[d0], p0, 0, 0, 0);
    p1 = __builtin_amdgcn_mfma_f32_32x32x16_bf16(b1, qr[d0], p1, 0, 0, 0); }
}
constexpr int VPB = 192;
__device__ __forceinline__ int v_st(int k, int c) { return k * VPB + c * 2; }
__device__ __forceinline__ int v_rd_base(int lane) { const int i = lane & 15, ch = (lane >> 4) & 1, h = lane >> 5; return (4 * h + (i >> 2)) * VPB + (16 * ch + 4 * (i & 3)) * 2; }
constexpr int v_rd_off(int d0, int ks, int half) { return d0 * 64 + ks * 16 * VPB + half * 8 * VPB; }
template <int OFF> __device__ __forceinline__ s16x4 tr_read(int vb) {
  s16x4 r; asm volatile("ds_read_b64_tr_b16 %0, %1 offset:%2" : "=&v"(r) : "v"(vb), "i"(OFF) : "memory"); return r;
}
template <int D0> __device__ __forceinline__ void pv_one(f32x16& od, int vb, bf16x8 pa0, bf16x8 pa1, bf16x8 pa2, bf16x8 pa3) {
  const s16x4 l0 = tr_read<v_rd_off(D0, 0, 0)>(vb), h0 = tr_read<v_rd_off(D0, 0, 1)>(vb), l1 = tr_read<v_rd_off(D0, 1, 0)>(vb), h1 = tr_read<v_rd_off(D0, 1, 1)>(vb);
  const s16x4 l2 = tr_read<v_rd_off(D0, 2, 0)>(vb), h2 = tr_read<v_rd_off(D0, 2, 1)>(vb), l3 = tr_read<v_rd_off(D0, 3, 0)>(vb), h3 = tr_read<v_rd_off(D0, 3, 1)>(vb);
  asm volatile("s_waitcnt lgkmcnt(0)" ::: "memory"); SBAR();
#define PK(L, H) (bf16x8){L[0], L[1], L[2], L[3], H[0], H[1], H[2], H[3]}
  od = __builtin_amdgcn_mfma_f32_32x32x16_bf16(pa0, PK(l0, h0), od, 0, 0, 0);
  od = __builtin_amdgcn_mfma_f32_32x32x16_bf16(pa1, PK(l1, h1), od, 0, 0, 0);
  od = __builtin_amdgcn_mfma_f32_32x32x16_bf16(pa2, PK(l2, h2), od, 0, 0, 0);
  od = __builtin_amdgcn_mfma_f32_32x32x16_bf16(pa3, PK(l3, h3), od, 0, 0, 0);
#undef PK
}
__device__ __forceinline__ void pv_d0(f32x16* o, int vb, bf16x8 pa0, bf16x8 pa1, bf16x8 pa2, bf16x8 pa3) {
  pv_one<0>(o[0], vb, pa0, pa1, pa2, pa3); pv_one<1>(o[1], vb, pa0, pa1, pa2, pa3);
}
#ifndef ATTN_HAND
#define ATTN_HAND 1
#endif
template <int OFF> __device__ __forceinline__ bf16x8 k_read(int a) { bf16x8 r; asm volatile("ds_read_b128 %0, %1 offset:%2" : "=&v"(r) : "v"(a), "i"(OFF) : "memory"); return r; }
__device__ __forceinline__ unsigned cvt2n(float lo, float hi) { const f32x2 v = {lo, hi}; typedef __bf16 bf2 __attribute__((ext_vector_type(2))); return __builtin_bit_cast(unsigned, __builtin_convertvector(v, bf2)); }
__device__ __forceinline__ void attn_dense_body(int tid_in, const bf16_t* __restrict__ Qb, int ldq, const bf16_t* __restrict__ Kh, const bf16_t* __restrict__ Vh,
                                                bf16_t* __restrict__ Ob, int ldo, int NT, char* lds) {
  int tid_ = tid_in; asm volatile("" : "+v"(tid_));
  const int tid = tid_, wid = tid >> 6, lane = tid & 63, r32 = lane & 31, hi = lane >> 5;
  bf16_t* V_lds = (bf16_t*)lds; bf16_t* K_lds = (bf16_t*)(lds + NSLOT * SHM_V);
  float* ws = (float*)(lds + NSLOT * SHM_V + NSLOT * SHM_K) + wid * 64; float* li_l = ws;
  f32x2 l_reg2 = {0.f, 0.f}; f32x16 o[2] = {}; bf16x8 qr[6];
  const bf16_t* Qw = Qb + (long)(wid * QBLK + r32) * ldq + hi * 8;
#pragma unroll
  for (int d0 = 0; d0 < 6; ++d0) qr[d0] = ld8(Qw + d0 * 16);
  const bool two = tid < 256;
  const int kc0 = tid, kc1 = tid + 512;
  const int kst0 = KSWZ(kc0 / 12, (kc0 % 12) * 16), kst1 = KSWZ(kc1 / 12, (kc1 % 12) * 16);
  const int vst0 = v_st(tid >> 3, (tid & 7) * 8);
  const int vb0 = (int)(uintptr_t)V_lds + v_rd_base(lane);
  bf16x8 sv0, sk0, sk1;
#define SLOAD(k0) do { sv0 = ld8(Vh + (long)(k0) * 64 + tid * 8); sk0 = ld8(Kh + (long)(k0) * 96 + kc0 * 8); if (two) sk1 = ld8(Kh + (long)(k0) * 96 + kc1 * 8); } while (0)
#define SWRITE(off) do { *(bf16x8*)((char*)V_lds + (off) + vst0) = sv0; *(bf16x8*)((char*)K_lds + (off) + kst0) = sk0; if (two) *(bf16x8*)((char*)K_lds + (off) + kst1) = sk1; } while (0)
  int o_prev = 0, o_cur = 0, o_next = SLOTB;
#define ROT() do { o_prev = o_cur; o_cur = o_next; o_next = (o_next == (NSLOT - 1) * SLOTB) ? 0 : o_next + SLOTB; } while (0)
  f32x16 pA0, pA1, pB0, pB1; bf16x8 pa0, pa1, pa2, pa3;
  if (__builtin_amdgcn_readfirstlane(wid) >= 4) __builtin_amdgcn_s_setprio(1);
  SLOAD(0); asm volatile("s_waitcnt vmcnt(0)" ::: "memory"); SWRITE(0); SLOAD(KVBLK); __syncthreads();
  qkt(pA0, pA1, K_lds, qr, r32, hi); partialSM(pA0);
  SWRITE(SLOTB); if (2 < NT) SLOAD(2 * KVBLK);
  __syncthreads(); ROT();
#define STEP(PC0, PC1, PP0, PP1, jj) do { \
    SBAR(); qkt(PC0, PC1, (bf16_t*)((char*)K_lds + o_cur), qr, r32, hi); \
    finishSM(PP0, PP1, l_reg2, pa0, pa1, pa2, pa3); SBAR(); \
    if ((jj) + 1 < NT) SWRITE(o_next); \
    if ((jj) + 2 < NT) SLOAD(((jj) + 2) * KVBLK); \
    SBAR(); pv_d0(o, vb0 + o_prev, pa0, pa1, pa2, pa3); partialSM(PC0); \
    __syncthreads(); ROT(); } while (0)
#if ATTN_HAND
  int ka[6];
#pragma unroll
  for (int d0 = 0; d0 < 6; ++d0) ka[d0] = (int)(uintptr_t)K_lds + KSWZ(r32, (d0 * 16 + hi * 8) * 2);
#define LGKM(n) asm volatile("s_waitcnt lgkmcnt(" #n ")" ::: "memory")
#define LGKMK(n, X) asm volatile("s_waitcnt lgkmcnt(" #n ")" : "+v"(X[0]), "+v"(X[1]) :: "memory")
#define LGKMV(n, X) asm volatile("s_waitcnt lgkmcnt(" #n ")" : "+v"(X[0]), "+v"(X[1]), "+v"(X[2]), "+v"(X[3]), "+v"(X[4]), "+v"(X[5]), "+v"(X[6]), "+v"(X[7]) :: "memory")
#define MF(a, b, c) __builtin_amdgcn_mfma_f32_32x32x16_bf16(a, b, c, 0, 0, 0)
#define KRD(X, d) do { const int a_ = ka[d] + o_cur; X[0] = k_read<0>(a_); X[1] = k_read<8192>(a_); } while (0)
#define QK2(X, d, PC0, PC1) do { PC0 = MF(X[0], qr[d], PC0); PC1 = MF(X[1], qr[d], PC1); asm volatile("" : "+v"(PC0), "+v"(PC1)); } while (0)
#define VRD(X, D0) do { X[0] = tr_read<v_rd_off(D0, 0, 0)>(vbp); X[1] = tr_read<v_rd_off(D0, 0, 1)>(vbp); X[2] = tr_read<v_rd_off(D0, 1, 0)>(vbp); X[3] = tr_read<v_rd_off(D0, 1, 1)>(vbp); \
                        X[4] = tr_read<v_rd_off(D0, 2, 0)>(vbp); X[5] = tr_read<v_rd_off(D0, 2, 1)>(vbp); X[6] = tr_read<v_rd_off(D0, 3, 0)>(vbp); X[7] = tr_read<v_rd_off(D0, 3, 1)>(vbp); } while (0)
#define PKV(L, H) (bf16x8){L[0], L[1], L[2], L[3], H[0], H[1], H[2], H[3]}
#define PVM(OD, X) do { OD = MF(pa0, PKV(X[0], X[1]), OD); OD = MF(pa1, PKV(X[2], X[3]), OD); OD = MF(pa2, PKV(X[4], X[5]), OD); OD = MF(pa3, PKV(X[6], X[7]), OD); } while (0)
#define P2(P, i) ((f32x2){P[2 * (i)], P[2 * (i) + 1]})
#define PK4N(P, BASE, OUT) do { u32x4 w = {cvt2n(P[BASE + 0], P[BASE + 1]), cvt2n(P[BASE + 2], P[BASE + 3]), cvt2n(P[BASE + 4], P[BASE + 5]), cvt2n(P[BASE + 6], P[BASE + 7])}; OUT = *reinterpret_cast<bf16x8*>(&w); } while (0)
#define EXPR(P, lo, hi_) do { _Pragma("unroll") for (int r = lo; r < hi_; ++r) P[r] = __builtin_amdgcn_exp2f(P[r]); } while (0)
#define HSTEP(PC0, PC1, PP0, PP1, jj) do { const int vbp = vb0 + o_prev; bf16x8 k0[2], k1[2]; s16x4 va[8], vb[8]; f32x2 t0, t1, t2, t3, sa, sb; \
    SBAR(); KRD(k0, 0); KRD(k1, 1); \
    LGKMK(2, k0); SBAR(); PC0 = MF(k0[0], qr[0], (f32x16)(0.f)); PC1 = MF(k0[1], qr[0], (f32x16)(0.f)); asm volatile("" : "+v"(PC0), "+v"(PC1)); EXPR(PP1, 0, 4); t0 = P2(PP0, 0) + P2(PP0, 1); t1 = P2(PP0, 2) + P2(PP0, 3); SBAR(); \
    KRD(k0, 2); LGKMK(2, k1); SBAR(); QK2(k1, 1, PC0, PC1); EXPR(PP1, 4, 8); t2 = P2(PP0, 4) + P2(PP0, 5); t3 = P2(PP0, 6) + P2(PP0, 7); sa = (t0 + t1) + (t2 + t3); SBAR(); \
    KRD(k1, 3); LGKMK(2, k0); SBAR(); QK2(k0, 2, PC0, PC1); EXPR(PP1, 8, 12); PK4N(PP0, 0, pa0); SBAR(); \
    KRD(k0, 4); LGKMK(2, k1); SBAR(); QK2(k1, 3, PC0, PC1); EXPR(PP1, 12, 16); PK4N(PP0, 8, pa1); SBAR(); \
    KRD(k1, 5); LGKMK(2, k0); SBAR(); QK2(k0, 4, PC0, PC1); \
      sb = ((P2(PP1, 0) + P2(PP1, 1)) + (P2(PP1, 2) + P2(PP1, 3))) + ((P2(PP1, 4) + P2(PP1, 5)) + (P2(PP1, 6) + P2(PP1, 7))); l_reg2 += sa + sb; asm volatile("" : "+v"(l_reg2)); SBAR(); \
    VRD(va, 0); LGKMK(8, k1); SBAR(); QK2(k1, 5, PC0, PC1); PK4N(PP1, 0, pa2); PK4N(PP1, 8, pa3); SBAR(); \
    LGKM(7); VRD(vb, 1); LGKMV(8, va); SBAR(); PVM(o[0], va); EXPR(PC0, 0, 8); asm volatile("" : "+v"(PC0)); SBAR(); \
    LGKMV(0, vb); SBAR(); PVM(o[1], vb); EXPR(PC0, 8, 16); asm volatile("" : "+v"(PC0)); SBAR(); \
    if ((jj) + 1 < NT) SWRITE(o_next); \
    if ((jj) + 2 < NT) SLOAD(((jj) + 2) * KVBLK); \
    __syncthreads(); ROT(); } while (0)
  for (int j = 1; j + 1 < NT; j += 2) { HSTEP(pB0, pB1, pA0, pA1, j); HSTEP(pA0, pA1, pB0, pB1, j + 1); }
  HSTEP(pB0, pB1, pA0, pA1, NT - 1);
#undef HSTEP
#undef EXPR
#undef PK4N
#undef P2
#undef PVM
#undef PKV
#undef VRD
#undef QK2
#undef KRD
#undef MF
#undef LGKM
#undef LGKMK
#undef LGKMV
#else
  for (int j = 1; j + 1 < NT; j += 2) { STEP(pB0, pB1, pA0, pA1, j); STEP(pA0, pA1, pB0, pB1, j + 1); }
  STEP(pB0, pB1, pA0, pA1, NT - 1);
#endif
  finishSM(pB0, pB1, l_reg2, pa0, pa1, pa2, pa3); SBAR();
  pv_d0(o, vb0 + o_prev, pa0, pa1, pa2, pa3);
#undef STEP
#undef ROT
  float l_reg = l_reg2[0] + l_reg2[1];
  { auto rr = __builtin_amdgcn_permlane32_swap(__float_as_uint(l_reg), __float_as_uint(l_reg), false, false); l_reg = __uint_as_float(rr[0]) + __uint_as_float(rr[1]); }
  if (hi == 0) li_l[r32] = l_reg; asm volatile("s_waitcnt lgkmcnt(0)" ::: "memory");
  float rli[16];
#pragma unroll
  for (int r = 0; r < 16; ++r) rli[r] = __builtin_amdgcn_rcpf(li_l[crow(r, hi)]);
  bf16_t* Ow = Ob + (long)(wid * QBLK) * ldo;
#pragma unroll
  for (int r = 0; r < 16; ++r) { int orow = crow(r, hi);
#pragma unroll
    for (int d0 = 0; d0 < 2; ++d0) Ow[(long)orow * ldo + d0 * 32 + r32] = (bf16_t)(cvtpk(o[d0][r] * rli[r], 0.f) & 0xffffu); }
  __builtin_amdgcn_s_setprio(0);
  __syncthreads();
#undef SLOAD
#undef SWRITE
}
#undef KSWZ
#undef SBAR
}
namespace attn16 {
typedef unsigned short bf16_t;
using bf16x8 = __attribute__((ext_vector_type(8))) short;
using s16x4  = __attribute__((ext_vector_type(4))) short;
using f32x4  = __attribute__((ext_vector_type(4))) float;
using u32x4  = __attribute__((ext_vector_type(4))) unsigned;
typedef float f32x2_t __attribute__((ext_vector_type(2))); typedef __bf16 bf16x2_t __attribute__((ext_vector_type(2))); typedef short v4i16_t __attribute__((ext_vector_type(4)));
#define A16LAS __attribute__((address_space(3)))
#define A16SBAR() __builtin_amdgcn_sched_barrier(0)
constexpr int KVBLK = 64, NSLOT = 3, KSLOT = 12288, VSLOT = 10240, VPB = 160, LDS_V0 = NSLOT * KSLOT, SHM_ATTN16 = NSLOT * (KSLOT + VSLOT);
constexpr float PSHIFT = 8.0f;
__device__ __forceinline__ unsigned cvtpk(float lo, float hi) { f32x2_t v = {lo, hi}; bf16x2_t b = __builtin_convertvector(v, bf16x2_t); return __builtin_bit_cast(unsigned, b); }
__device__ __forceinline__ bf16x8 pack8(const f32x4 a, const f32x4 b) { u32x4 w = {cvtpk(a[0], a[1]), cvtpk(a[2], a[3]), cvtpk(b[0], b[1]), cvtpk(b[2], b[3])}; return __builtin_bit_cast(bf16x8, w); }
__device__ __forceinline__ s16x4 trd(const A16LAS char* p) { return __builtin_bit_cast(s16x4, __builtin_amdgcn_ds_read_tr16_b64_v4i16((A16LAS v4i16_t*)p)); }
__device__ __forceinline__ bf16x8 ld8(const bf16_t* p) { return *reinterpret_cast<const bf16x8*>(p); }

__device__ __forceinline__ void qk16(f32x4 (&S)[4][2], const A16LAS char* ks, const bf16x8 (&qf)[2][3], int lane) {
#pragma unroll
  for (int kb = 0; kb < 4; ++kb) {
    S[kb][0] = (f32x4){-PSHIFT, -PSHIFT, -PSHIFT, -PSHIFT}; S[kb][1] = S[kb][0];
#pragma unroll
    for (int s = 0; s < 3; ++s) { const bf16x8 kf = *(const A16LAS bf16x8*)(ks + ((kb * 3 + s) * 64 + lane) * 16);
      S[kb][0] = __builtin_amdgcn_mfma_f32_16x16x32_bf16(kf, qf[0][s], S[kb][0], 0, 0, 0);
      S[kb][1] = __builtin_amdgcn_mfma_f32_16x16x32_bf16(kf, qf[1][s], S[kb][1], 0, 0, 0); } }
}
__device__ __forceinline__ void exp_half(f32x4 (&S)[4][2], int kb0) {
#pragma unroll
  for (int kb = 0; kb < 2; ++kb)
#pragma unroll
    for (int qb = 0; qb < 2; ++qb)
#pragma unroll
      for (int r = 0; r < 4; ++r) S[kb0 + kb][qb][r] = __builtin_amdgcn_exp2f(S[kb0 + kb][qb][r]);
}
__device__ __forceinline__ void finish16(f32x4 (&S)[4][2], float (&lsum)[2], bf16x8 (&pf)[2][2]) {
  exp_half(S, 2);
#pragma unroll
  for (int qb = 0; qb < 2; ++qb) { float ps = 0.f;
#pragma unroll
    for (int kb = 0; kb < 4; ++kb) ps += (S[kb][qb][0] + S[kb][qb][1]) + (S[kb][qb][2] + S[kb][qb][3]);
    lsum[qb] += ps;
    pf[qb][0] = pack8(S[0][qb], S[1][qb]); pf[qb][1] = pack8(S[2][qb], S[3][qb]); }
}
__device__ __forceinline__ void pv16(f32x4 (&o)[2][4], const A16LAS char* vp, const bf16x8 (&pf)[2][2]) {
#pragma unroll
  for (int ks = 0; ks < 2; ++ks)
#pragma unroll
    for (int db = 0; db < 4; ++db) { const s16x4 lo = trd(vp + ks * 32 * VPB + db * 32), hi = trd(vp + ks * 32 * VPB + 16 * VPB + db * 32);
      const bf16x8 vf = {lo[0], lo[1], lo[2], lo[3], hi[0], hi[1], hi[2], hi[3]};
      o[0][db] = __builtin_amdgcn_mfma_f32_16x16x32_bf16(pf[0][ks], vf, o[0][db], 0, 0, 0);
      o[1][db] = __builtin_amdgcn_mfma_f32_16x16x32_bf16(pf[1][ks], vf, o[1][db], 0, 0, 0); }
}
__device__ __forceinline__ void attn_body16(int tid_in, const bf16_t* __restrict__ Qb, int ldq, const bf16_t* __restrict__ Kh, const bf16_t* __restrict__ Vh,
                                            bf16_t* __restrict__ Ob, int ldo, int NT, char* lds) {
  int tid_ = tid_in; asm volatile("" : "+v"(tid_));
  const int tid = tid_, wid = tid >> 6, lane = tid & 63, r16 = lane & 15, quad = lane >> 4;
  A16LAS char* L3 = (A16LAS char*)lds;
  const A16LAS char* K3 = L3; const A16LAS char* V3 = L3 + LDS_V0 + (4 * quad + (r16 >> 2)) * VPB + (r16 & 3) * 8;
  bf16x8 qf[2][3];
#pragma unroll
  for (int qb = 0; qb < 2; ++qb)
#pragma unroll
    for (int s = 0; s < 3; ++s) qf[qb][s] = ld8(Qb + (long)(wid * 32 + 16 * qb + r16) * ldq + 32 * s + 8 * quad);
  const bool two = tid < 256;
  const int kc0 = tid, kc1 = tid + 512;
  const int kst0 = ((((kc0 / 12) >> 4) * 3 + ((kc0 % 12) >> 2)) * 64 + ((kc0 / 12) & 15) + 16 * ((kc0 % 12) & 3)) * 16;
  const int kst1 = ((((kc1 / 12) >> 4) * 3 + ((kc1 % 12) >> 2)) * 64 + ((kc1 / 12) & 15) + 16 * ((kc1 % 12) & 3)) * 16;
  const int vst0 = LDS_V0 + (tid >> 3) * VPB + (tid & 7) * 16;
  bf16x8 sv0, sk0, sk1;
#define SLOAD(k0) do { sv0 = ld8(Vh + (long)(k0) * 64 + tid * 8); sk0 = ld8(Kh + (long)(k0) * 96 + kc0 * 8); if (two) sk1 = ld8(Kh + (long)(k0) * 96 + kc1 * 8); } while (0)
#define SWRITE(sl) do { *(A16LAS bf16x8*)(L3 + (sl) * VSLOT + vst0) = sv0; *(A16LAS bf16x8*)(L3 + (sl) * KSLOT + kst0) = sk0; if (two) *(A16LAS bf16x8*)(L3 + (sl) * KSLOT + kst1) = sk1; } while (0)
  int s_prev = 0, s_cur = 0, s_next = 1;
#define ROT() do { s_prev = s_cur; s_cur = s_next; s_next = (s_next == NSLOT - 1) ? 0 : s_next + 1; } while (0)
  f32x4 sA[4][2], sB[4][2], o[2][4]; bf16x8 pf[2][2]; float lsum[2] = {0.f, 0.f};
#pragma unroll
  for (int qb = 0; qb < 2; ++qb)
#pragma unroll
    for (int db = 0; db < 4; ++db) o[qb][db] = (f32x4){0.f, 0.f, 0.f, 0.f};
  SLOAD(0); asm volatile("s_waitcnt vmcnt(0)" ::: "memory"); SWRITE(0); SLOAD(KVBLK); __syncthreads();
  qk16(sA, K3, qf, lane); exp_half(sA, 0);
  SWRITE(1); if (2 < NT) SLOAD(2 * KVBLK);
  __syncthreads(); ROT();
#define STEP(SC, SP, jj) do { \
    A16SBAR(); qk16(SC, K3 + s_cur * KSLOT, qf, lane); finish16(SP, lsum, pf); A16SBAR(); \
    if ((jj) + 1 < NT) SWRITE(s_next); \
    if ((jj) + 2 < NT) SLOAD(((jj) + 2) * KVBLK); \
    A16SBAR(); pv16(o, V3 + s_prev * VSLOT, pf); exp_half(SC, 0); \
    __syncthreads(); ROT(); } while (0)
  for (int j = 1; j + 1 < NT; j += 2) { STEP(sB, sA, j); STEP(sA, sB, j + 1); }
  STEP(sB, sA, NT - 1);
  finish16(sB, lsum, pf); A16SBAR();
  pv16(o, V3 + s_prev * VSLOT, pf);
#undef STEP
#undef ROT
  bf16_t* Ow = Ob + (long)(wid * 32) * ldo;
#pragma unroll
  for (int qb = 0; qb < 2; ++qb) { float l = lsum[qb]; l += __shfl_xor(l, 16); l += __shfl_xor(l, 32);
#pragma unroll
    for (int r = 0; r < 4; ++r) { const float rl = __builtin_amdgcn_rcpf(__shfl(l, 4 * quad + r)); const long orow = 16 * qb + 4 * quad + r;
#pragma unroll
      for (int db = 0; db < 4; ++db) Ow[orow * ldo + 16 * db + r16] = (bf16_t)(cvtpk(o[qb][db][r] * rl, 0.f) & 0xffffu); } }
  __syncthreads();
#undef SLOAD
#undef SWRITE
}
#undef A16SBAR
}
#define GAS __attribute__((address_space(1)))
#define LAS __attribute__((address_space(3)))
typedef unsigned short bf16_t;
typedef float f32x4 __attribute__((ext_vector_type(4)));
typedef unsigned u32x4 __attribute__((ext_vector_type(4)));
typedef unsigned u32x2 __attribute__((ext_vector_type(2)));
typedef int i32x2 __attribute__((ext_vector_type(2)));
typedef short bf16x8 __attribute__((ext_vector_type(8)));
#define LDS_WAIT() asm volatile("s_waitcnt lgkmcnt(0)" ::: "memory")
__device__ __forceinline__ float bf2f(unsigned short h) { return __uint_as_float(((unsigned)h) << 16); }
__device__ __forceinline__ unsigned short f2bf(float f) { return (unsigned short)(pg8::cvt_pk_bf16(f, 0.f) & 0xffffu); }
__device__ __forceinline__ float wave_sum(float v) {
#pragma unroll
    for (int o = 1; o < 64; o <<= 1) v += __shfl_xor(v, o);
    return v;
}
__device__ __forceinline__ float gelu_tanh(float x) { const float z = 0.7978845608028654f * (x + 0.044715f * x * x * x); return x / (1.0f + __expf(-2.0f * z)); }

__device__ __forceinline__ int hw_tid(int wid0) { int ln; asm volatile("v_mbcnt_lo_u32_b32 %0, -1, 0\n\tv_mbcnt_hi_u32_b32 %0, -1, %0" : "=v"(ln)); return wid0 * 64 + ln; }
#define XB_TMO      128
#define XB_XCNT(j)  (256  + 64 * (j))
#define XB_XSUB(j)  (1280 + 64 * (j))
#define XB_XGEN(j)  (2304 + 64 * (j))
#define XB_TOP      3328
#define XB_TOPGEN   3392
#define XCD_BAR_WORDS 3456
#define XB_SPIN_CAP (1u << 18)
__device__ __forceinline__ unsigned xb_ld(unsigned* p)              { return __hip_atomic_load(p, __ATOMIC_RELAXED, __HIP_MEMORY_SCOPE_AGENT); }
__device__ __forceinline__ unsigned xb_add(unsigned* p, unsigned v) { return __hip_atomic_fetch_add(p, v, __ATOMIC_RELAXED, __HIP_MEMORY_SCOPE_AGENT); }
__device__ __forceinline__ unsigned xb_xcc_id() { return (unsigned)__builtin_amdgcn_s_getreg((3 << 11) | 20) & 0xFu; }
#define XB_SPIN(cond, bar) do { unsigned _sp = 0; while (cond) { __builtin_amdgcn_s_sleep(1); \
    if ((++_sp & 255u) == 0u) { if (xb_ld(&(bar)[XB_TMO])) break; if (_sp > XB_SPIN_CAP) { atomicAdd(&(bar)[XB_TMO], 1u); break; } } } } while (0)
struct XcdBarrier { unsigned* bar; unsigned x; volatile LAS unsigned* st; };
__device__ __forceinline__ XcdBarrier xcd_barrier_post(unsigned* bar, volatile LAS unsigned* st, bool t0) {
    XcdBarrier b; b.bar = bar; b.x = xb_xcc_id(); b.st = st;
    if (t0) (void)xb_add(&bar[XB_XCNT(b.x)], 1u);
    return b;
}
__device__ __forceinline__ void xcd_barrier_complete(unsigned* bar, unsigned x, unsigned& nloc, unsigned& nx) {
    const unsigned G = gridDim.x * gridDim.y * gridDim.z;
    unsigned sum, cnt, mine, sp = 0u;
    for (;;) {
        sum = 0u; cnt = 0u; mine = 0u;
#pragma unroll
        for (unsigned j = 0; j < 16; ++j) { const unsigned c = xb_ld(&bar[XB_XCNT(j)]); sum += c; cnt += (c > 0u) ? 1u : 0u; mine = (j == x) ? c : mine; }
        if (sum == G) break;
        __builtin_amdgcn_s_sleep(1);
        if ((++sp & 255u) == 0u) { if (xb_ld(&bar[XB_TMO])) break; if (sp > XB_SPIN_CAP) { atomicAdd(&bar[XB_TMO], 1u); break; } }
    }
    nloc = mine > 0u ? mine : 1u; nx = cnt > 0u ? cnt : 1u;
}
__device__ __forceinline__ void xcd_barrier(const XcdBarrier& b, bool t0) {
    asm volatile("s_waitcnt vmcnt(0)" ::: "memory");
    __syncthreads();
    if (t0) {
        unsigned* bar = b.bar;
        __builtin_amdgcn_s_waitcnt(0);
        unsigned nloc = b.st[0], nx = b.st[1];
        if (nloc == 0u) { xcd_barrier_complete(bar, b.x, nloc, nx); b.st[0] = nloc; b.st[1] = nx; }
        const unsigned old = xb_add(&bar[XB_XSUB(b.x)], 1u);
        const unsigned gen = old / nloc;
        if (old + 1u == (gen + 1u) * nloc) {
            __builtin_amdgcn_fence(__ATOMIC_RELEASE, "agent");
            asm volatile("s_waitcnt vmcnt(0)" ::: "memory");
            const unsigned og = xb_add(&bar[XB_TOP], 1u);
            const unsigned tg = og / nx;
            if (og + 1u == (tg + 1u) * nx) xb_add(&bar[XB_TOPGEN], 1u);
            else XB_SPIN(xb_ld(&bar[XB_TOPGEN]) == tg, bar);
            __builtin_amdgcn_fence(__ATOMIC_ACQUIRE, "agent");
            xb_add(&bar[XB_XGEN(b.x)], 1u);
            asm volatile("s_waitcnt vmcnt(0)" ::: "memory");
        } else {
            XB_SPIN(xb_ld(&bar[XB_XGEN(b.x)]) == gen, bar);
            __builtin_amdgcn_fence(__ATOMIC_ACQUIRE, "agent");
            asm volatile("s_waitcnt vmcnt(0)" ::: "memory");
        }
    }
    __syncthreads();
}

constexpr int TR_SCR = 64 * 65 * 4;
template <class MAP>
__device__ __forceinline__ void transpose_item(const float* W, int K, int N, bf16_t* WT, LAS float* scr, int item, int lane, const MAP& map, const float* kscale = nullptr, int ldt = 0, int koff = 0) {
    const int kblk = K / 64, nb = item / kblk, kb = item - nb * kblk, k0 = 64 * kb, n0 = 64 * nb;
    const int kr = lane >> 4, nq = 4 * (lane & 15); const bool ok = n0 + nq < N;
    f32x4 v[16];
#pragma unroll
    for (int i = 0; i < 16; ++i) v[i] = (f32x4){0.f, 0.f, 0.f, 0.f};
    if (ok) {
        const float* src = W + (size_t)(k0 + kr) * N + n0 + nq;
#pragma unroll
        for (int i = 0; i < 16; ++i) v[i] = *(const f32x4*)(src + (size_t)(4 * i) * N);
    }
#pragma unroll
    for (int i = 0; i < 16; ++i) asm volatile("" : "+v"(v[i]));
#pragma unroll
    for (int i = 0; i < 16; ++i) { const int k = 4 * i + kr; f32x4 x = v[i]; if (kscale) x = x * kscale[k0 + k];
        LAS float* d = scr + k * 65 + nq; d[0] = x[0]; d[1] = x[1]; d[2] = x[2]; d[3] = x[3]; }
    LDS_WAIT(); asm volatile("" ::: "memory");
    const int c = lane & 7;
#pragma unroll
    for (int j = 0; j < 8; ++j) { const int n = (lane >> 3) + 8 * j; const LAS float* s = scr + (8 * c) * 65 + n;
        u32x4 o; o.x = pg8::cvt_pk_bf16(s[0 * 65], s[1 * 65]); o.y = pg8::cvt_pk_bf16(s[2 * 65], s[3 * 65]); o.z = pg8::cvt_pk_bf16(s[4 * 65], s[5 * 65]); o.w = pg8::cvt_pk_bf16(s[6 * 65], s[7 * 65]);
        const int dr = (n0 + n < N) ? map(n0 + n) : -1;
        if (dr >= 0) *(u32x4*)(WT + (size_t)dr * (ldt ? ldt : K) + koff + k0 + 8 * c) = o; }
    LDS_WAIT(); asm volatile("" ::: "memory");
}
struct MapId { int off; __device__ __forceinline__ int operator()(int n) const { return n + off; } };
struct MapIn { __device__ __forceinline__ int operator()(int n) const { if (n < 1440) return n < 1152 ? n : n < 1408 ? n + 128 : n - 256;
    const int g = n - 1440, c = g & 255; return 1536 + (g & ~255) + ((c >> 3) & 1) * 128 + (c >> 6) * 32 + ((c >> 4) & 3) * 8 + (c & 7); } };
struct MapUq { __device__ __forceinline__ int operator()(int n) const { const int h = n / 96, d = n - h * 96;
    return d < 64 ? 256 * (h >> 2) + 128 * (d >> 5) + 32 * (h & 3) + (d & 31) : 512 + 128 * (h >> 2) + 32 * (h & 3) + (d - 64); } };
struct MapUkv { __device__ __forceinline__ int operator()(int n) const { const int h = n >> 7, d = n & 127;
    return d < 64 ? 256 * (h >> 1) + 128 * (d >> 5) + 32 * (h & 1) + (d & 31) : 256 * (h >> 1) + 128 * ((d - 64) >> 5) + 32 * (2 + (h & 1)) + ((d - 64) & 31); } };
struct MapGU { int base; __device__ __forceinline__ int operator()(int d) const { return base + 256 * (d >> 7) + (d & 127); } };

__device__ __forceinline__ void rms_mod_store(const f32x4 (&v)[4], const float* g, const float* sh, const float* sc, bf16_t* orow, int lane) {
    float ss = 0.f;
#pragma unroll
    for (int j = 0; j < 4; ++j) ss += pg8::dot4(v[j]);
    const float r = rsqrtf(wave_sum(ss) * (1.0f / DM) + EPS);
#pragma unroll
    for (int j = 0; j < 4; ++j) { const int col = 4 * lane + 256 * j;
        const f32x4 gg = *(const f32x4*)(g + col), s1 = *(const f32x4*)(sc + col), s0 = *(const f32x4*)(sh + col);
        const f32x4 h = v[j] * r * gg * (1.0f + s1) + s0;
        u32x2 w; w.x = pg8::cvt_pk_bf16(h[0], h[1]); w.y = pg8::cvt_pk_bf16(h[2], h[3]);
        *(u32x2*)(orow + col) = w; }
}
constexpr int NWAVES = 8;
#ifndef MK_N_LAUNCHES
#define MK_N_LAUNCHES 1
#endif
constexpr int N_PHASES = 24;
#ifndef ATTN_SHAPE16
#define ATTN_SHAPE16 0
#endif
#if ATTN_SHAPE16
#define ATTN_BODY attn16::attn_body16
#else
#define ATTN_BODY attn::attn_dense_body
#endif
#ifndef REP_A
#define REP_A 1
#endif
#ifndef REP_D
#define REP_D 1
#endif
#ifndef REP_M
#define REP_M 1
#endif
#ifndef REP_E
#define REP_E 1
#endif
#ifndef REP_C
#define REP_C 1
#endif
#ifndef REP_F
#define REP_F 1
#endif
#ifndef REP_P
#define REP_P 1
#endif
#ifndef REP_B
#define REP_B 1
#endif
#ifndef REP_G
#define REP_G 1
#endif
#ifndef REP_H
#define REP_H 1
#endif
#ifndef REP_K
#define REP_K 1
#endif
#ifndef PHM
#define PHM 0xffff
#endif
#define PH_EN(k) (((PHM) >> (k)) & 1)
struct Args { const float* in[30]; float* out; unsigned char* ws; int ph_lo, ph_hi; };
static_assert(sizeof(Args) == 30 * 8 + 8 + 8 + 8, "Args has no padding");
enum { I_X = 0, I_C, I_CTX, I_CCTX, I_WMOD, I_BMOD, I_N1G, I_N2G, I_WIN, I_POOLW, I_POOLS, I_SGUNG, I_SGUWS, I_SGUB, I_QANG, I_WUQ, I_KVANG, I_WUKV, I_QNG, I_KNG,
       I_WBP, I_WBS, I_WBM, I_BGATE, I_WOUT, I_RW, I_RB, I_WEG, I_WEU, I_WED };

__device__ __forceinline__ void row_bk(int row, int& b, int& key) { if (row < NLAT) { b = row >> 13; key = row & (SEQ - 1); } else { const int r2 = row - NLAT; b = r2 >> 8; key = SEQ + (r2 & 255); } }

__global__ void __launch_bounds__(NWAVES * 64, 2) mk_fwd(Args args) {
    extern __shared__ __attribute__((aligned(16))) unsigned char lds[];
    LAS unsigned char* L = (LAS unsigned char*)lds;
    volatile LAS unsigned* MISC = (volatile LAS unsigned*)(L + MISC_OFF);
    const int wid0 = __builtin_amdgcn_readfirstlane((int)threadIdx.x >> 6);
    const int G = gridDim.x, bx = blockIdx.x;
    const int vcu = (G % 8 == 0) ? (bx % 8) * (G / 8) + bx / 8 : bx;
    const int NGW = G * NWAVES;
#define PH_BEGIN() \
    int tid = hw_tid(wid0); int zs = 0; asm volatile("" : "+v"(tid), "+s"(zs)); \
    const int lane = tid & 63, wid = __builtin_amdgcn_readfirstlane(tid >> 6), gw = vcu * NWAVES + wid; (void)lane; (void)gw; \
    const float* const* in = args.in + zs; unsigned char* ws = args.ws + zs; float* OUT = args.out + zs; (void)in; (void)OUT; \
    unsigned* ctl = (unsigned*)(ws + WS_CTL); (void)ctl; \
    float* MOD = (float*)(ws + WS_MOD); float* cosT = (float*)(ws + WS_ROPE); float* sinT = cosT + 1024; (void)MOD; (void)sinT; \
    u32x4* RT = (u32x4*)(ws + WS_RT); i32x2* POS = (i32x2*)(ws + WS_POS); float* XC = (float*)(ws + WS_XC); (void)RT; (void)POS; (void)XC; \
    bf16_t* XN = (bf16_t*)(ws + WS_XN); bf16_t* Qb = XN; bf16_t* MG = XN; (void)Qb; (void)MG; \
    bf16_t* Kb = (bf16_t*)(ws + WS_K); bf16_t* Vb = (bf16_t*)(ws + WS_V); (void)Kb; (void)Vb; \
    bf16_t* PROJ = (bf16_t*)(ws + WS_PROJ); bf16_t* XS = (bf16_t*)(ws + WS_XS); bf16_t* ACT = (bf16_t*)(ws + WS_ACT); (void)PROJ; (void)XS; (void)ACT; \
    bf16_t* X1B = (bf16_t*)(ws + WS_K); (void)X1B;     \
    bf16_t* WGU = (bf16_t*)(ws + WS_WGU); bf16_t* WDN = (bf16_t*)(ws + WS_WDN); (void)WGU; (void)WDN; \
    unsigned char* wl = ws + WS_W + (size_t)l * W_LAYER; (void)wl; \
    const float* MODL = MOD + (size_t)l * 5 * 6 * DM; (void)MODL;
    for (int u = hw_tid(wid0); u < (LDS_BYTES - MISC_OFF) / 4; u += NWAVES * 64) MISC[u] = 0u;
    __syncthreads();
    unsigned* const barw = (unsigned*)(args.ws + WS_CTL) + CW_BAR;
    XcdBarrier bar; bar.bar = barw; bar.x = 0; bar.st = nullptr;
    if (MK_N_LAUNCHES == 1) bar = xcd_barrier_post(barw, MISC + 8, hw_tid(wid0) == 0);
#define GRID_BAR() do { if (MK_N_LAUNCHES == 1) xcd_barrier(bar, hw_tid(wid0) == 0); } while (0)
    const int lo = args.ph_lo, hi = args.ph_hi;
#define IN(k) (lo <= (k) && (k) < hi)
#define BOTH(k) (IN(k) && IN((k) + 1))

    if (PH_EN(0) && IN(0)) { const int l = 0; PH_BEGIN()
_Pragma("unroll 1")
      for (int rep = 0; rep < REP_P; ++rep) {
        {
            LAS float* SC = (LAS float*)L; LAS float* RED = (LAS float*)(L + 32768);
            for (int i = tid; i < 5 * DM; i += 512) { const int r = i >> 10, k = i & 1023; const float cv = r < 4 ? in[I_C][r * DM + k] : in[I_CCTX][k]; SC[i] = cv / (1.0f + __expf(-cv)); }
            __syncthreads();
            for (int it = vcu; it < 192; it += G) {
                const int l2 = it / 96, cb = it % 96, col = 64 * cb + lane; const float* W = in[I_WMOD] + (size_t)l2 * DM * 6 * DM;
                float a0 = 0.f, a1 = 0.f, a2 = 0.f, a3 = 0.f, a4 = 0.f;
#pragma unroll 8
                for (int kk = 0; kk < 128; ++kk) { const int k = wid * 128 + kk; const float w = W[(size_t)k * (6 * DM) + col];
                    a0 += SC[k] * w; a1 += SC[DM + k] * w; a2 += SC[2 * DM + k] * w; a3 += SC[3 * DM + k] * w; a4 += SC[4 * DM + k] * w; }
                RED[(wid * 5 + 0) * 64 + lane] = a0; RED[(wid * 5 + 1) * 64 + lane] = a1; RED[(wid * 5 + 2) * 64 + lane] = a2; RED[(wid * 5 + 3) * 64 + lane] = a3; RED[(wid * 5 + 4) * 64 + lane] = a4;
                __syncthreads();
                if (tid < 320) { const int r = tid >> 6, cl = tid & 63; float s = 0.f;
#pragma unroll
                    for (int w = 0; w < 8; ++w) s += RED[(w * 5 + r) * 64 + cl];
                    MOD[(size_t)(l2 * 5 + r) * (6 * DM) + 64 * cb + cl] = s + in[I_BMOD][l2 * 6 * DM + 64 * cb + cl]; }
                __syncthreads();
            }
        }
        if (bx == 0) { for (int i = tid; i < 1024; i += 512) { const int p = i >> 3, f = i & 7; const float inv = powf(10000.0f, -((float)f * 2.0f / 16.0f)); const float ang = (float)p * inv; cosT[i] = cosf(ang); sinT[i] = sinf(ang); } }
        {
            __syncthreads();
            LAS float* scr = (LAS float*)(L + wid * TR_SCR);
            constexpr int I_IN = 16 * 71, I_UQ = 6 * 12, I_UKV = 4 * 16, I_BP = 4 * 16, I_BS = 4 * 16, I_BM = 8 * 16, I_OUT = 16 * 16, I_L = I_IN + I_UQ + I_UKV + I_BP + I_BS + I_BM + I_OUT;
            for (int it = gw; it < 2 * I_L; it += NGW) {
                const int l2 = it / I_L; int r = it - l2 * I_L; unsigned char* wl2 = ws + WS_W + (size_t)l2 * W_LAYER;
                if (r < I_IN) { transpose_item(in[I_WIN] + (size_t)l2 * DM * INW_SRC, DM, INW_SRC, (bf16_t*)(wl2 + W_IN), scr, r, lane, MapIn{}); continue; } r -= I_IN;
                if (r < I_UQ) { transpose_item(in[I_WUQ] + (size_t)l2 * QLORA * 768, QLORA, 768, (bf16_t*)(wl2 + W_UQ), scr, r, lane, MapUq{}, in[I_QANG] + l2 * QLORA); continue; } r -= I_UQ;
                if (r < I_UKV) { transpose_item(in[I_WUKV] + (size_t)l2 * KVLORA * 1024, KVLORA, 1024, (bf16_t*)(wl2 + W_UKV), scr, r, lane, MapUkv{}, in[I_KVANG] + l2 * KVLORA); continue; } r -= I_UKV;
                if (r < I_BP) { transpose_item(in[I_WBP] + (size_t)l2 * 256 * DM, 256, DM, (bf16_t*)(wl2 + W_BP) + (size_t)1 * DM * 256, scr, r, lane, MapId{0}); continue; } r -= I_BP;
                if (r < I_BS) { transpose_item(in[I_WBS] + (size_t)l2 * 256 * DM, 256, DM, (bf16_t*)(wl2 + W_BP), scr, r, lane, MapId{0}); continue; } r -= I_BS;
                if (r < I_BM) { const int hf = r >= I_BM / 2 ? 1 : 0; transpose_item(in[I_WBM] + (size_t)l2 * 512 * DM + (size_t)hf * 256 * DM, 256, DM, (bf16_t*)(wl2 + W_BP) + (size_t)(2 + hf) * DM * 256, scr, r - hf * (I_BM / 2), lane, MapId{0}); continue; } r -= I_BM;
                transpose_item(in[I_WOUT] + (size_t)l2 * DM * DM, DM, DM, (bf16_t*)(wl2 + W_OUT), scr, r, lane, MapId{0});
            }
            for (int i = (bx * 512 + tid); i < 2 * 96 * 128; i += G * 512) { const int l2 = i / (96 * 128), r = i % (96 * 128);
                *(u32x4*)(ws + WS_W + (size_t)l2 * W_LAYER + W_IN + (size_t)C_PAD * DM * 2 + (size_t)r * 16) = (u32x4){0u, 0u, 0u, 0u}; }
        }
      }
        if (BOTH(0)) GRID_BAR();
    }
    if (PH_EN(1) && IN(1)) { const int l = 0; PH_BEGIN()
_Pragma("unroll 1")
      for (int rep = 0; rep < REP_P; ++rep)
      {
        f32x4 vn[4];
#pragma unroll
        for (int j = 0; j < 4; ++j) vn[j] = (f32x4){0.f, 0.f, 0.f, 0.f};
#define P1_XR(r_) ((r_) < NLAT ? in[I_X] + (size_t)(r_) * DM : in[I_CTX] + (size_t)((r_) - NLAT) * DM)
        if (gw < MROWS) { const float* xr = P1_XR(gw);
#pragma unroll
            for (int j = 0; j < 4; ++j) vn[j] = *(const f32x4*)(xr + 4 * lane + 256 * j); }
        for (int row = gw; row < MROWS; row += NGW) {
            const int mrow = row < NLAT ? (row >> 13) : 4;
            f32x4 v[4];
#pragma unroll
            for (int j = 0; j < 4; ++j) v[j] = vn[j];
            if (row + NGW < MROWS) { const float* xr = P1_XR(row + NGW);
#pragma unroll
                for (int j = 0; j < 4; ++j) vn[j] = *(const f32x4*)(xr + 4 * lane + 256 * j); }
            const float* md = MOD + (size_t)mrow * (6 * DM);
            rms_mod_store(v, in[I_N1G], md, md + DM, XN + (size_t)row * DM, lane);
        }
#undef P1_XR
      }
        {
            bf16_t* WRH = (bf16_t*)(ws + WS_WR); bf16_t* WRL = WRH + 2 * 5 * NE * DM; float* CB = (float*)(ws + WS_CB);
            for (int i = bx * 512 + tid; i < 2 * 5 * NE * DM; i += G * 512) { const int k = i & (DM - 1), e = (i >> 10) & 15, lb = i >> 14, l2 = lb / 5;
                const float w = in[I_N2G][l2 * DM + k] * (1.0f + MOD[(size_t)lb * (6 * DM) + 4 * DM + k]) * in[I_RW][k * NE + e];
                const unsigned short h = f2bf(w); WRH[i] = h; WRL[i] = f2bf(w - bf2f(h)); }
            for (int it = gw; it < 2 * 5 * NE; it += NGW) { const int e = it & 15, lb = it >> 4; float p = 0.f;
#pragma unroll 4
                for (int j = 0; j < 16; ++j) { const int k = lane + 64 * j; p += MOD[(size_t)lb * (6 * DM) + 3 * DM + k] * in[I_RW][k * NE + e]; }
                p = wave_sum(p); if (lane == 0) CB[it] = p; }
        }
        if (BOTH(1)) GRID_BAR();
    }

    for (int l = 0; l < DEPTH; ++l) {
        const int pb = 2 + 11 * l;
        const int Mq = (l == 0) ? MROWS : NLAT;
        if (PH_EN(2) && IN(pb + 0)) { PH_BEGIN()
            pg8::Gemm g{XN, (const bf16_t*)(wl + W_IN), DM, DM}; pg8::StaticOrder S; S.init(MROWS, INW, G, bx);
            pg8::EpiInProj E{PROJ, in[I_BGATE] + l * 3 * DM, (float*)(ws + WS_RKV), Kb, in[I_KNG] + l * QKH + 64, cosT, sinT};
_Pragma("unroll 1")
            for (int rep = 0; rep < REP_A; ++rep) pg8::gemm_phase(L, tid, g, S, E);
#if defined(REP_ANULL)
            { pg8::EpiNull EN; pg8::gemm_phase(L, tid, g, S, EN); }
#endif
            if (BOTH(pb + 0)) GRID_BAR();
        }
        if (PH_EN(3) && IN(pb + 1)) { PH_BEGIN()
_Pragma("unroll 1")
            for (int rep = REP_B - 1; rep >= 0; --rep) {
            {
                typedef float f32x16 __attribute__((ext_vector_type(16)));
                const int nchunks = 256 + (l == 0 ? 8 : 0);
                const int ch_ = tid & 255, half = __builtin_amdgcn_readfirstlane(wid >> 2), g4 = __builtin_amdgcn_readfirstlane(wid & 3);
                constexpr int VTP = 136, DBP = 264;
                LAS unsigned short* VT = (LAS unsigned short*)L;
                LAS float* PART = (LAS float*)(L + MISC_OFF + 1024);
                LAS float* RS = (LAS float*)(L + MISC_OFF + 3072);
                LAS unsigned short* PT = (LAS unsigned short*)L;
                LAS unsigned short* DB = (LAS unsigned short*)(L + 73728);
                const float* sgn = in[I_SGUNG] + l * 256; const float* swp = in[I_SGUWS] + (size_t)l * 4 * 128 * 128 + (size_t)g4 * 128 * 128; const float* sbp = in[I_SGUB] + l * 4 * 128 + g4 * 128;
                const float* pwp = in[I_POOLW] + (size_t)l * 4 * 64 * 64 + (size_t)g4 * 64 * 64;
                const int r32 = lane & 31, hi = lane >> 5;
                for (int ck = vcu; ck < nchunks; ck += G) {
                    int ch = ch_; asm volatile("" : "+v"(ch));
                    int row0, seq0, n, t0;
                    if (ck < 256) { row0 = ck * 128; seq0 = (ck >> 6) * SEQ; n = SEQ; t0 = (ck & 63) * 128; }
                    else { const int cc = ck - 256, b_ = cc >> 1; seq0 = NLAT + b_ * CTXL; n = CTXL; t0 = (cc & 1) * 128; row0 = seq0 + t0; }
                    __syncthreads();
                    {
                        float gv[64];
#pragma unroll
                        for (int jj = 0; jj < 64; ++jj) gv[jj] = gelu_tanh(bf2f(PROJ[(size_t)(row0 + half * 64 + jj) * INW + C_V + ch]));
#pragma unroll
                        for (int jj = 0; jj < 64; ++jj) { const float s = wave_sum(gv[jj] * gv[jj]); if (lane == 0) PART[g4 * 128 + half * 64 + jj] = s; }
                        __syncthreads();
                        if (tid < 128) RS[tid] = rsqrtf(((PART[tid] + PART[128 + tid]) + (PART[256 + tid] + PART[384 + tid])) * (1.0f / 256.0f) + EPS);
                        __syncthreads();
                        const float gn = sgn[ch];
#pragma unroll
                        for (int q = 0; q < 8; ++q) { f32x4 a, b;
#pragma unroll
                            for (int e = 0; e < 4; ++e) { a[e] = gv[8 * q + e] * RS[half * 64 + 8 * q + e] * gn; b[e] = gv[8 * q + 4 + e] * RS[half * 64 + 8 * q + 4 + e] * gn; }
                            *(LAS u32x4*)(VT + ch * VTP + half * 64 + 8 * q) = pg8::pack8(a, b); }
                    }
                    __syncthreads();
                    {
#pragma unroll 1
                        for (int it = 0; it < 2; ++it) { const int i0 = half * 64 + it * 32;
                            bf16x8 af[8];
#pragma unroll
                            for (int s8 = 0; s8 < 8; s8 += 4) {
                                f32x4 wa[4], wb[4];
#pragma unroll
                                for (int q = 0; q < 4; ++q) { const float* ap = swp + (i0 + r32) * 128 + 16 * (s8 + q) + 8 * hi; wa[q] = *(const f32x4*)ap; wb[q] = *(const f32x4*)(ap + 4); }
#pragma unroll
                                for (int q = 0; q < 4; ++q) { asm volatile("" : "+v"(wa[q])); asm volatile("" : "+v"(wb[q])); }
#pragma unroll
                                for (int q = 0; q < 4; ++q) { const u32x4 w = pg8::pack8(wa[q], wb[q]); af[s8 + q] = __builtin_bit_cast(bf16x8, w); } }
#pragma unroll 1
                            for (int ct = 0; ct < 2; ++ct) { const int c0 = ct * 32; f32x16 acc = {};
#pragma unroll
                                for (int s8 = 0; s8 < 8; ++s8) { const bf16x8 bfr = *(const LAS bf16x8*)(VT + (g4 * 64 + c0 + r32) * VTP + 16 * s8 + 8 * hi); acc = __builtin_amdgcn_mfma_f32_32x32x16_bf16(af[s8], bfr, acc, 0, 0, 0); }
                                int uv[16]; float sb[16];
#pragma unroll
                                for (int rg = 0; rg < 16; ++rg) { const int i = i0 + (rg & 3) + 8 * (rg >> 2) + 4 * hi; uv[rg] = PROJ[(size_t)(row0 + i) * INW + C_U + g4 * 64 + c0 + r32]; sb[rg] = sbp[i]; }
#pragma unroll
                                for (int rg = 0; rg < 16; ++rg) { asm volatile("" : "+v"(uv[rg])); asm volatile("" : "+v"(sb[rg])); }
#pragma unroll
                                for (int rg = 0; rg < 16; ++rg) { const int i = i0 + (rg & 3) + 8 * (rg >> 2) + 4 * hi; const float mixed = acc[rg] + sb[rg];
                                    bf16_t* up = PROJ + (size_t)(row0 + i) * INW + C_U + g4 * 64 + c0 + r32; bf16_t* uw = (REP_B > 1 && rep > 0) ? XN + (size_t)(row0 + i) * DM + 640 + g4 * 64 + c0 + r32 : up; *uw = f2bf(gelu_tanh(bf2f((unsigned short)uv[rg])) * mixed); }
                            }
                        }
                    }
                    __syncthreads();
#pragma unroll
                    for (int q0 = 0; q0 < 72; q0 += 24) { int pv[24];
#pragma unroll
                        for (int q = 0; q < 24; ++q) { const int t = t0 - 8 + half + 2 * (q0 + q); const int tc = t < 0 ? 0 : (t < n ? t : n - 1); pv[q] = PROJ[(size_t)(seq0 + tc) * INW + C_P + ch]; }
#pragma unroll
                        for (int q = 0; q < 24; ++q) asm volatile("" : "+v"(pv[q]));
#pragma unroll
                        for (int q = 0; q < 24; ++q) { const int rr = half + 2 * (q0 + q), t = t0 - 8 + rr; PT[rr * 256 + ch] = (t >= 0 && t < n) ? (unsigned short)pv[q] : (unsigned short)0; } }
                    __syncthreads();
                    {
                        const int w2 = 1 << g4, i0 = half * 64; float s = 0.f;
                        for (int k = -w2; k < w2; ++k) s += bf2f(PT[(i0 + 8 + k) * 256 + ch]);
#pragma unroll 16
                        for (int jj = 0; jj < 64; ++jj) { const int i = i0 + jj, t = t0 + i; const int tlo = (t - w2 > 0) ? t - w2 : 0, thi = (t + w2 < n) ? t + w2 : n;
                            DB[i * DBP + ch] = f2bf(s / (float)(thi - tlo) - bf2f(PT[(i + 8) * 256 + ch]));
                            s += bf2f(PT[(i + 8 + w2) * 256 + ch]) - bf2f(PT[(i + 8 - w2) * 256 + ch]); }
                    }
                    __syncthreads();
                    {
#pragma unroll 1
                        for (int dt = 0; dt < 2; ++dt) { const int d0 = dt * 32; const float psc = in[I_POOLS][l * 256 + g4 * 64 + d0 + r32];
                            bf16x8 bfr[4];
#pragma unroll
                            for (int s4 = 0; s4 < 4; ++s4) { f32x4 a, b;
#pragma unroll
                                for (int e = 0; e < 4; ++e) { a[e] = pwp[(16 * s4 + 8 * hi + e) * 64 + d0 + r32]; b[e] = pwp[(16 * s4 + 8 * hi + 4 + e) * 64 + d0 + r32]; }
                                const u32x4 w = pg8::pack8(a, b); bfr[s4] = __builtin_bit_cast(bf16x8, w); }
#pragma unroll 1
                            for (int it = 0; it < 2; ++it) { const int i0 = half * 64 + it * 32; f32x16 acc = {};
#pragma unroll
                                for (int s4 = 0; s4 < 4; ++s4) { const bf16x8 afr = *(const LAS bf16x8*)(DB + (i0 + r32) * DBP + g4 * 64 + 16 * s4 + 8 * hi); acc = __builtin_amdgcn_mfma_f32_32x32x16_bf16(afr, bfr[s4], acc, 0, 0, 0); }
#pragma unroll
                                for (int rg = 0; rg < 16; ++rg) { const int i = i0 + (rg & 3) + 8 * (rg >> 2) + 4 * hi;
                                    bf16_t* vw = (REP_B > 1 && rep > 0) ? XN + (size_t)(row0 + i) * DM + g4 * 64 + d0 + r32 : PROJ + (size_t)(row0 + i) * INW + C_V + g4 * 64 + d0 + r32; *vw = f2bf(acc[rg] * psc); }
                            }
                        }
                    }
                }
                __syncthreads();
            }
            }
        }
        if (PH_EN(4) && IN(pb + 2)) { PH_BEGIN()
_Pragma("unroll 1")
            for (int rep = 0; rep < REP_C; ++rep) {
            { pg8::Gemm g{PROJ + C_QA, (const bf16_t*)(wl + W_UQ), INW, QLORA}; pg8::StaticOrder S; S.init(Mq, 768, G, bx);
              pg8::EpiQ E{Qb, in[I_QNG] + l * QKH, cosT, sinT}; pg8::gemm_phase(L, tid, g, S, E); }
            { pg8::Gemm g{PROJ + C_KVA, (const bf16_t*)(wl + W_UKV), INW, KVLORA}; pg8::StaticOrder S; S.init(MROWS, 1024, G, (bx + 112) % G);
              pg8::EpiKV E{Kb, Vb, in[I_KNG] + l * QKH, (const float*)(ws + WS_RKV)}; pg8::gemm_phase(L, tid, g, S, E); }
            }
            if (BOTH(pb + 2)) GRID_BAR();
        }
        if (PH_EN(5) && IN(pb + 3)) { PH_BEGIN()
_Pragma("unroll 1")
            for (int rep = 0; rep < REP_D; ++rep)
            for (int U = vcu; U < NB * NH * (SEQ / 256); U += G) {
                const int bh = U >> 5, qb = U & 31, b = bh >> 3, h = bh & 7; const size_t row0 = (size_t)b * SEQ + qb * 256;
                ATTN_BODY(tid, Qb + row0 * 768 + h * QKH, 768, Kb + (size_t)bh * NKEY * QKH, Vb + (size_t)bh * NKEY * VH, PROJ + row0 * INW + C_ATT + h * VH, INW, NKEY / 64, (char*)lds);
            }
            if (l == 0) for (int U = vcu; U < NB * NH; U += G) {
                const int bh = U, b = bh >> 3, h = bh & 7; const size_t row0 = (size_t)NLAT + b * CTXL;
                ATTN_BODY(tid, Qb + row0 * 768 + h * QKH, 768, Kb + ((size_t)bh * NKEY + SEQ) * QKH, Vb + ((size_t)bh * NKEY + SEQ) * VH, PROJ + row0 * INW + C_ATT + h * VH, INW, CTXL / 64, (char*)lds);
            }
            if (BOTH(pb + 3)) GRID_BAR();
        }
        if (PH_EN(6) && IN(pb + 4)) { PH_BEGIN()
            pg8::MergeOrder S; S.base.init(Mq, 2 * DM, G, bx);
_Pragma("unroll 1")
            for (int rep = 0; rep < REP_E; ++rep) {
            { pg8::Gemm g{PROJ + C_U, (const bf16_t*)(wl + W_BP), INW, 256}; pg8::EpiMergeF E{PROJ, MG}; pg8::gemm_phase(L, tid, g, S, E); }
            }
            if (BOTH(pb + 4)) GRID_BAR();
        }
        if (PH_EN(7) && IN(pb + 5)) { PH_BEGIN()
            pg8::Gemm g{MG, (const bf16_t*)(wl + W_OUT), DM, DM}; pg8::StaticOrder S; S.init(Mq, DM, G, bx);
            pg8::EpiOut E{l == 0 ? in[I_X] : OUT, l == 0 ? in[I_CTX] : XC, X1B, MODL + 2 * DM};
_Pragma("unroll 1")
            for (int rep = 0; rep < (l == 0 ? REP_F : 1); ++rep) pg8::gemm_phase(L, tid, g, S, E);
            if (l == 0 && G == 256 && bx >= 16) {
                LAS float* scr = (LAS float*)(L + wid * TR_SCR);
                constexpr int I_G = 16 * 8, I_D = 8 * 16;
                for (int it = (bx - 16) * NWAVES + wid; it < NE * (2 * I_G + I_D); it += 240 * NWAVES) {
                    const int e = it / (2 * I_G + I_D); int r = it - e * (2 * I_G + I_D);
                    if (r < I_G) { transpose_item(in[I_WEG] + ((size_t)l * NE + e) * DM * DE, DM, DE, WGU, scr, r, lane, MapGU{e * 1024}); continue; } r -= I_G;
                    if (r < I_G) { transpose_item(in[I_WEU] + ((size_t)l * NE + e) * DM * DE, DM, DE, WGU, scr, r, lane, MapGU{e * 1024 + 128}); continue; } r -= I_G;
                    transpose_item(in[I_WED] + ((size_t)l * NE + e) * DE * DM, DE, DM, WDN, scr, r, lane, MapId{e * 1024});
                }
            }
            if (BOTH(pb + 5)) GRID_BAR();
        }
        if (PH_EN(8) && IN(pb + 6)) { PH_BEGIN()
_Pragma("unroll 1")
            for (int rep = REP_G - 1; rep >= 0; --rep) {
            {
                volatile LAS unsigned* HC = MISC + 64;
                __syncthreads();
                {
                    LAS float* scr = (LAS float*)(L + wid * TR_SCR);
                    constexpr int I_G = 16 * 8, I_D = 8 * 16;
                    for (int it = (l == 0 && G == 256) ? NE * (2 * I_G + I_D) : gw; it < NE * (2 * I_G + I_D); it += NGW) {
                        const int e = it / (2 * I_G + I_D); int r = it - e * (2 * I_G + I_D);
                        if (r < I_G) { transpose_item(in[I_WEG] + ((size_t)l * NE + e) * DM * DE, DM, DE, WGU, scr, r, lane, MapGU{e * 1024}); continue; } r -= I_G;
                        if (r < I_G) { transpose_item(in[I_WEU] + ((size_t)l * NE + e) * DM * DE, DM, DE, WGU, scr, r, lane, MapGU{e * 1024 + 128}); continue; } r -= I_G;
                        transpose_item(in[I_WED] + ((size_t)l * NE + e) * DE * DM, DE, DM, WDN, scr, r, lane, MapId{e * 1024});
                    }
                }
                __syncthreads();
                if (tid < 16) HC[tid] = 0u;
                __syncthreads();
                {
                    typedef float f32x4_ __attribute__((ext_vector_type(4)));
                    const bf16_t* WRH = (const bf16_t*)(ws + WS_WR); const float* CB = (const float*)(ws + WS_CB) + l * 5 * NE;
                    const float* n2g = in[I_N2G] + l * DM; const float* rb = in[I_RB];
                    const int r16 = lane & 15, q4 = lane >> 4, c0w = 128 * wid + 8 * q4;
                    LAS f32x4_* accP = (LAS f32x4_*)L; LAS float* ssP = (LAS float*)(L + 16384);
                    const int NGRP = Mq / 16; int par = 0;
                    u32x4 xh[4];
#define G_XROW(grp_) (X1B + (size_t)((grp_) * 16 + r16) * DM + c0w)
                    LAS unsigned char* xsl = L + 20480 + wid * 8192;
                    if (vcu < NGRP) { const bf16_t* xr = G_XROW(vcu);
#pragma unroll
                        for (int s = 0; s < 4; ++s) __builtin_amdgcn_global_load_lds((const unsigned*)(xr + 32 * s), (LAS unsigned*)(xsl + s * 1024), 16, 0, 0); }
                    for (int grp = vcu; grp < NGRP; grp += G) {
                        const int R0 = grp * 16; const bool lat = R0 < NLAT; const int mrow = lat ? (R0 >> 13) : 4;
                        int c0v = c0w; asm volatile("" : "+v"(c0v));
                        asm volatile("s_waitcnt vmcnt(0)" ::: "memory");
#pragma unroll
                        for (int s = 0; s < 4; ++s) xh[s] = *(const LAS u32x4*)(xsl + s * 1024 + lane * 16);
                        asm volatile("s_waitcnt lgkmcnt(0)" ::: "memory");
                        if (grp + G < NGRP) { const bf16_t* xr = G_XROW(grp + G);
#pragma unroll
                            for (int s = 0; s < 4; ++s) __builtin_amdgcn_global_load_lds((const unsigned*)(xr + 32 * s), (LAS unsigned*)(xsl + s * 1024), 16, 0, 0); }
                        const bf16_t* bh = WRH + ((size_t)((l * 5 + mrow) * NE + r16)) * DM + c0v; const bf16_t* bl = bh + 2 * 5 * NE * DM;
                        f32x4_ acc = {0.f, 0.f, 0.f, 0.f}; float ss = 0.f;
#pragma unroll
                        for (int s = 0; s < 4; ++s) { f32x4 a, b; pg8::unpack8(xh[s], a, b); ss += pg8::dot4(a) + pg8::dot4(b);
                            const bf16x8 fh = __builtin_bit_cast(bf16x8, xh[s]); const bf16x8 wh = *(const bf16x8*)(bh + 32 * s), wl = *(const bf16x8*)(bl + 32 * s);
                            acc = __builtin_amdgcn_mfma_f32_16x16x32_bf16(fh, wh, acc, 0, 0, 0); acc = __builtin_amdgcn_mfma_f32_16x16x32_bf16(fh, wl, acc, 0, 0, 0); }
                        ss += __shfl_xor(ss, 16); ss += __shfl_xor(ss, 32);
                        accP[(par * 8 + wid) * 64 + lane] = acc; if (q4 == 0) ssP[(par * 8 + wid) * 16 + r16] = ss;
                        __syncthreads();
                        f32x4_ at = {0.f, 0.f, 0.f, 0.f}; float st = 0.f;
#pragma unroll
                        for (int w = 0; w < 8; ++w) { at += accP[(par * 8 + w) * 64 + lane]; st += ssP[(par * 8 + w) * 16 + r16]; }
                        const float rs = rsqrtf(st * (1.0f / DM) + EPS);
                        {   const float* md = MODL + (size_t)mrow * (6 * DM) + c0v; bf16_t* orow = XN + (size_t)(R0 + r16) * DM + c0v;
#pragma unroll
                            for (int s = 0; s < 4; ++s) { f32x4 a, b; pg8::unpack8(xh[s], a, b);
                                const f32x4 g0 = *(const f32x4*)(n2g + c0v + 32 * s), g1 = *(const f32x4*)(n2g + c0v + 32 * s + 4);
                                const f32x4 c0 = *(const f32x4*)(md + 4 * DM + 32 * s), c1 = *(const f32x4*)(md + 4 * DM + 32 * s + 4), h0 = *(const f32x4*)(md + 3 * DM + 32 * s), h1 = *(const f32x4*)(md + 3 * DM + 32 * s + 4);
                                *(u32x4*)(orow + 32 * s) = pg8::pack8(a * rs * g0 * (1.0f + c0) + h0, b * rs * g1 * (1.0f + c1) + h1);
                                if (s & 1) asm volatile("" ::: "memory"); } }
                        par ^= 1;
                        if (REP_G > 1 && rep > 0) continue;
                        if (wid < 4) {
                            const int rg = wid;
                            const float cbe = CB[mrow * NE + r16], rbe = rb[r16];
                            const float arg = rg == 0 ? at[0] : rg == 1 ? at[1] : rg == 2 ? at[2] : at[3];
                            const float rsr = __shfl(rs, 4 * q4 + rg);
                            const float lg = arg * rsr + cbe; const float sc = 1.0f / (1.0f + expf(-lg)); const float sl = sc + rbe;
                            const int qb = lane & ~3, rw16 = lane & ~15;
                            const float a = __shfl(sl, qb), b = __shfl(sl, qb + 1), c = __shfl(sl, qb + 2), d = __shfl(sl, qb + 3);
                            const float h1 = fmaxf(a, b), l1 = fminf(a, b), h2 = fmaxf(c, d), l2 = fminf(c, d); const float gsc = fmaxf(h1, h2) + fmaxf(fminf(h1, h2), fmaxf(l1, l2));
                            const float g0 = __shfl(gsc, rw16), g1 = __shfl(gsc, rw16 + 4), g2 = __shfl(gsc, rw16 + 8), g3 = __shfl(gsc, rw16 + 12);
                            int best = 0; float bv = g0; if (g1 > bv) { bv = g1; best = 1; } if (g2 > bv) { bv = g2; best = 2; } if (g3 > bv) { bv = g3; best = 3; }
                            const int bl4 = rw16 + 4 * best;
                            float s4[4], c4[4];
#pragma unroll
                            for (int i = 0; i < 4; ++i) { s4[i] = __shfl(sl, bl4 + i); c4[i] = __shfl(sc, bl4 + i); }
                            int i1 = 0; float m1 = s4[0];
#pragma unroll
                            for (int i = 1; i < 4; ++i) if (s4[i] > m1) { m1 = s4[i]; i1 = i; }
                            int i2 = -1; float m2 = -3.0e38f;
#pragma unroll
                            for (int i = 0; i < 4; ++i) if (i != i1 && s4[i] > m2) { m2 = s4[i]; i2 = i; }
                            const float w1 = i1 == 0 ? c4[0] : i1 == 1 ? c4[1] : i1 == 2 ? c4[2] : c4[3], w2 = i2 == 0 ? c4[0] : i2 == 1 ? c4[1] : i2 == 2 ? c4[2] : c4[3];
                            const float ws_ = w1 + w2; const int e0 = best * 4 + i1, e1 = best * 4 + i2;
                            if (r16 == 0) { RT[R0 + 4 * q4 + rg] = (u32x4){(unsigned)e0, (unsigned)e1, __float_as_uint(w1 / ws_), __float_as_uint(w2 / ws_)};
                                __hip_atomic_fetch_add((LAS unsigned*)&HC[e0], 1u, __ATOMIC_RELAXED, __HIP_MEMORY_SCOPE_WORKGROUP); __hip_atomic_fetch_add((LAS unsigned*)&HC[e1], 1u, __ATOMIC_RELAXED, __HIP_MEMORY_SCOPE_WORKGROUP); }
                        }
                    }
#undef G_XROW
                }
                __syncthreads();
                if (tid < 16) atomicAdd(ctl + CW_CNT + 64 * l + tid, HC[tid]);
                __syncthreads();
            }
            }
            if (BOTH(pb + 6)) GRID_BAR();
        }
        if (PH_EN(9) && IN(pb + 7)) { PH_BEGIN()
            {
                volatile LAS unsigned* HC = MISC + 64; volatile LAS unsigned* HB = MISC + 96; volatile LAS unsigned* EB = MISC + 128; volatile LAS unsigned* CN = MISC + 160;
                int* TOK = (int*)(ws + WS_TOK);
                const int rpb = Mq / G;
                if (tid < 16) HC[tid] = 0u;
                __syncthreads();
                int e0 = 0, e1 = 0, r0 = 0, r1 = 0; const int row = vcu * rpb + tid;
                if (tid < rpb) { const u32x4 rt = RT[row]; e0 = (int)rt.x; e1 = (int)rt.y;
                    r0 = (int)__hip_atomic_fetch_add((LAS unsigned*)&HC[e0], 1u, __ATOMIC_RELAXED, __HIP_MEMORY_SCOPE_WORKGROUP); r1 = (int)__hip_atomic_fetch_add((LAS unsigned*)&HC[e1], 1u, __ATOMIC_RELAXED, __HIP_MEMORY_SCOPE_WORKGROUP); }
                __syncthreads();
                if (tid < 16) { unsigned base = 0u, mine = 0u;
                    for (int j = 0; j < 16; ++j) { const unsigned c = __hip_atomic_load(ctl + CW_CNT + 64 * l + j, __ATOMIC_RELAXED, __HIP_MEMORY_SCOPE_AGENT); if (j < tid) base += (c + 255u) & ~255u; if (j == tid) mine = c; }
                    EB[tid] = base; CN[tid] = mine; HB[tid] = atomicAdd(ctl + CW_CUR + 64 * l + tid, HC[tid]); }
                __syncthreads();
                if (tid < rpb) { const int p0 = (int)(EB[e0] + HB[e0]) + r0, p1 = (int)(EB[e1] + HB[e1]) + r1; POS[row] = (i32x2){p0, p1}; TOK[p0] = row; TOK[p1] = row; }
                if (vcu < 16) { const unsigned st = EB[vcu] + CN[vcu], en = EB[vcu] + ((CN[vcu] + 255u) & ~255u);
                    for (unsigned i = st + tid; i < en; i += 512) TOK[i] = 0; }
                __syncthreads();
            }
            if (BOTH(pb + 7)) GRID_BAR();
        }
        if ((PH_EN(10) || PH_EN(11)) && (IN(pb + 8) || IN(pb + 9))) { PH_BEGIN()
            int tbv[16], nun; { int t = 0;
#pragma unroll
                for (int j = 0; j < 16; ++j) { tbv[j] = t; const int c = __builtin_amdgcn_readfirstlane((int)__hip_atomic_load(ctl + CW_CNT + 64 * l + j, __ATOMIC_RELAXED, __HIP_MEMORY_SCOPE_AGENT)); t += (c + 255) >> 8; }
                nun = 4 * t; }
            if (PH_EN(10) && IN(pb + 8)) {
                pg8::MoeOrder<true> S; S.tok = (const int*)(ws + WS_TOK); S.G = G; S.c = vcu; S.nunits = nun;
#pragma unroll
                for (int j = 0; j < 16; ++j) S.tb[j] = tbv[j];
                pg8::Gemm g{XN, WGU, DM, DM}; pg8::EpiMoe1 E{ACT};
_Pragma("unroll 1")
                for (int rep = 0; rep < REP_M; ++rep) pg8::gemm_phase(L, tid, g, S, E);
                if (BOTH(pb + 8)) GRID_BAR();
            }
            if (PH_EN(11) && IN(pb + 9)) {
                pg8::MoeOrder<false> S; S.tok = nullptr; S.G = G; S.c = vcu; S.nunits = nun;
#pragma unroll
                for (int j = 0; j < 16; ++j) S.tb[j] = tbv[j];
                pg8::Gemm g{ACT, WDN, DE, DE}; pg8::EpiMoe2 E{XS};
_Pragma("unroll 1")
                for (int rep = 0; rep < REP_M; ++rep) pg8::gemm_phase(L, tid, g, S, E);
                if (BOTH(pb + 9)) GRID_BAR();
            }
        }
        if (PH_EN(12) && IN(pb + 10)) { PH_BEGIN()
_Pragma("unroll 1")
            for (int rep = REP_K - 1; rep >= 0; --rep) {
            {
                const bool last = (l == DEPTH - 1);
#define K_XR(r_) ((r_) < NLAT ? OUT + (size_t)(r_) * DM : XC + (size_t)((r_) - NLAT) * DM)
#define K_LOAD(A_, B_, X_, ps_, r_) do { const bf16_t* y0_ = XS + (size_t)(ps_).x * DM; const bf16_t* y1_ = XS + (size_t)(ps_).y * DM; const bf16_t* xr_ = X1B + (size_t)(r_) * DM; \
        _Pragma("unroll") for (int j = 0; j < 4; ++j) { const int col = 4 * lane + 256 * j; A_[j] = *(const u32x2*)(y0_ + col); B_[j] = *(const u32x2*)(y1_ + col); X_[j] = *(const u32x2*)(xr_ + col); } } while (0)
                u32x4 rt0 = {0u, 0u, 0u, 0u}, rt1 = {0u, 0u, 0u, 0u}; i32x2 ps0 = {0, 0}, ps1 = {0, 0};
                u32x2 ad[4], bd[4], xd[4];
#pragma unroll
                for (int j = 0; j < 4; ++j) { ad[j] = (u32x2){0u, 0u}; bd[j] = (u32x2){0u, 0u}; xd[j] = (u32x2){0u, 0u}; }
                if (gw < Mq) { rt0 = RT[gw]; ps0 = POS[gw]; }
                if (gw + NGW < Mq) { rt1 = RT[gw + NGW]; ps1 = POS[gw + NGW]; }
                if (gw < Mq) K_LOAD(ad, bd, xd, ps0, gw);
                for (int row = gw; row < Mq; row += NGW) {
                    float* xr = K_XR(row); const int mrow = row < NLAT ? (row >> 13) : 4;
                    const float* md = MODL + (size_t)mrow * (6 * DM);
                    const float w0 = __uint_as_float(rt0.z), w1 = __uint_as_float(rt0.w);
                    u32x4 rt2 = {0u, 0u, 0u, 0u}; i32x2 ps2 = {0, 0};
                    if (row + 2 * NGW < Mq) { rt2 = RT[row + 2 * NGW]; ps2 = POS[row + 2 * NGW]; }
                    u32x2 an[4], bn[4], xn[4];
#pragma unroll
                    for (int j = 0; j < 4; ++j) { an[j] = ad[j]; bn[j] = bd[j]; xn[j] = xd[j]; }
                    if (row + NGW < Mq) K_LOAD(an, bn, xn, ps1, row + NGW);
                    f32x4 v[4];
#pragma unroll
                    for (int j = 0; j < 4; ++j) { const int col = 4 * lane + 256 * j;
                        const u32x2 a = ad[j], b = bd[j];
                        f32x4 ya, yb; ya[0] = __uint_as_float(a.x << 16); ya[1] = __uint_as_float(a.x & 0xffff0000u); ya[2] = __uint_as_float(a.y << 16); ya[3] = __uint_as_float(a.y & 0xffff0000u);
                        yb[0] = __uint_as_float(b.x << 16); yb[1] = __uint_as_float(b.x & 0xffff0000u); yb[2] = __uint_as_float(b.y << 16); yb[3] = __uint_as_float(b.y & 0xffff0000u);
                        const f32x4 g2 = *(const f32x4*)(md + 5 * DM + col);
                        f32x4 x1; x1[0] = __uint_as_float(xd[j].x << 16); x1[1] = __uint_as_float(xd[j].x & 0xffff0000u); x1[2] = __uint_as_float(xd[j].y << 16); x1[3] = __uint_as_float(xd[j].y & 0xffff0000u);
                        v[j] = x1 + g2 * (ya * w0 + yb * w1);
                        float* xw = (REP_K > 1 && rep > 0) ? (float*)Kb + (size_t)(row & 8191) * DM : xr; *(f32x4*)(xw + col) = v[j]; }
                    if (!last) { const float* md1 = MOD + (size_t)((l + 1) * 5 + mrow) * (6 * DM); rms_mod_store(v, in[I_N1G] + (l + 1) * DM, md1, md1 + DM, XN + (size_t)row * DM, lane); }
                    rt0 = rt1; ps0 = ps1; rt1 = rt2; ps1 = ps2;
#pragma unroll
                    for (int j = 0; j < 4; ++j) { ad[j] = an[j]; bd[j] = bn[j]; xd[j] = xn[j]; }
                }
#undef K_LOAD
#undef K_XR
            }
            }
            if (BOTH(pb + 10)) GRID_BAR();
        }
    }
#undef IN
#undef BOTH
#undef GRID_BAR
}

extern "C" void kernel_launch(void* const* d_in, const int* in_sizes, int n_in, void* d_out, int out_size, void* d_ws, size_t ws_size, hipStream_t stream) {
    static int grid = 0;
    if (grid == 0) {
        if (n_in != 30 || out_size != NLAT * DM || ws_size < WS_END) { fprintf(stderr, "kernel_launch: unexpected shapes: n_in %d out %d ws %zu (need %zu)\n", n_in, out_size, ws_size, (size_t)WS_END); grid = -1; return; }
        int dev = 0, cus = 0;
        if (hipGetDevice(&dev) != hipSuccess || hipDeviceGetAttribute(&cus, hipDeviceAttributeMultiprocessorCount, dev) != hipSuccess) { grid = -1; return; }
        if (hipFuncSetAttribute((const void*)mk_fwd, hipFuncAttributeMaxDynamicSharedMemorySize, LDS_BYTES) != hipSuccess) { fprintf(stderr, "kernel_launch: hipFuncSetAttribute failed\n"); grid = -1; return; }
        int per_cu = 0;
        if (hipOccupancyMaxActiveBlocksPerMultiprocessor(&per_cu, (const void*)mk_fwd, NWAVES * 64, LDS_BYTES) != hipSuccess || per_cu < 1) fprintf(stderr, "kernel_launch: occupancy query says %d per CU\n", per_cu);
        (void)hipGetLastError();
        grid = 256;
        if (cus != 256) fprintf(stderr, "kernel_launch: device has %d CUs, kernel is built for 256\n", cus);
    }
    if (grid < 0) return;
    (void)hipMemsetAsync((char*)d_ws + WS_CTL, 0, CTL_ZERO_BYTES, stream);
    Args a{};
    for (int i = 0; i < 30; ++i) a.in[i] = (const float*)d_in[i];
    a.out = (float*)d_out; a.ws = (unsigned char*)d_ws;
    if (MK_N_LAUNCHES == 1) { a.ph_lo = 0; a.ph_hi = N_PHASES; hipLaunchKernelGGL(mk_fwd, dim3(grid), dim3(NWAVES * 64), LDS_BYTES, stream, a); }
    else for (int p = 0; p < N_PHASES; ++p) { a.ph_lo = p; a.ph_hi = p + 1; hipLaunchKernelGGL(mk_fwd, dim3(grid), dim3(NWAVES * 64), LDS_BYTES, stream, a); }
    const hipError_t le = hipPeekAtLastError();
    if (le != hipSuccess) fprintf(stderr, "kernel_launch: launch failed: %s\n", hipGetErrorName(le));
}
```

```cpp
#include <hip/hip_runtime.h>
#include <cstdio>
#include <cstdint>
#ifndef MK_N_LAUNCHES
#define MK_N_LAUNCHES 1
#endif

constexpr int DM = 1024, NB = 4, SEQ = 8192, CTXL = 256, DEPTH = 2;
constexpr int NLAT = NB * SEQ;
constexpr int NCTX = NB * CTXL;
constexpr int MROWS = NLAT + NCTX;
constexpr int NKEY = SEQ + CTXL;
constexpr int NH = 8, QKN = 64, QKR = 32, QKH = 96, VH = 64;
constexpr int QLORA = 384, KVLORA = 256;
constexpr int INW_SRC = 4512, INW = 4608;
constexpr int C_P = 0, C_U = 256, C_V = 512, C_QA = 768, C_KR = 1152, C_PAD = 1184, C_KVA = 1280, C_GATE = 1536, C_ATT = 768;
constexpr int NE = 16, DE = 512;
constexpr float EPS = 1e-6f;
constexpr int MOE_ROWS = 2 * MROWS + 16 * 256;

constexpr size_t MiB = 1u << 20;
constexpr size_t WS_CTL = 0, CTL_ZERO_BYTES = 1 * MiB;
constexpr size_t WS_MOD = 1 * MiB;
constexpr size_t WS_ROPE = 1 * MiB + 256 * 1024;
constexpr size_t WS_RKV = 1 * MiB + 384 * 1024;
constexpr size_t WS_RT = 2 * MiB;
constexpr size_t WS_POS = 2 * MiB + 640 * 1024;
constexpr size_t WS_WR = 3 * MiB;
constexpr size_t WS_CB = 3 * MiB + 704 * 1024;
constexpr size_t WS_TOK = 3 * MiB + 720 * 1024;
constexpr size_t WS_XC = 4 * MiB;
constexpr size_t WS_W = 8 * MiB, W_LAYER = 15 * MiB;
constexpr size_t W_IN = 0, W_UQ = W_IN + (size_t)INW * DM * 2, W_UKV = W_UQ + (size_t)768 * QLORA * 2, W_BP = W_UKV + (size_t)1024 * KVLORA * 2,
                 W_BS = W_BP + (size_t)DM * 256 * 2, W_BM = W_BS + (size_t)DM * 256 * 2, W_OUT = W_BM + (size_t)DM * 512 * 2, W_END = W_OUT + (size_t)DM * DM * 2;
static_assert(W_END <= W_LAYER, "weights per layer");
constexpr size_t WS_XN = 38 * MiB;
constexpr size_t WS_K = 104 * MiB;
constexpr size_t WS_V = 154 * MiB;
constexpr size_t WS_PROJ = 188 * MiB;
constexpr size_t WS_XS = WS_PROJ;
constexpr size_t WS_ACT = WS_PROJ + 140 * MiB;
constexpr size_t WS_WGU = WS_PROJ + 210 * MiB;
constexpr size_t WS_WDN = WS_PROJ + 242 * MiB;
constexpr size_t WS_END = WS_PROJ + 297 * MiB;
static_assert(WS_K + (size_t)NB * NH * NKEY * 96 * 2 <= WS_V && WS_V + (size_t)NB * NH * NKEY * 64 * 2 <= WS_PROJ && WS_XN + (size_t)MROWS * DM * 2 <= WS_K, "ws map");
static_assert((size_t)MOE_ROWS * DM * 2 <= 140 * MiB && (size_t)MOE_ROWS * DE * 2 <= 70 * MiB && WS_WDN + (size_t)NE * DM * DE * 2 <= WS_END && (size_t)MROWS * INW * 2 <= 297 * MiB, "ws map 2");
constexpr int CW_BAR = 4096;
constexpr int CW_CNT = 1024;
constexpr int CW_CUR = 1536;

constexpr int LDS_BYTES = 147456;
constexpr int MISC_OFF = 141312;
namespace pg8 {
#define PG8_LAS __attribute__((address_space(3)))
typedef unsigned short bf16_t;
typedef short bf16x8 __attribute__((ext_vector_type(8)));
typedef float f32x4 __attribute__((ext_vector_type(4)));
typedef unsigned u32x4 __attribute__((ext_vector_type(4)));
typedef unsigned u32x2 __attribute__((ext_vector_type(2)));
constexpr int BM = 256, BK = 64, HALF = 128, HTB = HALF * BK * 2, STAGE_BYTES = 8 * HTB, NXCD = 8, WGM = 8;

__host__ __device__ __forceinline__ int lds_byte(int r, int c) { const int st = (r >> 4) * 2 + (c >> 5), rr = r & 15, cc = c & 31, ob = rr * 64 + cc * 2; return st * 1024 + (ob ^ (((ob >> 9) & 1) << 5)); }
__host__ __device__ __forceinline__ void stage_rc(int b, int& R, int& C) { const int st = b / 1024, sb = b % 1024, swz = sb ^ (((sb >> 9) & 1) << 5); R = (st >> 1) * 16 + swz / 64; C = (st & 1) * 32 + (swz % 64) / 2; }
__host__ __device__ __forceinline__ int perm32(int rho) { const int n = rho >> 4, i = rho & 15; return 8 * (i >> 2) + 4 * n + (i & 3); }

struct Unit { int pm, pn; };
struct Gemm { const bf16_t* A; const bf16_t* Bt; int lda, K; };

struct StaticOrder {
    static constexpr bool GATHER = false; const int* tok;
    int nM, nN, nwg, G, c;
    __device__ __forceinline__ void init(int M, int N, int G_, int c_) { nM = M / BM; nN = N / BM; nwg = nM * nN; G = G_; c = c_; }
    __device__ __forceinline__ bool next(int i, Unit& u) const {
        const long L = (long)i * G + c; if (L >= nwg) return false;
        int wgid = (int)L; { const int q = nwg / NXCD, r = nwg % NXCD, xcd = wgid % NXCD, off = wgid / NXCD; wgid = (xcd < r ? xcd * (q + 1) : r * (q + 1) + (xcd - r) * q) + off; }
        const int nig = WGM * nN, gid = wgid / nig, fm = gid * WGM, gsz = (nM - fm) < WGM ? (nM - fm) : WGM;
        const int w = wgid % nig;
        if (gsz == WGM) { u.pm = fm + (w & 7); u.pn = w >> 3; } else { u.pm = fm + (w & 3); u.pn = w >> 2; }
        return true;
    }
    __device__ __forceinline__ size_t acol(const Unit&) const { return 0; }
    __device__ __forceinline__ bool keep_acc(const Unit&) const { return false; }
    __device__ __forceinline__ void a_ready(const Unit&) const {}
    __device__ __forceinline__ void done(const Unit&) const {}
};

struct MergeOrder {
    static constexpr bool GATHER = false; const int* tok; StaticOrder base;
    __device__ __forceinline__ bool next(int i, Unit& u) const { Unit b; if (!base.next(i >> 2, b)) return false; u.pm = b.pm; u.pn = (i & 3) * 8 + b.pn; return true; }
    __device__ __forceinline__ size_t acol(const Unit& u) const { return (size_t)(u.pn >> 3) * 512; }
    __device__ __forceinline__ bool keep_acc(const Unit& u) const { return (u.pn >> 3) == 2; }
    __device__ __forceinline__ void a_ready(const Unit&) const {}
    __device__ __forceinline__ void done(const Unit&) const {}
};
template <bool GA> struct MoeOrder {
    static constexpr bool GATHER = GA;
    const int* tok; int G, c, nunits; int tb[16];
    __device__ __forceinline__ bool next(int i, Unit& u) const {
        const int L = i * G + c; if (L >= nunits) return false;
        const int pm = L >> 2, pnl = L & 3; int e = 0;
#pragma unroll
        for (int j = 1; j < 16; ++j) e += (pm >= tb[j]) ? 1 : 0;
        u.pm = pm; u.pn = e * 4 + pnl; return true;
    }
    __device__ __forceinline__ size_t acol(const Unit&) const { return 0; }
    __device__ __forceinline__ bool keep_acc(const Unit&) const { return false; }
    __device__ __forceinline__ void a_ready(const Unit&) const {}
    __device__ __forceinline__ void done(const Unit&) const {}
};

typedef float f32x2_t __attribute__((ext_vector_type(2))); typedef __bf16 bf16x2_t __attribute__((ext_vector_type(2)));
__device__ __forceinline__ unsigned cvt_pk_bf16(float lo, float hi) { const f32x2_t v = {lo, hi}; return __builtin_bit_cast(unsigned, __builtin_convertvector(v, bf16x2_t)); }
__device__ __forceinline__ u32x4 pack8(const f32x4 a, const f32x4 b) { u32x4 w; w.x = cvt_pk_bf16(a[0], a[1]); w.y = cvt_pk_bf16(a[2], a[3]); w.z = cvt_pk_bf16(b[0], b[1]); w.w = cvt_pk_bf16(b[2], b[3]); return w; }
__device__ __forceinline__ void unpack8(const u32x4 w, f32x4& a, f32x4& b) {
    a[0] = __uint_as_float(w.x << 16); a[1] = __uint_as_float(w.x & 0xffff0000u); a[2] = __uint_as_float(w.y << 16); a[3] = __uint_as_float(w.y & 0xffff0000u);
    b[0] = __uint_as_float(w.z << 16); b[1] = __uint_as_float(w.z & 0xffff0000u); b[2] = __uint_as_float(w.w << 16); b[3] = __uint_as_float(w.w & 0xffff0000u); }
__device__ __forceinline__ float sigmoidf_fast(float x) { return __builtin_amdgcn_rcpf(1.0f + __builtin_amdgcn_exp2f(-1.4426950408889634f * x)); }
__device__ __forceinline__ f32x4 sigmoid4(const f32x4 v) { f32x4 o; o[0] = sigmoidf_fast(v[0]); o[1] = sigmoidf_fast(v[1]); o[2] = sigmoidf_fast(v[2]); o[3] = sigmoidf_fast(v[3]); return o; }
__device__ __forceinline__ float dot4(const f32x4 v) { return (v[0] * v[0] + v[1] * v[1]) + (v[2] * v[2] + v[3] * v[3]); }


template <class Epi, class Sched>
__device__ __forceinline__ void gemm_phase(PG8_LAS unsigned char* lds, int tid_in, const Gemm g, const Sched& S, const Epi& E) {
    int tid_ = tid_in; asm volatile("" : "+v"(tid_));
    const int tid = tid_, wid = __builtin_amdgcn_readfirstlane(tid >> 6), lane = tid & 63, wr = wid >> 2, wc = wid & 3, fr = lane & 15, fq = lane >> 4;
    constexpr int NB = Epi::NB;
    const int K = g.K, nt = K / BK, lda = g.lda;
    unsigned voffA[2], voffB[2]; int Rv[2]; unsigned cv2[2];
#pragma unroll
    for (int i = 0; i < 2; ++i) { int R, C; stage_rc(tid * 16 + i * 8192, R, C); const int Rb = Epi::PERM ? ((R & ~31) + perm32(R & 31)) : R;
        voffA[i] = (unsigned)(R * lda + C) * 2u; voffB[i] = (unsigned)(Rb * K + C) * 2u; Rv[i] = R; cv2[i] = (unsigned)C * 2u; }
    unsigned goC[2][2] = {{0u, 0u}, {0u, 0u}}, goN[2][2] = {{0u, 0u}, {0u, 0u}};
#define PG8_LOADGO(go, u) do { if constexpr (Sched::GATHER) { _Pragma("unroll") for (int _h = 0; _h < 2; ++_h) _Pragma("unroll") for (int _i = 0; _i < 2; ++_i) \
        go[_h][_i] = (unsigned)S.tok[(u).pm * BM + _h * HALF + Rv[_i]] * (unsigned)(lda * 2) + cv2[_i]; } } while (0)
#define PG8_STAGE_A(bufoff, base, h, go) do { if constexpr (Sched::GATHER) { PG8_STAGE(bufoff, base, go[h]); } else { PG8_STAGE(bufoff, (base) + (h) * hstepA, voffA); } } while (0)
    const size_t kstep = (size_t)(BK * 2);
    const size_t hstepA = (size_t)HALF * lda * 2, hstepB = (size_t)HALF * K * 2;
    const size_t tstepA = 2 * hstepA, tstepB = NB * hstepB;
    const unsigned ldsw = (unsigned)wid * 1024u;
    const int aoff = lds_byte(wr * 64 + fr, fq * 8), boff = lds_byte(wc * 32 + fr, fq * 8);
#define PG8_SA(b, h) (((b) * 2 + (h)) * HTB)
#define PG8_SB(b, h) ((4 + (b) * 2 + (h)) * HTB)
#define PG8_STAGE(bufoff, gbase, voff) do { _Pragma("unroll") for (int _i = 0; _i < 2; ++_i) \
        __builtin_amdgcn_global_load_lds((const unsigned*)((const char*)(gbase) + (voff)[_i]), (PG8_LAS unsigned*)(lds + (bufoff) + ldsw + _i * 8192), 16, 0, 0); } while (0)
#define PG8_LDA(dst, b, h) do { _Pragma("unroll") for (int m = 0; m < 4; ++m) _Pragma("unroll") for (int k = 0; k < 2; ++k) dst[m][k] = *(const PG8_LAS bf16x8*)(lds + PG8_SA(b, h) + aoff + m * 2048 + k * 1024); } while (0)
#define PG8_LDB(dst, b, h) do { _Pragma("unroll") for (int n = 0; n < 2; ++n) _Pragma("unroll") for (int k = 0; k < 2; ++k) dst[n][k] = *(const PG8_LAS bf16x8*)(lds + PG8_SB(b, h) + boff + n * 2048 + k * 1024); } while (0)
    typedef int i32x4_ __attribute__((ext_vector_type(4))); typedef int i32x8_ __attribute__((ext_vector_type(8)));
    const int sclW = 0x7A7A7A7A, sclX = 0x7F7F7F7F;
#define PG8_F8(lo, hi) __builtin_shufflevector(__builtin_bit_cast(i32x4_, lo), __builtin_bit_cast(i32x4_, hi), 0, 1, 2, 3, 4, 5, 6, 7)
#define PG8_MMA(ai, bj, At, Bt) do { __builtin_amdgcn_s_setprio(1); \
    if constexpr (Epi::FP8) { _Pragma("unroll") for (int m = 0; m < 4; ++m) _Pragma("unroll") for (int n = 0; n < 2; ++n) \
        { const i32x8_ a8_ = PG8_F8(Bt[n][0], Bt[n][1]), b8_ = PG8_F8(At[m][0], At[m][1]);     \
          asm volatile("v_mfma_scale_f32_16x16x128_f8f6f4 %0, %1, %2, %0, %3, %4 op_sel_hi:[0,0,0]" : "+v"(acc[ai][bj][m][n]) : "v"(a8_), "v"(b8_), "v"(sclW), "v"(sclX)); } } \
    else { _Pragma("unroll") for (int m = 0; m < 4; ++m) _Pragma("unroll") for (int n = 0; n < 2; ++n) _Pragma("unroll") for (int k = 0; k < 2; ++k) \
        acc[ai][bj][m][n] = __builtin_amdgcn_mfma_f32_16x16x32_bf16(Bt[n][k], At[m][k], acc[ai][bj][m][n], 0, 0, 0); } \
    __builtin_amdgcn_s_setprio(0); } while (0)
#define PG8_WAIT_V(n) asm volatile("s_waitcnt vmcnt(" #n ")" ::: "memory")
#define PG8_WAIT_L(n) asm volatile("s_waitcnt lgkmcnt(" #n ")" ::: "memory")
#define PG8_WAIT_VN() do { if constexpr (NB == 2) PG8_WAIT_V(8); else PG8_WAIT_V(6); } while (0)
#define PG8_BAR __builtin_amdgcn_s_barrier()
#define PG8_SCHED __builtin_amdgcn_sched_barrier(0)
    Unit cur, nxt; int ui = 0;
    if (!S.next(0, cur)) return;
    cur.pm = __builtin_amdgcn_readfirstlane(cur.pm); cur.pn = __builtin_amdgcn_readfirstlane(cur.pn);
    f32x4 acc[2][2][4][2];
#pragma unroll
    for (int a = 0; a < 2; ++a)
#pragma unroll
        for (int b = 0; b < 2; ++b)
#pragma unroll
            for (int m = 0; m < 4; ++m)
#pragma unroll
                for (int n = 0; n < 2; ++n) acc[a][b][m][n] = (f32x4){0.f, 0.f, 0.f, 0.f};
    bf16x8 At[4][2], B0[2][2], B1[2][2];
    const char* cA = (const char*)g.A + (Sched::GATHER ? (size_t)0 : (size_t)cur.pm * tstepA) + S.acol(cur); const char* cB = (const char*)g.Bt + (size_t)cur.pn * tstepB;
    PG8_LOADGO(goC, cur);
    S.a_ready(cur);
    PG8_STAGE(PG8_SB(0, 0), cB, voffB); if constexpr (NB == 2) PG8_STAGE(PG8_SB(0, 1), cB + hstepB, voffB); PG8_STAGE_A(PG8_SA(0, 0), cA, 0, goC); PG8_STAGE_A(PG8_SA(0, 1), cA, 1, goC);
    if (wr == 1) PG8_BAR;
    PG8_WAIT_V(2); PG8_BAR;
    PG8_STAGE(PG8_SB(1, 0), cB + kstep, voffB); PG8_STAGE_A(PG8_SA(1, 0), cA + kstep, 0, goC); if constexpr (NB == 2) PG8_STAGE(PG8_SB(1, 1), cB + hstepB + kstep, voffB);
    if constexpr (NB == 2) PG8_WAIT_V(6); else PG8_WAIT_V(4);
    PG8_BAR;
    for (;;) {
        bool has_next = S.next(ui + 1, nxt);
        has_next = __builtin_amdgcn_readfirstlane((int)has_next) != 0; nxt.pm = __builtin_amdgcn_readfirstlane(nxt.pm); nxt.pn = __builtin_amdgcn_readfirstlane(nxt.pn);
        if constexpr (Sched::GATHER) { if (has_next) { PG8_LOADGO(goN, nxt); } else { _Pragma("unroll") for (int _h = 0; _h < 2; ++_h) _Pragma("unroll") for (int _i = 0; _i < 2; ++_i) goN[_h][_i] = goC[_h][_i]; } }
        const char* nA = Sched::GATHER ? (const char*)g.A : (has_next ? (const char*)g.A + (size_t)nxt.pm * tstepA + S.acol(nxt) : cA); const char* nB = has_next ? (const char*)g.Bt + (size_t)nxt.pn * tstepB : cB;
#pragma unroll 1
        for (int t = 0; t < nt; t += 2) {
            const bool last = (t == nt - 2);
            const char* a1 = cA + (size_t)(t + 1) * kstep;
            const char* a2 = last ? nA : cA + (size_t)(t + 2) * kstep; const char* b2 = last ? nB : cB + (size_t)(t + 2) * kstep;
            const char* a3 = a2 + kstep; const char* b3 = b2 + kstep;
            unsigned s2[2][2];
#pragma unroll
            for (int _h = 0; _h < 2; ++_h)
#pragma unroll
                for (int _i = 0; _i < 2; ++_i) s2[_h][_i] = last ? goN[_h][_i] : goC[_h][_i];
            if (last && has_next) S.a_ready(nxt);
            if constexpr (Epi::HOOKS) { if (t == 4 || t == 8) E.hook(acc, cur, t, wr, wc, fr, fq); }
            PG8_LDB(B0, 0, 0); if constexpr (NB == 2) PG8_LDB(B1, 0, 1); PG8_SCHED; PG8_LDA(At, 0, 0); PG8_STAGE_A(PG8_SA(1, 1), a1, 1, goC);
            PG8_WAIT_VN(); PG8_WAIT_L(0); PG8_BAR; PG8_MMA(0, 0, At, B0); if constexpr (NB == 2) PG8_MMA(0, 1, At, B1); PG8_BAR; PG8_SCHED;
            PG8_LDA(At, 0, 1); PG8_STAGE(PG8_SB(0, 0), b2, voffB); if constexpr (NB == 2) PG8_STAGE(PG8_SB(0, 1), b2 + hstepB, voffB); PG8_STAGE_A(PG8_SA(0, 0), a2, 0, s2);
            PG8_WAIT_VN(); PG8_WAIT_L(0); PG8_BAR; PG8_MMA(1, 0, At, B0); if constexpr (NB == 2) PG8_MMA(1, 1, At, B1); PG8_BAR; PG8_SCHED;
            PG8_LDB(B0, 1, 0); if constexpr (NB == 2) PG8_LDB(B1, 1, 1); PG8_SCHED; PG8_LDA(At, 1, 0); PG8_STAGE_A(PG8_SA(0, 1), a2, 1, s2);
            PG8_WAIT_VN(); PG8_WAIT_L(0); PG8_BAR; PG8_MMA(0, 0, At, B0); if constexpr (NB == 2) PG8_MMA(0, 1, At, B1); PG8_BAR; PG8_SCHED;
            PG8_LDA(At, 1, 1); PG8_STAGE(PG8_SB(1, 0), b3, voffB); if constexpr (NB == 2) PG8_STAGE(PG8_SB(1, 1), b3 + hstepB, voffB); PG8_STAGE_A(PG8_SA(1, 0), a3, 0, s2);
            PG8_WAIT_VN(); PG8_WAIT_L(0); PG8_BAR; PG8_MMA(1, 0, At, B0); if constexpr (NB == 2) PG8_MMA(1, 1, At, B1); PG8_BAR; PG8_SCHED;
        }
        if (wr == 0) PG8_BAR;
        const bool keep = S.keep_acc(cur);
        if (!keep) E(acc, cur, wr, wc, fr, fq);
        S.done(cur);
        if (!has_next) break;
        if (!keep)
#pragma unroll
        for (int a = 0; a < 2; ++a)
#pragma unroll
            for (int b = 0; b < 2; ++b)
#pragma unroll
                for (int m = 0; m < 4; ++m)
#pragma unroll
                    for (int n = 0; n < 2; ++n) acc[a][b][m][n] = (f32x4){0.f, 0.f, 0.f, 0.f};
        cur = nxt; cA = nA; cB = nB; ++ui;
        if constexpr (Sched::GATHER) { _Pragma("unroll") for (int _h = 0; _h < 2; ++_h) _Pragma("unroll") for (int _i = 0; _i < 2; ++_i) goC[_h][_i] = goN[_h][_i]; }
        if (wr == 1) PG8_BAR;
    }
    PG8_WAIT_V(0);
    PG8_BAR;
#undef PG8_SA
#undef PG8_SB
#undef PG8_STAGE
#undef PG8_STAGE_A
#undef PG8_LOADGO
#undef PG8_LDA
#undef PG8_LDB
#undef PG8_MMA
#undef PG8_F8
#undef PG8_WAIT_V
#undef PG8_WAIT_L
#undef PG8_WAIT_VN
#undef PG8_BAR
#undef PG8_SCHED
}
}
namespace pg8 {
constexpr float QSCALE_LOG2 = 0.10206207261596575f * 1.4426950408889634f;
struct EpiNull { static constexpr bool PERM = true, HOOKS = false; static constexpr int NB = 2; static constexpr bool FP8 = false;
    __device__ __forceinline__ void operator()(const f32x4 (&acc)[2][2][4][2], const Unit&, int, int, int, int) const {
#pragma unroll
        for (int a = 0; a < 2; ++a)
#pragma unroll
            for (int b = 0; b < 2; ++b)
#pragma unroll
                for (int m = 0; m < 4; ++m)
#pragma unroll
                    for (int n = 0; n < 2; ++n) asm volatile("" :: "v"(acc[a][b][m][n])); } };
struct EpiInProj { static constexpr bool PERM = true, HOOKS = false; static constexpr int NB = 2; static constexpr bool FP8 = true;
    bf16_t* P; const float* bgate; float* RKV; bf16_t* Kb; const float* kng; const float* cosT; const float* sinT;
    __device__ __forceinline__ void operator()(const f32x4 (&acc)[2][2][4][2], const Unit& u, int wr, int wc, int fr, int fq) const {
        asm volatile("" : "+v"(fr), "+v"(fq));
        const int row0 = u.pm * BM + wr * 64 + fr, colt = u.pn * BM + wc * 32 + 8 * fq;
        if (u.pn >= C_GATE / BM) {
            const int gc0 = (u.pn - C_GATE / BM) * BM + wc * 64 + fq * 16;
            f32x4 bv[2][2];
#pragma unroll
            for (int bj = 0; bj < 2; ++bj)
#pragma unroll
                for (int n = 0; n < 2; ++n) bv[bj][n] = *(const f32x4*)(bgate + gc0 + bj * 8 + 4 * n);
            asm volatile("" : "+v"(bv[0][0]), "+v"(bv[0][1]), "+v"(bv[1][0]), "+v"(bv[1][1]));
#pragma unroll
            for (int ai = 0; ai < 2; ++ai)
#pragma unroll
                for (int m = 0; m < 4; ++m) { u32x4 w;
#pragma unroll
                    for (int bj = 0; bj < 2; ++bj)
#pragma unroll
                        for (int n = 0; n < 2; ++n) { const f32x4 s = sigmoid4(acc[ai][bj][m][n] + bv[bj][n]) * 255.0f + 0.5f;
                            w[bj * 2 + n] = (unsigned)s[0] | ((unsigned)s[1] << 8) | ((unsigned)s[2] << 16) | ((unsigned)s[3] << 24); }
                    *(u32x4*)((unsigned char*)P + (size_t)(row0 + ai * HALF + m * 16) * (INW * 2) + C_GATE * 2 + gc0) = w; }
            return;
        }
#pragma unroll
        for (int ai = 0; ai < 2; ++ai)
#pragma unroll
            for (int m = 0; m < 4; ++m) { bf16_t* rowp = P + (size_t)(row0 + ai * HALF + m * 16) * INW + colt;
#pragma unroll
                for (int bj = 0; bj < 2; ++bj) *(u32x4*)(rowp + bj * HALF) = pack8(acc[ai][bj][m][0], acc[ai][bj][m][1]); }
        if (u.pn == C_KVA / BM) {
#pragma unroll
            for (int ai = 0; ai < 2; ++ai)
#pragma unroll
                for (int m = 0; m < 4; ++m) {
                    float ss = (dot4(acc[ai][0][m][0]) + dot4(acc[ai][0][m][1])) + (dot4(acc[ai][1][m][0]) + dot4(acc[ai][1][m][1]));
                    ss += __shfl_xor(ss, 16); ss += __shfl_xor(ss, 32);
                    if (fq == 0) RKV[(size_t)(row0 + ai * HALF + m * 16) * 4 + wc] = ss; }
        }
        if (u.pn == C_KR / BM && wc == 0) {
            const f32x4 g0 = *(const f32x4*)(kng + 8 * fq), g1 = *(const f32x4*)(kng + 8 * fq + 4);
            const bool lat = u.pm < NLAT / BM; const bool first = (fq & 1) == 0;
#pragma unroll
            for (int ai = 0; ai < 2; ++ai)
#pragma unroll
                for (int m = 0; m < 4; ++m) {
                    const int row = row0 + ai * HALF + m * 16;
                    float ss = dot4(acc[ai][1][m][0]) + dot4(acc[ai][1][m][1]);
                    ss += __shfl_xor(ss, 16); ss += __shfl_xor(ss, 32);
                    const float r = rsqrtf(ss * (1.0f / 32.0f) + EPS);
                    f32x4 v0 = acc[ai][1][m][0] * r * g0, v1 = acc[ai][1][m][1] * r * g1, p0, p1;
#pragma unroll
                    for (int e = 0; e < 4; ++e) { p0[e] = __shfl_xor(v0[e], 16); p1[e] = __shfl_xor(v1[e], 16); }
                    if (lat) { const int t = row & (SEQ - 1); const int pos = (fq >> 1) ? (t & 63) : (t >> 6);
                        const f32x4 c0 = *(const f32x4*)(cosT + pos * 8), c1 = *(const f32x4*)(cosT + pos * 8 + 4); f32x4 s0 = *(const f32x4*)(sinT + pos * 8), s1 = *(const f32x4*)(sinT + pos * 8 + 4);
                        if (first) { s0 = -s0; s1 = -s1; }
                        v0 = v0 * c0 + p0 * s0; v1 = v1 * c1 + p1 * s1; }
                    const int b = lat ? (row >> 13) : ((row - NLAT) >> 8), key = lat ? (row & (SEQ - 1)) : (SEQ + ((row - NLAT) & 255));
                    const u32x4 w = pack8(v0, v1);
#pragma unroll
                    for (int h = 0; h < NH; ++h) *(u32x4*)(Kb + ((unsigned)((b * NH + h) * NKEY + key) * (unsigned)QKH + (unsigned)(64 + 8 * fq))) = w;
                    asm volatile("" ::: "memory"); }
        }
    }
};
struct EpiQ { static constexpr bool PERM = true, HOOKS = false; static constexpr int NB = 2; static constexpr bool FP8 = false;
    bf16_t* Q; const float* qg; const float* cosT; const float* sinT;
    __device__ __forceinline__ void operator()(const f32x4 (&acc)[2][2][4][2], const Unit& u, int wr, int wc, int fr, int fq) const {
        asm volatile("" : "+v"(fr), "+v"(fq));
        const int row0 = u.pm * BM + wr * 64 + fr;
        if (u.pn < 2) {
            const int head = u.pn * 4 + wc;
            f32x4 g[2][2];
#pragma unroll
            for (int bj = 0; bj < 2; ++bj)
#pragma unroll
                for (int n = 0; n < 2; ++n) g[bj][n] = *(const f32x4*)(qg + 32 * bj + 8 * fq + 4 * n);
#pragma unroll
            for (int ai = 0; ai < 2; ++ai)
#pragma unroll
                for (int m = 0; m < 4; ++m) {
                    float ss = (dot4(acc[ai][0][m][0]) + dot4(acc[ai][0][m][1])) + (dot4(acc[ai][1][m][0]) + dot4(acc[ai][1][m][1]));
                    ss += __shfl_xor(ss, 16); ss += __shfl_xor(ss, 32);
                    const float r = rsqrtf(ss * (1.0f / 64.0f) + EPS) * QSCALE_LOG2;
                    bf16_t* rowp = Q + (size_t)(row0 + ai * HALF + m * 16) * 768 + head * QKH + 8 * fq;
#pragma unroll
                    for (int bj = 0; bj < 2; ++bj) *(u32x4*)(rowp + 32 * bj) = pack8(acc[ai][bj][m][0] * r * g[bj][0], acc[ai][bj][m][1] * r * g[bj][1]);
                    asm volatile("" ::: "memory");
                }
        } else {
            const f32x4 g0 = *(const f32x4*)(qg + 64 + 8 * fq), g1 = *(const f32x4*)(qg + 64 + 8 * fq + 4);
            const bool rope = u.pm < NLAT / BM; const bool first = (fq & 1) == 0;
#pragma unroll
            for (int ai = 0; ai < 2; ++ai)
#pragma unroll
                for (int m = 0; m < 4; ++m) {
                    const int row = row0 + ai * HALF + m * 16;
                    f32x4 c0 = {1.f, 1.f, 1.f, 1.f}, c1 = c0, s0 = {0.f, 0.f, 0.f, 0.f}, s1 = s0;
                    if (rope) { const int t = row & (SEQ - 1); const int pos = (fq >> 1) ? (t & 63) : (t >> 6);
                        c0 = *(const f32x4*)(cosT + pos * 8); c1 = *(const f32x4*)(cosT + pos * 8 + 4); s0 = *(const f32x4*)(sinT + pos * 8); s1 = *(const f32x4*)(sinT + pos * 8 + 4);
                        if (first) { s0 = -s0; s1 = -s1; } }
#pragma unroll
                    for (int bj = 0; bj < 2; ++bj) {
                        const int head = 4 * bj + wc;
                        float ss = dot4(acc[ai][bj][m][0]) + dot4(acc[ai][bj][m][1]);
                        ss += __shfl_xor(ss, 16); ss += __shfl_xor(ss, 32);
                        const float r = rsqrtf(ss * (1.0f / 32.0f) + EPS) * QSCALE_LOG2;
                        f32x4 v0 = acc[ai][bj][m][0] * r * g0, v1 = acc[ai][bj][m][1] * r * g1, p0, p1;
#pragma unroll
                        for (int e = 0; e < 4; ++e) { p0[e] = __shfl_xor(v0[e], 16); p1[e] = __shfl_xor(v1[e], 16); }
                        v0 = v0 * c0 + p0 * s0; v1 = v1 * c1 + p1 * s1;
                        *(u32x4*)(Q + (size_t)row * 768 + head * QKH + 64 + 8 * fq) = pack8(v0, v1);
                    }
                    asm volatile("" ::: "memory");
                }
        }
    }
};
struct EpiKV { static constexpr bool PERM = true, HOOKS = false; static constexpr int NB = 2; static constexpr bool FP8 = false;
    bf16_t* Kb; bf16_t* Vb; const float* kg; const float* RKV;
    __device__ __forceinline__ void operator()(const f32x4 (&acc)[2][2][4][2], const Unit& u, int wr, int wc, int fr, int fq) const {
        asm volatile("" : "+v"(fr), "+v"(fq));
        const int row0 = u.pm * BM + wr * 64 + fr; const int head = 2 * u.pn + (wc & 1);
        const bool lat = u.pm < NLAT / BM;
        if (wc < 2) {
            f32x4 g[2][2];
#pragma unroll
            for (int bj = 0; bj < 2; ++bj) { g[bj][0] = *(const f32x4*)(kg + 32 * bj + 8 * fq); g[bj][1] = *(const f32x4*)(kg + 32 * bj + 8 * fq + 4); }
            asm volatile("" : "+v"(g[0][0]), "+v"(g[0][1]), "+v"(g[1][0]), "+v"(g[1][1]));
#pragma unroll
            for (int ai = 0; ai < 2; ++ai)
#pragma unroll
                for (int m = 0; m < 4; ++m) {
                    const int row = row0 + ai * HALF + m * 16;
                    const int b = lat ? (row >> 13) : ((row - NLAT) >> 8), key = lat ? (row & (SEQ - 1)) : (SEQ + ((row - NLAT) & 255));
                    const unsigned kidx = (unsigned)((b * NH + head) * NKEY + key);
                    float ss = (dot4(acc[ai][0][m][0]) + dot4(acc[ai][0][m][1])) + (dot4(acc[ai][1][m][0]) + dot4(acc[ai][1][m][1]));
                    ss += __shfl_xor(ss, 16); ss += __shfl_xor(ss, 32);
                    const float r = rsqrtf(ss * (1.0f / 64.0f) + EPS);
#pragma unroll
                    for (int bj = 0; bj < 2; ++bj)
                        *(u32x4*)(Kb + (kidx * (unsigned)QKH + (unsigned)(32 * bj + 8 * fq))) = pack8(acc[ai][bj][m][0] * r * g[bj][0], acc[ai][bj][m][1] * r * g[bj][1]);
                }
        } else {
#pragma unroll
            for (int ai = 0; ai < 2; ++ai) {
                f32x4 pr[4];
#pragma unroll
                for (int m = 0; m < 4; ++m) pr[m] = *(const f32x4*)(RKV + (size_t)(row0 + ai * HALF + m * 16) * 4);
                asm volatile("" : "+v"(pr[0]), "+v"(pr[1]), "+v"(pr[2]), "+v"(pr[3]));
#pragma unroll
                for (int m = 0; m < 4; ++m) {
                    const int row = row0 + ai * HALF + m * 16;
                    const int b = lat ? (row >> 13) : ((row - NLAT) >> 8), key = lat ? (row & (SEQ - 1)) : (SEQ + ((row - NLAT) & 255));
                    const unsigned kidx = (unsigned)((b * NH + head) * NKEY + key);
                    const float rk = rsqrtf(((pr[m][0] + pr[m][1]) + (pr[m][2] + pr[m][3])) * (1.0f / 256.0f) + EPS);
#pragma unroll
                    for (int bj = 0; bj < 2; ++bj) *(u32x4*)(Vb + (kidx * (unsigned)VH + (unsigned)(32 * bj + 8 * fq))) = pack8(acc[ai][bj][m][0] * rk, acc[ai][bj][m][1] * rk);
                }
                asm volatile("" ::: "memory");
            }
        }
    }
};
struct EpiMergeF { static constexpr bool PERM = true, HOOKS = false; static constexpr int NB = 1; static constexpr bool FP8 = false;
    const bf16_t* P; bf16_t* MG; mutable u32x4 run[2][4];
    __device__ __forceinline__ void operator()(const f32x4 (&acc)[2][2][4][2], const Unit& u, int wr, int wc, int fr, int fq) const {
        asm volatile("" : "+v"(fr), "+v"(fq));
        const int seg = u.pn >> 3, pnl = u.pn & 7, gate = seg == 0 ? 1 : seg == 1 ? 0 : 2;
        const int row0 = u.pm * BM + wr * 64 + fr, colt = pnl * HALF + wc * 32 + 8 * fq;
#pragma unroll
        for (int i0 = 0; i0 < 8; i0 += 4) {
            u32x2 gw[4];
#pragma unroll
            for (int k = 0; k < 4; ++k) { const int i = i0 + k; gw[k] = *(const u32x2*)((const unsigned char*)P + (size_t)(row0 + (i >> 2) * HALF + (i & 3) * 16) * (INW * 2) + C_GATE * 2 + DM * gate + colt); }
#pragma unroll
            for (int k = 0; k < 4; ++k) asm volatile("" : "+v"(gw[k]));
#pragma unroll
            for (int k = 0; k < 4; ++k) { const int i = i0 + k, ai = i >> 2, m = i & 3; f32x4 g0, g1;
#pragma unroll
                for (int b = 0; b < 4; ++b) { g0[b] = (float)((gw[k].x >> (8 * b)) & 255u) * (1.0f / 255.0f); g1[b] = (float)((gw[k].y >> (8 * b)) & 255u) * (1.0f / 255.0f); }
                f32x4 v0 = acc[ai][0][m][0] * g0, v1 = acc[ai][0][m][1] * g1;
                if (seg != 0) { f32x4 q0, q1; unpack8(run[ai][m], q0, q1); v0 += q0; v1 += q1; }
                const u32x4 w = pack8(v0, v1); run[ai][m] = w;
                if (seg == 3) *(u32x4*)(MG + (size_t)(row0 + ai * HALF + m * 16) * DM + colt) = w; }
            asm volatile("" ::: "memory");
        }
    }
};
struct EpiOut { static constexpr bool PERM = true, HOOKS = false; static constexpr int NB = 2; static constexpr bool FP8 = false;
    const float* resL; const float* resC; bf16_t* X1; const float* gvec;
    template <int I0, int N> __device__ __forceinline__ void batch(const f32x4 (&acc)[2][2][4][2], const f32x4 (&gv)[2][2], const float* res, size_t roff0, size_t xoff0) const {
        f32x4 xr[N][2];
#pragma unroll
        for (int k = 0; k < N; ++k) { const int i = I0 + k, ai = i >> 3, m = (i >> 1) & 3, bj = i & 1; const float* p = res + roff0 + (size_t)(ai * HALF + m * 16) * DM + bj * HALF;
            xr[k][0] = *(const f32x4*)p; xr[k][1] = *(const f32x4*)(p + 4); }
#pragma unroll
        for (int k = 0; k < N; ++k) { asm volatile("" : "+v"(xr[k][0])); asm volatile("" : "+v"(xr[k][1])); }
#pragma unroll
        for (int k = 0; k < N; ++k) { const int i = I0 + k, ai = i >> 3, m = (i >> 1) & 3, bj = i & 1;
            *(u32x4*)(X1 + xoff0 + (size_t)(ai * HALF + m * 16) * DM + bj * HALF) = pack8(xr[k][0] + gv[bj][0] * acc[ai][bj][m][0], xr[k][1] + gv[bj][1] * acc[ai][bj][m][1]); }
        asm volatile("" ::: "memory");
    }
    __device__ __forceinline__ void operator()(const f32x4 (&acc)[2][2][4][2], const Unit& u, int wr, int wc, int fr, int fq) const {
        asm volatile("" : "+v"(fr), "+v"(fq));
        const bool lat = u.pm < NLAT / BM;
        const float* res = lat ? resL : resC; const int roff = lat ? 0 : NLAT;
        const int col0 = u.pn * BM + wc * 32 + 8 * fq, mrow = lat ? (u.pm >> 5) : 4;
        const float* gp = gvec + (size_t)mrow * (6 * DM) + col0;
        f32x4 gv[2][2];
#pragma unroll
        for (int bj = 0; bj < 2; ++bj)
#pragma unroll
            for (int n = 0; n < 2; ++n) gv[bj][n] = *(const f32x4*)(gp + bj * HALF + 4 * n);
        const int row = u.pm * BM + wr * 64 + fr;
        const size_t roff0 = (size_t)(row - roff) * DM + col0, xoff0 = (size_t)row * DM + col0;
        batch<0, 2>(acc, gv, res, roff0, xoff0); batch<2, 2>(acc, gv, res, roff0, xoff0); batch<4, 4>(acc, gv, res, roff0, xoff0); batch<8, 8>(acc, gv, res, roff0, xoff0);
    }
};
struct EpiMoe1 { static constexpr bool PERM = true, HOOKS = false; static constexpr int NB = 2; static constexpr bool FP8 = false;
    bf16_t* ACT;
    __device__ __forceinline__ void operator()(const f32x4 (&acc)[2][2][4][2], const Unit& u, int wr, int wc, int fr, int fq) const {
        asm volatile("" : "+v"(fr), "+v"(fq));
        const int row0 = u.pm * BM + wr * 64 + fr, col = (u.pn & 3) * HALF + wc * 32 + 8 * fq;
#pragma unroll
        for (int ai = 0; ai < 2; ++ai)
#pragma unroll
            for (int m = 0; m < 4; ++m) {
                const f32x4 g0 = acc[ai][0][m][0], g1 = acc[ai][0][m][1];
                const f32x4 a0 = g0 * sigmoid4(g0) * acc[ai][1][m][0], a1 = g1 * sigmoid4(g1) * acc[ai][1][m][1];
                *(u32x4*)(ACT + (size_t)(row0 + ai * HALF + m * 16) * DE + col) = pack8(a0, a1); }
    }
};
struct EpiMoe2 { static constexpr bool PERM = true, HOOKS = false; static constexpr int NB = 2; static constexpr bool FP8 = false;
    bf16_t* YS;
    __device__ __forceinline__ void operator()(const f32x4 (&acc)[2][2][4][2], const Unit& u, int wr, int wc, int fr, int fq) const {
        asm volatile("" : "+v"(fr), "+v"(fq));
        const int row0 = u.pm * BM + wr * 64 + fr, col = (u.pn & 3) * BM + wc * 32 + 8 * fq;
#pragma unroll
        for (int ai = 0; ai < 2; ++ai)
#pragma unroll
            for (int m = 0; m < 4; ++m)
#pragma unroll
                for (int bj = 0; bj < 2; ++bj) *(u32x4*)(YS + (size_t)(row0 + ai * HALF + m * 16) * DM + col + bj * HALF) = pack8(acc[ai][bj][m][0], acc[ai][bj][m][1]);
    }
};
}
namespace attn {
typedef unsigned short bf16_t;
using bf16x8 = __attribute__((ext_vector_type(8))) short;
using s16x4  = __attribute__((ext_vector_type(4))) short;
using f32x16 = __attribute__((ext_vector_type(16))) float;
using u32x4  = __attribute__((ext_vector_type(4))) unsigned;
constexpr int NW = 8, QBLK = 32, KVBLK = 64;
constexpr float QSCALE = 0.10206207261596575f * 1.4426950408889634f;
constexpr int SHM_V = 16384, SHM_K = 16384, SLOTB = 16384, NSLOT = 3,     SHM_ATTN = NSLOT * SHM_V + NSLOT * SHM_K + NW * 64 * 4;
#define KSWZ(row, colB) ((row) * 256 + ((colB) ^ (((row) & 7) << 4)))
#define SBAR() __builtin_amdgcn_sched_barrier(0)
__device__ __forceinline__ int crow(int r, int hi) { return (r & 3) + 8 * (r >> 2) + 4 * hi; }
__device__ __forceinline__ unsigned cvtpk(float lo, float hi) { unsigned r; asm volatile("v_cvt_pk_bf16_f32 %0, %1, %2" : "=v"(r) : "v"(lo), "v"(hi)); return r; }
__device__ __forceinline__ bf16x8 ld8(const bf16_t* p) { return *reinterpret_cast<const bf16x8*>(p); }

constexpr float PSHIFT = 0.0f;
__device__ __forceinline__ void partialSM(f32x16& p0) {
  for (int r = 0; r < 16; ++r) p0[r] = __builtin_amdgcn_exp2f(p0[r]);
}
typedef float f32x2 __attribute__((ext_vector_type(2)));
__device__ __forceinline__ void finishSM(f32x16& p0, f32x16& p1, f32x2& l_reg, bf16x8& pa0, bf16x8& pa1, bf16x8& pa2, bf16x8& pa3) {
  for (int r = 0; r < 16; ++r) p1[r] = __builtin_amdgcn_exp2f(p1[r]);
#define P2(P, i) ((f32x2){P[2 * (i)], P[2 * (i) + 1]})
  const f32x2 a = ((P2(p0, 0) + P2(p0, 1)) + (P2(p0, 2) + P2(p0, 3))) + ((P2(p0, 4) + P2(p0, 5)) + (P2(p0, 6) + P2(p0, 7)));
  const f32x2 b = ((P2(p1, 0) + P2(p1, 1)) + (P2(p1, 2) + P2(p1, 3))) + ((P2(p1, 4) + P2(p1, 5)) + (P2(p1, 6) + P2(p1, 7)));
  l_reg += a + b;
#undef P2
#define PK4(P, BASE, OUT) do { u32x4 w = {cvtpk(P[BASE + 0], P[BASE + 1]), cvtpk(P[BASE + 2], P[BASE + 3]), cvtpk(P[BASE + 4], P[BASE + 5]), cvtpk(P[BASE + 6], P[BASE + 7])}; \
    OUT = *reinterpret_cast<bf16x8*>(&w); } while (0)
  PK4(p0, 0, pa0); PK4(p0, 8, pa1); PK4(p1, 0, pa2); PK4(p1, 8, pa3);
#undef PK4
}
__device__ __forceinline__ void qkt(f32x16& p0, f32x16& p1, const bf16_t* Ks, const bf16x8* qr, int r32, int hi) {
  for (int r = 0; r < 16; ++r) { p0[r] = 0.0f - PSHIFT; p1[r] = 0.0f - PSHIFT; }
#pragma unroll
  for (int d0 = 0; d0 < 6; ++d0) { int cb = (d0 * 16 + hi * 8) * 2;
    bf16x8 b0 = *reinterpret_cast<const bf16x8*>((const char*)Ks + KSWZ(r32, cb));
    bf16x8 b1 = *reinterpret_cast<const bf16x8*>((const char*)Ks + KSWZ(32 + r32, cb));
    p0 = __builtin_amdgcn_mfma_f32_32x32x16_bf16(b0, qr[d0], p0, 0, 0, 0);
    p1 = __builtin_amdgcn_mfma_f32_32x32x16_bf16(b1, qr[d0], p1, 0, 0, 0); }
}
constexpr int VPB = 192;
__device__ __forceinline__ int v_st(int k, int c) { return k * VPB + c * 2; }
__device__ __forceinline__ int v_rd_base(int lane) { const int i = lane & 15, ch = (lane >> 4) & 1, h = lane >> 5; return (4 * h + (i >> 2)) * VPB + (16 * ch + 4 * (i & 3)) * 2; }
constexpr int v_rd_off(int d0, int ks, int half) { return d0 * 64 + ks * 16 * VPB + half * 8 * VPB; }
template <int OFF> __device__ __forceinline__ s16x4 tr_read(int vb) {
  s16x4 r; asm volatile("ds_read_b64_tr_b16 %0, %1 offset:%2" : "=&v"(r) : "v"(vb), "i"(OFF) : "memory"); return r;
}
template <int D0> __device__ __forceinline__ void pv_one(f32x16& od, int vb, bf16x8 pa0, bf16x8 pa1, bf16x8 pa2, bf16x8 pa3) {
  const s16x4 l0 = tr_read<v_rd_off(D0, 0, 0)>(vb), h0 = tr_read<v_rd_off(D0, 0, 1)>(vb), l1 = tr_read<v_rd_off(D0, 1, 0)>(vb), h1 = tr_read<v_rd_off(D0, 1, 1)>(vb);
  const s16x4 l2 = tr_read<v_rd_off(D0, 2, 0)>(vb), h2 = tr_read<v_rd_off(D0, 2, 1)>(vb), l3 = tr_read<v_rd_off(D0, 3, 0)>(vb), h3 = tr_read<v_rd_off(D0, 3, 1)>(vb);
  asm volatile("s_waitcnt lgkmcnt(0)" ::: "memory"); SBAR();
#define PK(L, H) (bf16x8){L[0], L[1], L[2], L[3], H[0], H[1], H[2], H[3]}
  od = __builtin_amdgcn_mfma_f32_32x32x16_bf16(pa0, PK(l0, h0), od, 0, 0, 0);
  od = __builtin_amdgcn_mfma_f32_32x32x16_bf16(pa1, PK(l1, h1), od, 0, 0, 0);
  od = __builtin_amdgcn_mfma_f32_32x32x16_bf16(pa2, PK(l2, h2), od, 0, 0, 0);
  od = __builtin_amdgcn_mfma_f32_32x32x16_bf16(pa3, PK(l3, h3), od, 0, 0, 0);
#undef PK
}
__device__ __forceinline__ void pv_d0(f32x16* o, int vb, bf16x8 pa0, bf16x8 pa1, bf16x8 pa2, bf16x8 pa3) {
  pv_one<0>(o[0], vb, pa0, pa1, pa2, pa3); pv_one<1>(o[1], vb, pa0, pa1, pa2, pa3);
}
#ifndef ATTN_HAND
#define ATTN_HAND 1
#endif
template <int OFF> __device__ __forceinline__ bf16x8 k_read(int a) { bf16x8 r; asm volatile("ds_read_b128 %0, %1 offset:%2" : "=&v"(r) : "v"(a), "i"(OFF) : "memory"); return r; }
__device__ __forceinline__ unsigned cvt2n(float lo, float hi) { const f32x2 v = {lo, hi}; typedef __bf16 bf2 __attribute__((ext_vector_type(2))); return __builtin_bit_cast(unsigned, __builtin_convertvector(v, bf2)); }
__device__ __forceinline__ void attn_dense_body(int tid_in, const bf16_t* __restrict__ Qb, int ldq, const bf16_t* __restrict__ Kh, const bf16_t* __restrict__ Vh,
                                                bf16_t* __restrict__ Ob, int ldo, int NT, char* lds) {
  int tid_ = tid_in; asm volatile("" : "+v"(tid_));
  const int tid = tid_, wid = tid >> 6, lane = tid & 63, r32 = lane & 31, hi = lane >> 5;
  bf16_t* V_lds = (bf16_t*)lds; bf16_t* K_lds = (bf16_t*)(lds + NSLOT * SHM_V);
  float* ws = (float*)(lds + NSLOT * SHM_V + NSLOT * SHM_K) + wid * 64; float* li_l = ws;
  f32x2 l_reg2 = {0.f, 0.f}; f32x16 o[2] = {}; bf16x8 qr[6];
  const bf16_t* Qw = Qb + (long)(wid * QBLK + r32) * ldq + hi * 8;
#pragma unroll
  for (int d0 = 0; d0 < 6; ++d0) qr[d0] = ld8(Qw + d0 * 16);
  const bool two = tid < 256;
  const int kc0 = tid, kc1 = tid + 512;
  const int kst0 = KSWZ(kc0 / 12, (kc0 % 12) * 16), kst1 = KSWZ(kc1 / 12, (kc1 % 12) * 16);
  const int vst0 = v_st(tid >> 3, (tid & 7) * 8);
  const int vb0 = (int)(uintptr_t)V_lds + v_rd_base(lane);
  bf16x8 sv0, sk0, sk1;
#define SLOAD(k0) do { sv0 = ld8(Vh + (long)(k0) * 64 + tid * 8); sk0 = ld8(Kh + (long)(k0) * 96 + kc0 * 8); if (two) sk1 = ld8(Kh + (long)(k0) * 96 + kc1 * 8); } while (0)
#define SWRITE(off) do { *(bf16x8*)((char*)V_lds + (off) + vst0) = sv0; *(bf16x8*)((char*)K_lds + (off) + kst0) = sk0; if (two) *(bf16x8*)((char*)K_lds + (off) + kst1) = sk1; } while (0)
  int o_prev = 0, o_cur = 0, o_next = SLOTB;
#define ROT() do { o_prev = o_cur; o_cur = o_next; o_next = (o_next == (NSLOT - 1) * SLOTB) ? 0 : o_next + SLOTB; } while (0)
  f32x16 pA0, pA1, pB0, pB1; bf16x8 pa0, pa1, pa2, pa3;
  if (__builtin_amdgcn_readfirstlane(wid) >= 4) __builtin_amdgcn_s_setprio(1);
  SLOAD(0); asm volatile("s_waitcnt vmcnt(0)" ::: "memory"); SWRITE(0); SLOAD(KVBLK); __syncthreads();
  qkt(pA0, pA1, K_lds, qr, r32, hi); partialSM(pA0);
  SWRITE(SLOTB); if (2 < NT) SLOAD(2 * KVBLK);
  __syncthreads(); ROT();
#define STEP(PC0, PC1, PP0, PP1, jj) do { \
    SBAR(); qkt(PC0, PC1, (bf16_t*)((char*)K_lds + o_cur), qr, r32, hi); \
    finishSM(PP0, PP1, l_reg2, pa0, pa1, pa2, pa3); SBAR(); \
    if ((jj) + 1 < NT) SWRITE(o_next); \
    if ((jj) + 2 < NT) SLOAD(((jj) + 2) * KVBLK); \
    SBAR(); pv_d0(o, vb0 + o_prev, pa0, pa1, pa2, pa3); partialSM(PC0); \
    __syncthreads(); ROT(); } while (0)
#if ATTN_HAND
  int ka[6];
#pragma unroll
  for (int d0 = 0; d0 < 6; ++d0) ka[d0] = (int)(uintptr_t)K_lds + KSWZ(r32, (d0 * 16 + hi * 8) * 2);
#define LGKM(n) asm volatile("s_waitcnt lgkmcnt(" #n ")" ::: "memory")
#define LGKMK(n, X) asm volatile("s_waitcnt lgkmcnt(" #n ")" : "+v"(X[0]), "+v"(X[1]) :: "memory")
#define LGKMV(n, X) asm volatile("s_waitcnt lgkmcnt(" #n ")" : "+v"(X[0]), "+v"(X[1]), "+v"(X[2]), "+v"(X[3]), "+v"(X[4]), "+v"(X[5]), "+v"(X[6]), "+v"(X[7]) :: "memory")
#define MF(a, b, c) __builtin_amdgcn_mfma_f32_32x32x16_bf16(a, b, c, 0, 0, 0)
#define KRD(X, d) do { const int a_ = ka[d] + o_cur; X[0] = k_read<0>(a_); X[1] = k_read<8192>(a_); } while (0)
#define QK2(X, d, PC0, PC1) do { PC0 = MF(X[0], qr[d], PC0); PC1 = MF(X[1], qr[d], PC1); asm volatile("" : "+v"(PC0), "+v"(PC1)); } while (0)
#define VRD(X, D0) do { X[0] = tr_read<v_rd_off(D0, 0, 0)>(vbp); X[1] = tr_read<v_rd_off(D0, 0, 1)>(vbp); X[2] = tr_read<v_rd_off(D0, 1, 0)>(vbp); X[3] = tr_read<v_rd_off(D0, 1, 1)>(vbp); \
                        X[4] = tr_read<v_rd_off(D0, 2, 0)>(vbp); X[5] = tr_read<v_rd_off(D0, 2, 1)>(vbp); X[6] = tr_read<v_rd_off(D0, 3, 0)>(vbp); X[7] = tr_read<v_rd_off(D0, 3, 1)>(vbp); } while (0)
#define PKV(L, H) (bf16x8){L[0], L[1], L[2], L[3], H[0], H[1], H[2], H[3]}
#define PVM(OD, X) do { OD = MF(pa0, PKV(X[0], X[1]), OD); OD = MF(pa1, PKV(X[2], X[3]), OD); OD = MF(pa2, PKV(X[4], X[5]), OD); OD = MF(pa3, PKV(X[6], X[7]), OD); } while (0)
#define P2(P, i) ((f32x2){P[2 * (i)], P[2 * (i) + 1]})
#define PK4N(P, BASE, OUT) do { u32x4 w = {cvt2n(P[BASE + 0], P[BASE + 1]), cvt2n(P[BASE + 2], P[BASE + 3]), cvt2n(P[BASE + 4], P[BASE + 5]), cvt2n(P[BASE + 6], P[BASE + 7])}; OUT = *reinterpret_cast<bf16x8*>(&w); } while (0)
#define EXPR(P, lo, hi_) do { _Pragma("unroll") for (int r = lo; r < hi_; ++r) P[r] = __builtin_amdgcn_exp2f(P[r]); } while (0)
#define HSTEP(PC0, PC1, PP0, PP1, jj) do { const int vbp = vb0 + o_prev; bf16x8 k0[2], k1[2]; s16x4 va[8], vb[8]; f32x2 t0, t1, t2, t3, sa, sb; \
    SBAR(); KRD(k0, 0); KRD(k1, 1); \
    LGKMK(2, k0); SBAR(); PC0 = MF(k0[0], qr[0], (f32x16)(0.f)); PC1 = MF(k0[1], qr[0], (f32x16)(0.f)); asm volatile("" : "+v"(PC0), "+v"(PC1)); EXPR(PP1, 0, 4); t0 = P2(PP0, 0) + P2(PP0, 1); t1 = P2(PP0, 2) + P2(PP0, 3); SBAR(); \
    KRD(k0, 2); LGKMK(2, k1); SBAR(); QK2(k1, 1, PC0, PC1); EXPR(PP1, 4, 8); t2 = P2(PP0, 4) + P2(PP0, 5); t3 = P2(PP0, 6) + P2(PP0, 7); sa = (t0 + t1) + (t2 + t3); SBAR(); \
    KRD(k1, 3); LGKMK(2, k0); SBAR(); QK2(k0, 2, PC0, PC1); EXPR(PP1, 8, 12); PK4N(PP0, 0, pa0); SBAR(); \
    KRD(k0, 4); LGKMK(2, k1); SBAR(); QK2(k1, 3, PC0, PC1); EXPR(PP1, 12, 16); PK4N(PP0, 8, pa1); SBAR(); \
    KRD(k1, 5); LGKMK(2, k0); SBAR(); QK2(k0, 4, PC0, PC1); \
      sb = ((P2(PP1, 0) + P2(PP1, 1)) + (P2(PP1, 2) + P2(PP1, 3))) + ((P2(PP1, 4) + P2(PP1, 5)) + (P2(PP1, 6) + P2(PP1, 7))); l_reg2 += sa + sb; asm volatile("" : "+v"(l_reg2)); SBAR(); \
    VRD(va, 0); LGKMK(8, k1); SBAR(); QK2(k1, 5, PC0, PC1); PK4N(PP1, 0, pa2); PK4N(PP1, 8, pa3); SBAR(); \
    LGKM(7); VRD(vb, 1); LGKMV(8, va); SBAR(); PVM(o[0], va); EXPR(PC0, 0, 8); asm volatile("" : "+v"(PC0)); SBAR(); \
    LGKMV(0, vb); SBAR(); PVM(o[1], vb); EXPR(PC0, 8, 16); asm volatile("" : "+v"(PC0)); SBAR(); \
    if ((jj) + 1 < NT) SWRITE(o_next); \
    if ((jj) + 2 < NT) SLOAD(((jj) + 2) * KVBLK); \
    __syncthreads(); ROT(); } while (0)
  for (int j = 1; j + 1 < NT; j += 2) { HSTEP(pB0, pB1, pA0, pA1, j); HSTEP(pA0, pA1, pB0, pB1, j + 1); }
  HSTEP(pB0, pB1, pA0, pA1, NT - 1);
#undef HSTEP
#undef EXPR
#undef PK4N
#undef P2
#undef PVM
#undef PKV
#undef VRD
#undef QK2
#undef KRD
#undef MF
#undef LGKM
#undef LGKMK
#undef LGKMV
#else
  for (int j = 1; j + 1 < NT; j += 2) { STEP(pB0, pB1, pA0, pA1, j); STEP(pA0, pA1, pB0, pB1, j + 1); }
  STEP(pB0, pB1, pA0, pA1, NT - 1);
#endif
  finishSM(pB0, pB1, l_reg2, pa0, pa1, pa2, pa3); SBAR();
  pv_d0(o, vb0 + o_prev, pa0, pa1, pa2, pa3);
#undef STEP
#undef ROT
  float l_reg = l_reg2[0] + l_reg2[1];
  { auto rr = __builtin_amdgcn_permlane32_swap(__float_as_uint(l_reg), __float_as_uint(l_reg), false, false); l_reg = __uint_as_float(rr[0]) + __uint_as_float(rr[1]); }
  if (hi == 0) li_l[r32] = l_reg; asm volatile("s_waitcnt lgkmcnt(0)" ::: "memory");
  float rli[16];
#pragma unroll
  for (int r = 0; r < 16; ++r) rli[r] = __builtin_amdgcn_rcpf(li_l[crow(r, hi)]);
  bf16_t* Ow = Ob + (long)(wid * QBLK) * ldo;
#pragma unroll
  for (int r = 0; r < 16; ++r) { int orow = crow(r, hi);
#pragma unroll
    for (int d0 = 0; d0 < 2; ++d0) Ow[(long)orow * ldo + d0 * 32 + r32] = (bf16_t)(cvtpk(o[d0][r] * rli[r], 0.f) & 0xffffu); }
  __builtin_amdgcn_s_setprio(0);
  __syncthreads();
#undef SLOAD
#undef SWRITE
}
#undef KSWZ
#undef SBAR
}
namespace attn16 {
typedef unsigned short bf16_t;
using bf16x8 = __attribute__((ext_vector_type(8))) short;
using s16x4  = __attribute__((ext_vector_type(4))) short;
using f32x4  = __attribute__((ext_vector_type(4))) float;
using u32x4  = __attribute__((ext_vector_type(4))) unsigned;
typedef float f32x2_t __attribute__((ext_vector_type(2))); typedef __bf16 bf16x2_t __attribute__((ext_vector_type(2))); typedef short v4i16_t __attribute__((ext_vector_type(4)));
#define A16LAS __attribute__((address_space(3)))
#define A16SBAR() __builtin_amdgcn_sched_barrier(0)
constexpr int KVBLK = 64, NSLOT = 3, KSLOT = 12288, VSLOT = 10240, VPB = 160, LDS_V0 = NSLOT * KSLOT, SHM_ATTN16 = NSLOT * (KSLOT + VSLOT);
constexpr float PSHIFT = 8.0f;
__device__ __forceinline__ unsigned cvtpk(float lo, float hi) { f32x2_t v = {lo, hi}; bf16x2_t b = __builtin_convertvector(v, bf16x2_t); return __builtin_bit_cast(unsigned, b); }
__device__ __forceinline__ bf16x8 pack8(const f32x4 a, const f32x4 b) { u32x4 w = {cvtpk(a[0], a[1]), cvtpk(a[2], a[3]), cvtpk(b[0], b[1]), cvtpk(b[2], b[3])}; return __builtin_bit_cast(bf16x8, w); }
__device__ __forceinline__ s16x4 trd(const A16LAS char* p) { return __builtin_bit_cast(s16x4, __builtin_amdgcn_ds_read_tr16_b64_v4i16((A16LAS v4i16_t*)p)); }
__device__ __forceinline__ bf16x8 ld8(const bf16_t* p) { return *reinterpret_cast<const bf16x8*>(p); }

__device__ __forceinline__ void qk16(f32x4 (&S)[4][2], const A16LAS char* ks, const bf16x8 (&qf)[2][3], int lane) {
#pragma unroll
  for (int kb = 0; kb < 4; ++kb) {
    S[kb][0] = (f32x4){-PSHIFT, -PSHIFT, -PSHIFT, -PSHIFT}; S[kb][1] = S[kb][0];
#pragma unroll
    for (int s = 0; s < 3; ++s) { const bf16x8 kf = *(const A16LAS bf16x8*)(ks + ((kb * 3 + s) * 64 + lane) * 16);
      S[kb][0] = __builtin_amdgcn_mfma_f32_16x16x32_bf16(kf, qf[0][s], S[kb][0], 0, 0, 0);
      S[kb][1] = __builtin_amdgcn_mfma_f32_16x16x32_bf16(kf, qf[1][s], S[kb][1], 0, 0, 0); } }
}
__device__ __forceinline__ void exp_half(f32x4 (&S)[4][2], int kb0) {
#pragma unroll
  for (int kb = 0; kb < 2; ++kb)
#pragma unroll
    for (int qb = 0; qb < 2; ++qb)
#pragma unroll
      for (int r = 0; r < 4; ++r) S[kb0 + kb][qb][r] = __builtin_amdgcn_exp2f(S[kb0 + kb][qb][r]);
}
__device__ __forceinline__ void finish16(f32x4 (&S)[4][2], float (&lsum)[2], bf16x8 (&pf)[2][2]) {
  exp_half(S, 2);
#pragma unroll
  for (int qb = 0; qb < 2; ++qb) { float ps = 0.f;
#pragma unroll
    for (int kb = 0; kb < 4; ++kb) ps += (S[kb][qb][0] + S[kb][qb][1]) + (S[kb][qb][2] + S[kb][qb][3]);
    lsum[qb] += ps;
    pf[qb][0] = pack8(S[0][qb], S[1][qb]); pf[qb][1] = pack8(S[2][qb], S[3][qb]); }
}
__device__ __forceinline__ void pv16(f32x4 (&o)[2][4], const A16LAS char* vp, const bf16x8 (&pf)[2][2]) {
#pragma unroll
  for (int ks = 0; ks < 2; ++ks)
#pragma unroll
    for (int db = 0; db < 4; ++db) { const s16x4 lo = trd(vp + ks * 32 * VPB + db * 32), hi = trd(vp + ks * 32 * VPB + 16 * VPB + db * 32);
      const bf16x8 vf = {lo[0], lo[1], lo[2], lo[3], hi[0], hi[1], hi[2], hi[3]};
      o[0][db] = __builtin_amdgcn_mfma_f32_16x16x32_bf16(pf[0][ks], vf, o[0][db], 0, 0, 0);
      o[1][db] = __builtin_amdgcn_mfma_f32_16x16x32_bf16(pf[1][ks], vf, o[1][db], 0, 0, 0); }
}
__device__ __forceinline__ void attn_body16(int tid_in, const bf16_t* __restrict__ Qb, int ldq, const bf16_t* __restrict__ Kh, const bf16_t* __restrict__ Vh,
                                            bf16_t* __restrict__ Ob, int ldo, int NT, char* lds) {
  int tid_ = tid_in; asm volatile("" : "+v"(tid_));
  const int tid = tid_, wid = tid >> 6, lane = tid & 63, r16 = lane & 15, quad = lane >> 4;
  A16LAS char* L3 = (A16LAS char*)lds;
  const A16LAS char* K3 = L3; const A16LAS char* V3 = L3 + LDS_V0 + (4 * quad + (r16 >> 2)) * VPB + (r16 & 3) * 8;
  bf16x8 qf[2][3];
#pragma unroll
  for (int qb = 0; qb < 2; ++qb)
#pragma unroll
    for (int s = 0; s < 3; ++s) qf[qb][s] = ld8(Qb + (long)(wid * 32 + 16 * qb + r16) * ldq + 32 * s + 8 * quad);
  const bool two = tid < 256;
  const int kc0 = tid, kc1 = tid + 512;
  const int kst0 = ((((kc0 / 12) >> 4) * 3 + ((kc0 % 12) >> 2)) * 64 + ((kc0 / 12) & 15) + 16 * ((kc0 % 12) & 3)) * 16;
  const int kst1 = ((((kc1 / 12) >> 4) * 3 + ((kc1 % 12) >> 2)) * 64 + ((kc1 / 12) & 15) + 16 * ((kc1 % 12) & 3)) * 16;
  const int vst0 = LDS_V0 + (tid >> 3) * VPB + (tid & 7) * 16;
  bf16x8 sv0, sk0, sk1;
#define SLOAD(k0) do { sv0 = ld8(Vh + (long)(k0) * 64 + tid * 8); sk0 = ld8(Kh + (long)(k0) * 96 + kc0 * 8); if (two) sk1 = ld8(Kh + (long)(k0) * 96 + kc1 * 8); } while (0)
#define SWRITE(sl) do { *(A16LAS bf16x8*)(L3 + (sl) * VSLOT + vst0) = sv0; *(A16LAS bf16x8*)(L3 + (sl) * KSLOT + kst0) = sk0; if (two) *(A16LAS bf16x8*)(L3 + (sl) * KSLOT + kst1) = sk1; } while (0)
  int s_prev = 0, s_cur = 0, s_next = 1;
#define ROT() do { s_prev = s_cur; s_cur = s_next; s_next = (s_next == NSLOT - 1) ? 0 : s_next + 1; } while (0)
  f32x4 sA[4][2], sB[4][2], o[2][4]; bf16x8 pf[2][2]; float lsum[2] = {0.f, 0.f};
#pragma unroll
  for (int qb = 0; qb < 2; ++qb)
#pragma unroll
    for (int db = 0; db < 4; ++db) o[qb][db] = (f32x4){0.f, 0.f, 0.f, 0.f};
  SLOAD(0); asm volatile("s_waitcnt vmcnt(0)" ::: "memory"); SWRITE(0); SLOAD(KVBLK); __syncthreads();
  qk16(sA, K3, qf, lane); exp_half(sA, 0);
  SWRITE(1); if (2 < NT) SLOAD(2 * KVBLK);
  __syncthreads(); ROT();
#define STEP(SC, SP, jj) do { \
    A16SBAR(); qk16(SC, K3 + s_cur * KSLOT, qf, lane); finish16(SP, lsum, pf); A16SBAR(); \
    if ((jj) + 1 < NT) SWRITE(s_next); \
    if ((jj) + 2 < NT) SLOAD(((jj) + 2) * KVBLK); \
    A16SBAR(); pv16(o, V3 + s_prev * VSLOT, pf); exp_half(SC, 0); \
    __syncthreads(); ROT(); } while (0)
  for (int j = 1; j + 1 < NT; j += 2) { STEP(sB, sA, j); STEP(sA, sB, j + 1); }
  STEP(sB, sA, NT - 1);
  finish16(sB, lsum, pf); A16SBAR();
  pv16(o, V3 + s_prev * VSLOT, pf);
#undef STEP
#undef ROT
  bf16_t* Ow = Ob + (long)(wid * 32) * ldo;
#pragma unroll
  for (int qb = 0; qb < 2; ++qb) { float l = lsum[qb]; l += __shfl_xor(l, 16); l += __shfl_xor(l, 32);
#pragma unroll
    for (int r = 0; r < 4; ++r) { const float rl = __builtin_amdgcn_rcpf(__shfl(l, 4 * quad + r)); const long orow = 16 * qb + 4 * quad + r;
#pragma unroll
      for (int db = 0; db < 4; ++db) Ow[orow * ldo + 16 * db + r16] = (bf16_t)(cvtpk(o[qb][db][r] * rl, 0.f) & 0xffffu); } }
  __syncthreads();
#undef SLOAD
#undef SWRITE
}
#undef A16SBAR
}
#define GAS __attribute__((address_space(1)))
#define LAS __attribute__((address_space(3)))
typedef unsigned short bf16_t;
typedef float f32x4 __attribute__((ext_vector_type(4)));
typedef unsigned u32x4 __attribute__((ext_vector_type(4)));
typedef unsigned u32x2 __attribute__((ext_vector_type(2)));
typedef int i32x2 __attribute__((ext_vector_type(2)));
typedef short bf16x8 __attribute__((ext_vector_type(8)));
#define LDS_WAIT() asm volatile("s_waitcnt lgkmcnt(0)" ::: "memory")
__device__ __forceinline__ float bf2f(unsigned short h) { return __uint_as_float(((unsigned)h) << 16); }
__device__ __forceinline__ unsigned short f2bf(float f) { return (unsigned short)(pg8::cvt_pk_bf16(f, 0.f) & 0xffffu); }
__device__ __forceinline__ float wave_sum(float v) {
#pragma unroll
    for (int o = 1; o < 64; o <<= 1) v += __shfl_xor(v, o);
    return v;
}
__device__ __forceinline__ float gelu_tanh(float x) { const float z = 0.7978845608028654f * (x + 0.044715f * x * x * x); return x / (1.0f + __expf(-2.0f * z)); }

__device__ __forceinline__ int hw_tid(int wid0) { int ln; asm volatile("v_mbcnt_lo_u32_b32 %0, -1, 0\n\tv_mbcnt_hi_u32_b32 %0, -1, %0" : "=v"(ln)); return wid0 * 64 + ln; }
#define XB_TMO      128
#define XB_XCNT(j)  (256  + 64 * (j))
#define XB_XSUB(j)  (1280 + 64 * (j))
#define XB_XGEN(j)  (2304 + 64 * (j))
#define XB_TOP      3328
#define XB_TOPGEN   3392
#define XCD_BAR_WORDS 3456
#define XB_SPIN_CAP (1u << 18)
__device__ __forceinline__ unsigned xb_ld(unsigned* p)              { return __hip_atomic_load(p, __ATOMIC_RELAXED, __HIP_MEMORY_SCOPE_AGENT); }
__device__ __forceinline__ unsigned xb_add(unsigned* p, unsigned v) { return __hip_atomic_fetch_add(p, v, __ATOMIC_RELAXED, __HIP_MEMORY_SCOPE_AGENT); }
__device__ __forceinline__ unsigned xb_xcc_id() { return (unsigned)__builtin_amdgcn_s_getreg((3 << 11) | 20) & 0xFu; }
#define XB_SPIN(cond, bar) do { unsigned _sp = 0; while (cond) { __builtin_amdgcn_s_sleep(1); \
    if ((++_sp & 255u) == 0u) { if (xb_ld(&(bar)[XB_TMO])) break; if (_sp > XB_SPIN_CAP) { atomicAdd(&(bar)[XB_TMO], 1u); break; } } } } while (0)
struct XcdBarrier { unsigned* bar; unsigned x; volatile LAS unsigned* st; };
__device__ __forceinline__ XcdBarrier xcd_barrier_post(unsigned* bar, volatile LAS unsigned* st, bool t0) {
    XcdBarrier b; b.bar = bar; b.x = xb_xcc_id(); b.st = st;
    if (t0) (void)xb_add(&bar[XB_XCNT(b.x)], 1u);
    return b;
}
__device__ __forceinline__ void xcd_barrier_complete(unsigned* bar, unsigned x, unsigned& nloc, unsigned& nx) {
    const unsigned G = gridDim.x * gridDim.y * gridDim.z;
    unsigned sum, cnt, mine, sp = 0u;
    for (;;) {
        sum = 0u; cnt = 0u; mine = 0u;
#pragma unroll
        for (unsigned j = 0; j < 16; ++j) { const unsigned c = xb_ld(&bar[XB_XCNT(j)]); sum += c; cnt += (c > 0u) ? 1u : 0u; mine = (j == x) ? c : mine; }
        if (sum == G) break;
        __builtin_amdgcn_s_sleep(1);
        if ((++sp & 255u) == 0u) { if (xb_ld(&bar[XB_TMO])) break; if (sp > XB_SPIN_CAP) { atomicAdd(&bar[XB_TMO], 1u); break; } }
    }
    nloc = mine > 0u ? mine : 1u; nx = cnt > 0u ? cnt : 1u;
}
__device__ __forceinline__ void xcd_barrier(const XcdBarrier& b, bool t0) {
    asm volatile("s_waitcnt vmcnt(0)" ::: "memory");
    __syncthreads();
    if (t0) {
        unsigned* bar = b.bar;
        __builtin_amdgcn_s_waitcnt(0);
        unsigned nloc = b.st[0], nx = b.st[1];
        if (nloc == 0u) { xcd_barrier_complete(bar, b.x, nloc, nx); b.st[0] = nloc; b.st[1] = nx; }
        const unsigned old = xb_add(&bar[XB_XSUB(b.x)], 1u);
        const unsigned gen = old / nloc;
        if (old + 1u == (gen + 1u) * nloc) {
            __builtin_amdgcn_fence(__ATOMIC_RELEASE, "agent");
            asm volatile("s_waitcnt vmcnt(0)" ::: "memory");
            const unsigned og = xb_add(&bar[XB_TOP], 1u);
            const unsigned tg = og / nx;
            if (og + 1u == (tg + 1u) * nx) xb_add(&bar[XB_TOPGEN], 1u);
            else XB_SPIN(xb_ld(&bar[XB_TOPGEN]) == tg, bar);
            __builtin_amdgcn_fence(__ATOMIC_ACQUIRE, "agent");
            xb_add(&bar[XB_XGEN(b.x)], 1u);
            asm volatile("s_waitcnt vmcnt(0)" ::: "memory");
        } else {
            XB_SPIN(xb_ld(&bar[XB_XGEN(b.x)]) == gen, bar);
            __builtin_amdgcn_fence(__ATOMIC_ACQUIRE, "agent");
            asm volatile("s_waitcnt vmcnt(0)" ::: "memory");
        }
    }
    __syncthreads();
}

constexpr int TR_SCR = 64 * 65 * 4;
template <class MAP>
__device__ __forceinline__ void transpose_item(const float* W, int K, int N, bf16_t* WT, LAS float* scr, int item, int lane, const MAP& map, const float* kscale = nullptr, int ldt = 0, int koff = 0) {
    const int kblk = K / 64, nb = item / kblk, kb = item - nb * kblk, k0 = 64 * kb, n0 = 64 * nb;
    const int kr = lane >> 4, nq = 4 * (lane & 15); const bool ok = n0 + nq < N;
    f32x4 v[16];
#pragma unroll
    for (int i = 0; i < 16; ++i) v[i] = (f32x4){0.f, 0.f, 0.f, 0.f};
    if (ok) {
        const float* src = W + (size_t)(k0 + kr) * N + n0 + nq;
#pragma unroll
        for (int i = 0; i < 16; ++i) v[i] = *(const f32x4*)(src + (size_t)(4 * i) * N);
    }
#pragma unroll
    for (int i = 0; i < 16; ++i) asm volatile("" : "+v"(v[i]));
#pragma unroll
    for (int i = 0; i < 16; ++i) { const int k = 4 * i + kr; f32x4 x = v[i]; if (kscale) x = x * kscale[k0 + k];
        LAS float* d = scr + k * 65 + nq; d[0] = x[0]; d[1] = x[1]; d[2] = x[2]; d[3] = x[3]; }
    LDS_WAIT(); asm volatile("" ::: "memory");
    const int c = lane & 7;
#pragma unroll
    for (int j = 0; j < 8; ++j) { const int n = (lane >> 3) + 8 * j; const LAS float* s = scr + (8 * c) * 65 + n;
        u32x4 o; o.x = pg8::cvt_pk_bf16(s[0 * 65], s[1 * 65]); o.y = pg8::cvt_pk_bf16(s[2 * 65], s[3 * 65]); o.z = pg8::cvt_pk_bf16(s[4 * 65], s[5 * 65]); o.w = pg8::cvt_pk_bf16(s[6 * 65], s[7 * 65]);
        const int dr = (n0 + n < N) ? map(n0 + n) : -1;
        if (dr >= 0) *(u32x4*)(WT + (size_t)dr * (ldt ? ldt : K) + koff + k0 + 8 * c) = o; }
    LDS_WAIT(); asm volatile("" ::: "memory");
}
struct MapId { int off; __device__ __forceinline__ int operator()(int n) const { return n + off; } };
template <class MAP>
__device__ __forceinline__ void transpose_item_f8(const float* W, int K, int N, unsigned char* WT, LAS float* scr, int item, int lane, const MAP& map, const float* kscale = nullptr, int ldt = 0, int koff = 0) {
    const int kblk = K / 64, nb = item / kblk, kb = item - nb * kblk, k0 = 64 * kb, n0 = 64 * nb;
    const int kr = lane >> 4, nq = 4 * (lane & 15); const bool ok = n0 + nq < N;
    f32x4 v[16];
#pragma unroll
    for (int i = 0; i < 16; ++i) v[i] = (f32x4){0.f, 0.f, 0.f, 0.f};
    if (ok) {
        const float* src = W + (size_t)(k0 + kr) * N + n0 + nq;
#pragma unroll
        for (int i = 0; i < 16; ++i) v[i] = *(const f32x4*)(src + (size_t)(4 * i) * N);
    }
#pragma unroll
    for (int i = 0; i < 16; ++i) asm volatile("" : "+v"(v[i]));
#pragma unroll
    for (int i = 0; i < 16; ++i) { const int k = 4 * i + kr; f32x4 x = v[i]; if (kscale) x = x * kscale[k0 + k];
        LAS float* d = scr + k * 65 + nq; d[0] = x[0]; d[1] = x[1]; d[2] = x[2]; d[3] = x[3]; }
    LDS_WAIT(); asm volatile("" ::: "memory");
    const int c = lane & 7;
#pragma unroll
    for (int j = 0; j < 8; ++j) { const int n = (lane >> 3) + 8 * j; const LAS float* s = scr + (8 * c) * 65 + n;
        int o0 = 0, o1 = 0;
        o0 = __builtin_amdgcn_cvt_pk_fp8_f32(s[0 * 65] * 32.0f, s[1 * 65] * 32.0f, o0, false); o0 = __builtin_amdgcn_cvt_pk_fp8_f32(s[2 * 65] * 32.0f, s[3 * 65] * 32.0f, o0, true);
        o1 = __builtin_amdgcn_cvt_pk_fp8_f32(s[4 * 65] * 32.0f, s[5 * 65] * 32.0f, o1, false); o1 = __builtin_amdgcn_cvt_pk_fp8_f32(s[6 * 65] * 32.0f, s[7 * 65] * 32.0f, o1, true);
        const int dr = (n0 + n < N) ? map(n0 + n) : -1;
        if (dr >= 0) *(i32x2*)(WT + (size_t)dr * (ldt ? ldt : K) + koff + k0 + 8 * c) = (i32x2){o0, o1}; }
    LDS_WAIT(); asm volatile("" ::: "memory");
}
struct MapIn { __device__ __forceinline__ int operator()(int n) const { if (n < 1440) return n < 1152 ? n : n < 1408 ? n + 128 : n - 256;
    const int g = n - 1440, c = g & 255; return 1536 + (g & ~255) + ((c >> 3) & 1) * 128 + (c >> 6) * 32 + ((c >> 4) & 3) * 8 + (c & 7); } };
struct MapUq { __device__ __forceinline__ int operator()(int n) const { const int h = n / 96, d = n - h * 96;
    return d < 64 ? 256 * (h >> 2) + 128 * (d >> 5) + 32 * (h & 3) + (d & 31) : 512 + 128 * (h >> 2) + 32 * (h & 3) + (d - 64); } };
struct MapUkv { __device__ __forceinline__ int operator()(int n) const { const int h = n >> 7, d = n & 127;
    return d < 64 ? 256 * (h >> 1) + 128 * (d >> 5) + 32 * (h & 1) + (d & 31) : 256 * (h >> 1) + 128 * ((d - 64) >> 5) + 32 * (2 + (h & 1)) + ((d - 64) & 31); } };
struct MapGU { int base; __device__ __forceinline__ int operator()(int d) const { return base + 256 * (d >> 7) + (d & 127); } };

__device__ __forceinline__ void rms_mod_store(const f32x4 (&v)[4], const float* g, const float* sh, const float* sc, unsigned char* orow, int lane) {
    float ss = 0.f;
#pragma unroll
    for (int j = 0; j < 4; ++j) ss += pg8::dot4(v[j]);
    const float r = rsqrtf(wave_sum(ss) * (1.0f / DM) + EPS);
#pragma unroll
    for (int j = 0; j < 4; ++j) { const int col = 4 * lane + 256 * j;
        const f32x4 gg = *(const f32x4*)(g + col), s1 = *(const f32x4*)(sc + col), s0 = *(const f32x4*)(sh + col);
        const f32x4 h = v[j] * r * gg * (1.0f + s1) + s0;
        int w = 0; w = __builtin_amdgcn_cvt_pk_fp8_f32(h[0], h[1], w, false); w = __builtin_amdgcn_cvt_pk_fp8_f32(h[2], h[3], w, true);
        *(int*)(orow + col) = w; }
}
constexpr int NWAVES = 8;
#ifndef MK_N_LAUNCHES
#define MK_N_LAUNCHES 1
#endif
constexpr int N_PHASES = 24;
#ifndef ATTN_SHAPE16
#define ATTN_SHAPE16 0
#endif
#if ATTN_SHAPE16
#define ATTN_BODY attn16::attn_body16
#else
#define ATTN_BODY attn::attn_dense_body
#endif
#ifndef REP_A
#define REP_A 1
#endif
#ifndef REP_D
#define REP_D 1
#endif
#ifndef REP_M
#define REP_M 1
#endif
#ifndef REP_E
#define REP_E 1
#endif
#ifndef REP_C
#define REP_C 1
#endif
#ifndef REP_F
#define REP_F 1
#endif
#ifndef REP_P
#define REP_P 1
#endif
#ifndef REP_B
#define REP_B 1
#endif
#ifndef REP_G
#define REP_G 1
#endif
#ifndef REP_H
#define REP_H 1
#endif
#ifndef REP_K
#define REP_K 1
#endif
#ifndef PHM
#define PHM 0xffff
#endif
#define PH_EN(k) (((PHM) >> (k)) & 1)
struct Args { const float* in[30]; float* out; unsigned char* ws; int ph_lo, ph_hi; };
static_assert(sizeof(Args) == 30 * 8 + 8 + 8 + 8, "Args has no padding");
enum { I_X = 0, I_C, I_CTX, I_CCTX, I_WMOD, I_BMOD, I_N1G, I_N2G, I_WIN, I_POOLW, I_POOLS, I_SGUNG, I_SGUWS, I_SGUB, I_QANG, I_WUQ, I_KVANG, I_WUKV, I_QNG, I_KNG,
       I_WBP, I_WBS, I_WBM, I_BGATE, I_WOUT, I_RW, I_RB, I_WEG, I_WEU, I_WED };

__device__ __forceinline__ void row_bk(int row, int& b, int& key) { if (row < NLAT) { b = row >> 13; key = row & (SEQ - 1); } else { const int r2 = row - NLAT; b = r2 >> 8; key = SEQ + (r2 & 255); } }

__global__ void __launch_bounds__(NWAVES * 64, 2) mk_fwd(Args args) {
    extern __shared__ __attribute__((aligned(16))) unsigned char lds[];
    LAS unsigned char* L = (LAS unsigned char*)lds;
    volatile LAS unsigned* MISC = (volatile LAS unsigned*)(L + MISC_OFF);
    const int wid0 = __builtin_amdgcn_readfirstlane((int)threadIdx.x >> 6);
    const int G = gridDim.x, bx = blockIdx.x;
    const int vcu = (G % 8 == 0) ? (bx % 8) * (G / 8) + bx / 8 : bx;
    const int NGW = G * NWAVES;
#define PH_BEGIN() \
    int tid = hw_tid(wid0); int zs = 0; asm volatile("" : "+v"(tid), "+s"(zs)); \
    const int lane = tid & 63, wid = __builtin_amdgcn_readfirstlane(tid >> 6), gw = vcu * NWAVES + wid; (void)lane; (void)gw; \
    const float* const* in = args.in + zs; unsigned char* ws = args.ws + zs; float* OUT = args.out + zs; (void)in; (void)OUT; \
    unsigned* ctl = (unsigned*)(ws + WS_CTL); (void)ctl; \
    float* MOD = (float*)(ws + WS_MOD); float* cosT = (float*)(ws + WS_ROPE); float* sinT = cosT + 1024; (void)MOD; (void)sinT; \
    u32x4* RT = (u32x4*)(ws + WS_RT); i32x2* POS = (i32x2*)(ws + WS_POS); float* XC = (float*)(ws + WS_XC); (void)RT; (void)POS; (void)XC; \
    bf16_t* XN = (bf16_t*)(ws + WS_XN); bf16_t* Qb = XN; bf16_t* MG = XN; (void)Qb; (void)MG; \
    bf16_t* Kb = (bf16_t*)(ws + WS_K); bf16_t* Vb = (bf16_t*)(ws + WS_V); (void)Kb; (void)Vb; \
    bf16_t* PROJ = (bf16_t*)(ws + WS_PROJ); bf16_t* XS = (bf16_t*)(ws + WS_XS); bf16_t* ACT = (bf16_t*)(ws + WS_ACT); (void)PROJ; (void)XS; (void)ACT; \
    bf16_t* X1B = (bf16_t*)(ws + WS_K); (void)X1B;     \
    bf16_t* WGU = (bf16_t*)(ws + WS_WGU); bf16_t* WDN = (bf16_t*)(ws + WS_WDN); (void)WGU; (void)WDN; \
    unsigned char* wl = ws + WS_W + (size_t)l * W_LAYER; (void)wl; \
    const float* MODL = MOD + (size_t)l * 5 * 6 * DM; (void)MODL;
    for (int u = hw_tid(wid0); u < (LDS_BYTES - MISC_OFF) / 4; u += NWAVES * 64) MISC[u] = 0u;
    __syncthreads();
    unsigned* const barw = (unsigned*)(args.ws + WS_CTL) + CW_BAR;
    XcdBarrier bar; bar.bar = barw; bar.x = 0; bar.st = nullptr;
    if (MK_N_LAUNCHES == 1) bar = xcd_barrier_post(barw, MISC + 8, hw_tid(wid0) == 0);
#define GRID_BAR() do { if (MK_N_LAUNCHES == 1) xcd_barrier(bar, hw_tid(wid0) == 0); } while (0)
    const int lo = args.ph_lo, hi = args.ph_hi;
#define IN(k) (lo <= (k) && (k) < hi)
#define BOTH(k) (IN(k) && IN((k) + 1))

    if (PH_EN(0) && IN(0)) { const int l = 0; PH_BEGIN()
_Pragma("unroll 1")
      for (int rep = 0; rep < REP_P; ++rep) {
        {
            LAS float* SC = (LAS float*)L; LAS float* RED = (LAS float*)(L + 32768);
            for (int i = tid; i < 5 * DM; i += 512) { const int r = i >> 10, k = i & 1023; const float cv = r < 4 ? in[I_C][r * DM + k] : in[I_CCTX][k]; SC[i] = cv / (1.0f + __expf(-cv)); }
            __syncthreads();
            for (int it = vcu; it < 192; it += G) {
                const int l2 = it / 96, cb = it % 96, col = 64 * cb + lane; const float* W = in[I_WMOD] + (size_t)l2 * DM * 6 * DM;
                float a0 = 0.f, a1 = 0.f, a2 = 0.f, a3 = 0.f, a4 = 0.f;
#pragma unroll 8
                for (int kk = 0; kk < 128; ++kk) { const int k = wid * 128 + kk; const float w = W[(size_t)k * (6 * DM) + col];
                    a0 += SC[k] * w; a1 += SC[DM + k] * w; a2 += SC[2 * DM + k] * w; a3 += SC[3 * DM + k] * w; a4 += SC[4 * DM + k] * w; }
                RED[(wid * 5 + 0) * 64 + lane] = a0; RED[(wid * 5 + 1) * 64 + lane] = a1; RED[(wid * 5 + 2) * 64 + lane] = a2; RED[(wid * 5 + 3) * 64 + lane] = a3; RED[(wid * 5 + 4) * 64 + lane] = a4;
                __syncthreads();
                if (tid < 320) { const int r = tid >> 6, cl = tid & 63; float s = 0.f;
#pragma unroll
                    for (int w = 0; w < 8; ++w) s += RED[(w * 5 + r) * 64 + cl];
                    MOD[(size_t)(l2 * 5 + r) * (6 * DM) + 64 * cb + cl] = s + in[I_BMOD][l2 * 6 * DM + 64 * cb + cl]; }
                __syncthreads();
            }
        }
        if (bx == 0) { for (int i = tid; i < 1024; i += 512) { const int p = i >> 3, f = i & 7; const float inv = powf(10000.0f, -((float)f * 2.0f / 16.0f)); const float ang = (float)p * inv; cosT[i] = cosf(ang); sinT[i] = sinf(ang); } }
        {
            __syncthreads();
            LAS float* scr = (LAS float*)(L + wid * TR_SCR);
            constexpr int I_IN = 16 * 71, I_UQ = 6 * 12, I_UKV = 4 * 16, I_BP = 4 * 16, I_BS = 4 * 16, I_BM = 8 * 16, I_OUT = 16 * 16, I_L = I_IN + I_UQ + I_UKV + I_BP + I_BS + I_BM + I_OUT;
            for (int it = gw; it < 2 * I_L; it += NGW) {
                const int l2 = it / I_L; int r = it - l2 * I_L; unsigned char* wl2 = ws + WS_W + (size_t)l2 * W_LAYER;
                if (r < I_IN) { transpose_item_f8(in[I_WIN] + (size_t)l2 * DM * INW_SRC, DM, INW_SRC, wl2 + W_IN, scr, r, lane, MapIn{}); continue; } r -= I_IN;
                if (r < I_UQ) { transpose_item(in[I_WUQ] + (size_t)l2 * QLORA * 768, QLORA, 768, (bf16_t*)(wl2 + W_UQ), scr, r, lane, MapUq{}, in[I_QANG] + l2 * QLORA); continue; } r -= I_UQ;
                if (r < I_UKV) { transpose_item(in[I_WUKV] + (size_t)l2 * KVLORA * 1024, KVLORA, 1024, (bf16_t*)(wl2 + W_UKV), scr, r, lane, MapUkv{}, in[I_KVANG] + l2 * KVLORA); continue; } r -= I_UKV;
                if (r < I_BP) { transpose_item(in[I_WBP] + (size_t)l2 * 256 * DM, 256, DM, (bf16_t*)(wl2 + W_BP) + (size_t)1 * DM * 256, scr, r, lane, MapId{0}); continue; } r -= I_BP;
                if (r < I_BS) { transpose_item(in[I_WBS] + (size_t)l2 * 256 * DM, 256, DM, (bf16_t*)(wl2 + W_BP), scr, r, lane, MapId{0}); continue; } r -= I_BS;
                if (r < I_BM) { const int hf = r >= I_BM / 2 ? 1 : 0; transpose_item(in[I_WBM] + (size_t)l2 * 512 * DM + (size_t)hf * 256 * DM, 256, DM, (bf16_t*)(wl2 + W_BP) + (size_t)(2 + hf) * DM * 256, scr, r - hf * (I_BM / 2), lane, MapId{0}); continue; } r -= I_BM;
                transpose_item(in[I_WOUT] + (size_t)l2 * DM * DM, DM, DM, (bf16_t*)(wl2 + W_OUT), scr, r, lane, MapId{0});
            }
            for (int i = (bx * 512 + tid); i < 2 * 96 * 64; i += G * 512) { const int l2 = i / (96 * 64), r = i % (96 * 64);
                *(u32x4*)(ws + WS_W + (size_t)l2 * W_LAYER + W_IN + (size_t)C_PAD * DM + (size_t)r * 16) = (u32x4){0u, 0u, 0u, 0u}; }
        }
      }
        if (BOTH(0)) GRID_BAR();
    }
    if (PH_EN(1) && IN(1)) { const int l = 0; PH_BEGIN()
_Pragma("unroll 1")
      for (int rep = 0; rep < REP_P; ++rep)
      {
        f32x4 vn[4];
#pragma unroll
        for (int j = 0; j < 4; ++j) vn[j] = (f32x4){0.f, 0.f, 0.f, 0.f};
#define P1_XR(r_) ((r_) < NLAT ? in[I_X] + (size_t)(r_) * DM : in[I_CTX] + (size_t)((r_) - NLAT) * DM)
        if (gw < MROWS) { const float* xr = P1_XR(gw);
#pragma unroll
            for (int j = 0; j < 4; ++j) vn[j] = *(const f32x4*)(xr + 4 * lane + 256 * j); }
        for (int row = gw; row < MROWS; row += NGW) {
            const int mrow = row < NLAT ? (row >> 13) : 4;
            f32x4 v[4];
#pragma unroll
            for (int j = 0; j < 4; ++j) v[j] = vn[j];
            if (row + NGW < MROWS) { const float* xr = P1_XR(row + NGW);
#pragma unroll
                for (int j = 0; j < 4; ++j) vn[j] = *(const f32x4*)(xr + 4 * lane + 256 * j); }
            const float* md = MOD + (size_t)mrow * (6 * DM);
            rms_mod_store(v, in[I_N1G], md, md + DM, (unsigned char*)XN + (size_t)row * DM, lane);
        }
#undef P1_XR
      }
        {
            bf16_t* WRH = (bf16_t*)(ws + WS_WR); bf16_t* WRL = WRH + 2 * 5 * NE * DM; float* CB = (float*)(ws + WS_CB);
            for (int i = bx * 512 + tid; i < 2 * 5 * NE * DM; i += G * 512) { const int k = i & (DM - 1), e = (i >> 10) & 15, lb = i >> 14, l2 = lb / 5;
                const float w = in[I_N2G][l2 * DM + k] * (1.0f + MOD[(size_t)lb * (6 * DM) + 4 * DM + k]) * in[I_RW][k * NE + e];
                const unsigned short h = f2bf(w); WRH[i] = h; WRL[i] = f2bf(w - bf2f(h)); }
            for (int it = gw; it < 2 * 5 * NE; it += NGW) { const int e = it & 15, lb = it >> 4; float p = 0.f;
#pragma unroll 4
                for (int j = 0; j < 16; ++j) { const int k = lane + 64 * j; p += MOD[(size_t)lb * (6 * DM) + 3 * DM + k] * in[I_RW][k * NE + e]; }
                p = wave_sum(p); if (lane == 0) CB[it] = p; }
        }
        if (BOTH(1)) GRID_BAR();
    }

    for (int l = 0; l < DEPTH; ++l) {
        const int pb = 2 + 11 * l;
        const int Mq = (l == 0) ? MROWS : NLAT;
        if (PH_EN(2) && IN(pb + 0)) { PH_BEGIN()
            pg8::Gemm g{XN, (const bf16_t*)(wl + W_IN), DM / 2, DM / 2}; pg8::StaticOrder S; S.init(MROWS, INW, G, bx);
            pg8::EpiInProj E{PROJ, in[I_BGATE] + l * 3 * DM, (float*)(ws + WS_RKV), Kb, in[I_KNG] + l * QKH + 64, cosT, sinT};
_Pragma("unroll 1")
            for (int rep = 0; rep < REP_A; ++rep) pg8::gemm_phase(L, tid, g, S, E);
#if defined(REP_ANULL)
            { pg8::EpiNull EN; pg8::gemm_phase(L, tid, g, S, EN); }
#endif
            if (BOTH(pb + 0)) GRID_BAR();
        }
        if (PH_EN(3) && IN(pb + 1)) { PH_BEGIN()
_Pragma("unroll 1")
            for (int rep = REP_B - 1; rep >= 0; --rep) {
            {
                typedef float f32x16 __attribute__((ext_vector_type(16)));
                const int nchunks = 256 + (l == 0 ? 8 : 0);
                const int ch_ = tid & 255, half = __builtin_amdgcn_readfirstlane(wid >> 2), g4 = __builtin_amdgcn_readfirstlane(wid & 3);
                constexpr int VTP = 136, DBP = 264;
                LAS unsigned short* VT = (LAS unsigned short*)L;
                LAS float* PART = (LAS float*)(L + MISC_OFF + 1024);
                LAS float* RS = (LAS float*)(L + MISC_OFF + 3072);
                LAS unsigned short* PT = (LAS unsigned short*)L;
                LAS unsigned short* DB = (LAS unsigned short*)(L + 73728);
                const float* sgn = in[I_SGUNG] + l * 256; const float* swp = in[I_SGUWS] + (size_t)l * 4 * 128 * 128 + (size_t)g4 * 128 * 128; const float* sbp = in[I_SGUB] + l * 4 * 128 + g4 * 128;
                const float* pwp = in[I_POOLW] + (size_t)l * 4 * 64 * 64 + (size_t)g4 * 64 * 64;
                const int r32 = lane & 31, hi = lane >> 5;
                for (int ck = vcu; ck < nchunks; ck += G) {
                    int ch = ch_; asm volatile("" : "+v"(ch));
                    int row0, seq0, n, t0;
                    if (ck < 256) { row0 = ck * 128; seq0 = (ck >> 6) * SEQ; n = SEQ; t0 = (ck & 63) * 128; }
                    else { const int cc = ck - 256, b_ = cc >> 1; seq0 = NLAT + b_ * CTXL; n = CTXL; t0 = (cc & 1) * 128; row0 = seq0 + t0; }
                    __syncthreads();
                    {
                        float gv[64];
#pragma unroll
                        for (int jj = 0; jj < 64; ++jj) gv[jj] = gelu_tanh(bf2f(PROJ[(size_t)(row0 + half * 64 + jj) * INW + C_V + ch]));
#pragma unroll
                        for (int jj = 0; jj < 64; ++jj) { const float s = wave_sum(gv[jj] * gv[jj]); if (lane == 0) PART[g4 * 128 + half * 64 + jj] = s; }
                        __syncthreads();
                        if (tid < 128) RS[tid] = rsqrtf(((PART[tid] + PART[128 + tid]) + (PART[256 + tid] + PART[384 + tid])) * (1.0f / 256.0f) + EPS);
                        __syncthreads();
                        const float gn = sgn[ch];
#pragma unroll
                        for (int q = 0; q < 8; ++q) { f32x4 a, b;
#pragma unroll
                            for (int e = 0; e < 4; ++e) { a[e] = gv[8 * q + e] * RS[half * 64 + 8 * q + e] * gn; b[e] = gv[8 * q + 4 + e] * RS[half * 64 + 8 * q + 4 + e] * gn; }
                            *(LAS u32x4*)(VT + ch * VTP + half * 64 + 8 * q) = pg8::pack8(a, b); }
                    }
                    __syncthreads();
                    {
#pragma unroll 1
                        for (int it = 0; it < 2; ++it) { const int i0 = half * 64 + it * 32;
                            bf16x8 af[8];
#pragma unroll
                            for (int s8 = 0; s8 < 8; s8 += 4) {
                                f32x4 wa[4], wb[4];
#pragma unroll
                                for (int q = 0; q < 4; ++q) { const float* ap = swp + (i0 + r32) * 128 + 16 * (s8 + q) + 8 * hi; wa[q] = *(const f32x4*)ap; wb[q] = *(const f32x4*)(ap + 4); }
#pragma unroll
                                for (int q = 0; q < 4; ++q) { asm volatile("" : "+v"(wa[q])); asm volatile("" : "+v"(wb[q])); }
#pragma unroll
                                for (int q = 0; q < 4; ++q) { const u32x4 w = pg8::pack8(wa[q], wb[q]); af[s8 + q] = __builtin_bit_cast(bf16x8, w); } }
#pragma unroll 1
                            for (int ct = 0; ct < 2; ++ct) { const int c0 = ct * 32; f32x16 acc = {};
#pragma unroll
                                for (int s8 = 0; s8 < 8; ++s8) { const bf16x8 bfr = *(const LAS bf16x8*)(VT + (g4 * 64 + c0 + r32) * VTP + 16 * s8 + 8 * hi); acc = __builtin_amdgcn_mfma_f32_32x32x16_bf16(af[s8], bfr, acc, 0, 0, 0); }
                                int uv[16]; float sb[16];
#pragma unroll
                                for (int rg = 0; rg < 16; ++rg) { const int i = i0 + (rg & 3) + 8 * (rg >> 2) + 4 * hi; uv[rg] = PROJ[(size_t)(row0 + i) * INW + C_U + g4 * 64 + c0 + r32]; sb[rg] = sbp[i]; }
#pragma unroll
                                for (int rg = 0; rg < 16; ++rg) { asm volatile("" : "+v"(uv[rg])); asm volatile("" : "+v"(sb[rg])); }
#pragma unroll
                                for (int rg = 0; rg < 16; ++rg) { const int i = i0 + (rg & 3) + 8 * (rg >> 2) + 4 * hi; const float mixed = acc[rg] + sb[rg];
                                    bf16_t* up = PROJ + (size_t)(row0 + i) * INW + C_U + g4 * 64 + c0 + r32; bf16_t* uw = (REP_B > 1 && rep > 0) ? XN + (size_t)(row0 + i) * DM + 640 + g4 * 64 + c0 + r32 : up; *uw = f2bf(gelu_tanh(bf2f((unsigned short)uv[rg])) * mixed); }
                            }
                        }
                    }
                    __syncthreads();
#pragma unroll
                    for (int q0 = 0; q0 < 72; q0 += 24) { int pv[24];
#pragma unroll
                        for (int q = 0; q < 24; ++q) { const int t = t0 - 8 + half + 2 * (q0 + q); const int tc = t < 0 ? 0 : (t < n ? t : n - 1); pv[q] = PROJ[(size_t)(seq0 + tc) * INW + C_P + ch]; }
#pragma unroll
                        for (int q = 0; q < 24; ++q) asm volatile("" : "+v"(pv[q]));
#pragma unroll
                        for (int q = 0; q < 24; ++q) { const int rr = half + 2 * (q0 + q), t = t0 - 8 + rr; PT[rr * 256 + ch] = (t >= 0 && t < n) ? (unsigned short)pv[q] : (unsigned short)0; } }
                    __syncthreads();
                    {
                        const int w2 = 1 << g4, i0 = half * 64; float s = 0.f;
                        for (int k = -w2; k < w2; ++k) s += bf2f(PT[(i0 + 8 + k) * 256 + ch]);
#pragma unroll 16
                        for (int jj = 0; jj < 64; ++jj) { const int i = i0 + jj, t = t0 + i; const int tlo = (t - w2 > 0) ? t - w2 : 0, thi = (t + w2 < n) ? t + w2 : n;
                            DB[i * DBP + ch] = f2bf(s / (float)(thi - tlo) - bf2f(PT[(i + 8) * 256 + ch]));
                            s += bf2f(PT[(i + 8 + w2) * 256 + ch]) - bf2f(PT[(i + 8 - w2) * 256 + ch]); }
                    }
                    __syncthreads();
                    {
#pragma unroll 1
                        for (int dt = 0; dt < 2; ++dt) { const int d0 = dt * 32; const float psc = in[I_POOLS][l * 256 + g4 * 64 + d0 + r32];
                            bf16x8 bfr[4];
#pragma unroll
                            for (int s4 = 0; s4 < 4; ++s4) { f32x4 a, b;
#pragma unroll
                                for (int e = 0; e < 4; ++e) { a[e] = pwp[(16 * s4 + 8 * hi + e) * 64 + d0 + r32]; b[e] = pwp[(16 * s4 + 8 * hi + 4 + e) * 64 + d0 + r32]; }
                                const u32x4 w = pg8::pack8(a, b); bfr[s4] = __builtin_bit_cast(bf16x8, w); }
#pragma unroll 1
                            for (int it = 0; it < 2; ++it) { const int i0 = half * 64 + it * 32; f32x16 acc = {};
#pragma unroll
                                for (int s4 = 0; s4 < 4; ++s4) { const bf16x8 afr = *(const LAS bf16x8*)(DB + (i0 + r32) * DBP + g4 * 64 + 16 * s4 + 8 * hi); acc = __builtin_amdgcn_mfma_f32_32x32x16_bf16(afr, bfr[s4], acc, 0, 0, 0); }
#pragma unroll
                                for (int rg = 0; rg < 16; ++rg) { const int i = i0 + (rg & 3) + 8 * (rg >> 2) + 4 * hi;
                                    bf16_t* vw = (REP_B > 1 && rep > 0) ? XN + (size_t)(row0 + i) * DM + g4 * 64 + d0 + r32 : PROJ + (size_t)(row0 + i) * INW + C_V + g4 * 64 + d0 + r32; *vw = f2bf(acc[rg] * psc); }
                            }
                        }
                    }
                }
                __syncthreads();
            }
            }
        }
        if (PH_EN(4) && IN(pb + 2)) { PH_BEGIN()
_Pragma("unroll 1")
            for (int rep = 0; rep < REP_C; ++rep) {
            { pg8::Gemm g{PROJ + C_QA, (const bf16_t*)(wl + W_UQ), INW, QLORA}; pg8::StaticOrder S; S.init(Mq, 768, G, bx);
              pg8::EpiQ E{Qb, in[I_QNG] + l * QKH, cosT, sinT}; pg8::gemm_phase(L, tid, g, S, E); }
            { pg8::Gemm g{PROJ + C_KVA, (const bf16_t*)(wl + W_UKV), INW, KVLORA}; pg8::StaticOrder S; S.init(MROWS, 1024, G, (bx + 112) % G);
              pg8::EpiKV E{Kb, Vb, in[I_KNG] + l * QKH, (const float*)(ws + WS_RKV)}; pg8::gemm_phase(L, tid, g, S, E); }
            }
            if (BOTH(pb + 2)) GRID_BAR();
        }
        if (PH_EN(5) && IN(pb + 3)) { PH_BEGIN()
_Pragma("unroll 1")
            for (int rep = 0; rep < REP_D; ++rep)
            for (int U = vcu; U < NB * NH * (SEQ / 256); U += G) {
                const int bh = U >> 5, qb = U & 31, b = bh >> 3, h = bh & 7; const size_t row0 = (size_t)b * SEQ + qb * 256;
                ATTN_BODY(tid, Qb + row0 * 768 + h * QKH, 768, Kb + (size_t)bh * NKEY * QKH, Vb + (size_t)bh * NKEY * VH, PROJ + row0 * INW + C_ATT + h * VH, INW, NKEY / 64, (char*)lds);
            }
            if (l == 0) for (int U = vcu; U < NB * NH; U += G) {
                const int bh = U, b = bh >> 3, h = bh & 7; const size_t row0 = (size_t)NLAT + b * CTXL;
                ATTN_BODY(tid, Qb + row0 * 768 + h * QKH, 768, Kb + ((size_t)bh * NKEY + SEQ) * QKH, Vb + ((size_t)bh * NKEY + SEQ) * VH, PROJ + row0 * INW + C_ATT + h * VH, INW, CTXL / 64, (char*)lds);
            }
            if (BOTH(pb + 3)) GRID_BAR();
        }
        if (PH_EN(6) && IN(pb + 4)) { PH_BEGIN()
            pg8::MergeOrder S; S.base.init(Mq, 2 * DM, G, bx);
_Pragma("unroll 1")
            for (int rep = 0; rep < REP_E; ++rep) {
            { pg8::Gemm g{PROJ + C_U, (const bf16_t*)(wl + W_BP), INW, 256}; pg8::EpiMergeF E{PROJ, MG}; pg8::gemm_phase(L, tid, g, S, E); }
            }
            if (BOTH(pb + 4)) GRID_BAR();
        }
        if (PH_EN(7) && IN(pb + 5)) { PH_BEGIN()
            pg8::Gemm g{MG, (const bf16_t*)(wl + W_OUT), DM, DM}; pg8::StaticOrder S; S.init(Mq, DM, G, bx);
            pg8::EpiOut E{l == 0 ? in[I_X] : OUT, l == 0 ? in[I_CTX] : XC, X1B, MODL + 2 * DM};
_Pragma("unroll 1")
            for (int rep = 0; rep < (l == 0 ? REP_F : 1); ++rep) pg8::gemm_phase(L, tid, g, S, E);
            if (l == 0 && G == 256 && bx >= 16) {
                LAS float* scr = (LAS float*)(L + wid * TR_SCR);
                constexpr int I_G = 16 * 8, I_D = 8 * 16;
                for (int it = (bx - 16) * NWAVES + wid; it < NE * (2 * I_G + I_D); it += 240 * NWAVES) {
                    const int e = it / (2 * I_G + I_D); int r = it - e * (2 * I_G + I_D);
                    if (r < I_G) { transpose_item(in[I_WEG] + ((size_t)l * NE + e) * DM * DE, DM, DE, WGU, scr, r, lane, MapGU{e * 1024}); continue; } r -= I_G;
                    if (r < I_G) { transpose_item(in[I_WEU] + ((size_t)l * NE + e) * DM * DE, DM, DE, WGU, scr, r, lane, MapGU{e * 1024 + 128}); continue; } r -= I_G;
                    transpose_item(in[I_WED] + ((size_t)l * NE + e) * DE * DM, DE, DM, WDN, scr, r, lane, MapId{e * 1024});
                }
            }
            if (BOTH(pb + 5)) GRID_BAR();
        }
        if (PH_EN(8) && IN(pb + 6)) { PH_BEGIN()
_Pragma("unroll 1")
            for (int rep = REP_G - 1; rep >= 0; --rep) {
            {
                volatile LAS unsigned* HC = MISC + 64;
                __syncthreads();
                {
                    LAS float* scr = (LAS float*)(L + wid * TR_SCR);
                    constexpr int I_G = 16 * 8, I_D = 8 * 16;
                    for (int it = (l == 0 && G == 256) ? NE * (2 * I_G + I_D) : gw; it < NE * (2 * I_G + I_D); it += NGW) {
                        const int e = it / (2 * I_G + I_D); int r = it - e * (2 * I_G + I_D);
                        if (r < I_G) { transpose_item(in[I_WEG] + ((size_t)l * NE + e) * DM * DE, DM, DE, WGU, scr, r, lane, MapGU{e * 1024}); continue; } r -= I_G;
                        if (r < I_G) { transpose_item(in[I_WEU] + ((size_t)l * NE + e) * DM * DE, DM, DE, WGU, scr, r, lane, MapGU{e * 1024 + 128}); continue; } r -= I_G;
                        transpose_item(in[I_WED] + ((size_t)l * NE + e) * DE * DM, DE, DM, WDN, scr, r, lane, MapId{e * 1024});
                    }
                }
                __syncthreads();
                if (tid < 16) HC[tid] = 0u;
                __syncthreads();
                {
                    typedef float f32x4_ __attribute__((ext_vector_type(4)));
                    const bf16_t* WRH = (const bf16_t*)(ws + WS_WR); const float* CB = (const float*)(ws + WS_CB) + l * 5 * NE;
                    const float* n2g = in[I_N2G] + l * DM; const float* rb = in[I_RB];
                    const int r16 = lane & 15, q4 = lane >> 4, c0w = 128 * wid + 8 * q4;
                    LAS f32x4_* accP = (LAS f32x4_*)L; LAS float* ssP = (LAS float*)(L + 16384);
                    const int NGRP = Mq / 16; int par = 0;
                    u32x4 xh[4];
#define G_XROW(grp_) (X1B + (size_t)((grp_) * 16 + r16) * DM + c0w)
                    LAS unsigned char* xsl = L + 20480 + wid * 8192;
                    if (vcu < NGRP) { const bf16_t* xr = G_XROW(vcu);
#pragma unroll
                        for (int s = 0; s < 4; ++s) __builtin_amdgcn_global_load_lds((const unsigned*)(xr + 32 * s), (LAS unsigned*)(xsl + s * 1024), 16, 0, 0); }
                    for (int grp = vcu; grp < NGRP; grp += G) {
                        const int R0 = grp * 16; const bool lat = R0 < NLAT; const int mrow = lat ? (R0 >> 13) : 4;
                        int c0v = c0w; asm volatile("" : "+v"(c0v));
                        asm volatile("s_waitcnt vmcnt(0)" ::: "memory");
#pragma unroll
                        for (int s = 0; s < 4; ++s) xh[s] = *(const LAS u32x4*)(xsl + s * 1024 + lane * 16);
                        asm volatile("s_waitcnt lgkmcnt(0)" ::: "memory");
                        if (grp + G < NGRP) { const bf16_t* xr = G_XROW(grp + G);
#pragma unroll
                            for (int s = 0; s < 4; ++s) __builtin_amdgcn_global_load_lds((const unsigned*)(xr + 32 * s), (LAS unsigned*)(xsl + s * 1024), 16, 0, 0); }
                        const bf16_t* bh = WRH + ((size_t)((l * 5 + mrow) * NE + r16)) * DM + c0v; const bf16_t* bl = bh + 2 * 5 * NE * DM;
                        f32x4_ acc = {0.f, 0.f, 0.f, 0.f}; float ss = 0.f;
#pragma unroll
                        for (int s = 0; s < 4; ++s) { f32x4 a, b; pg8::unpack8(xh[s], a, b); ss += pg8::dot4(a) + pg8::dot4(b);
                            const bf16x8 fh = __builtin_bit_cast(bf16x8, xh[s]); const bf16x8 wh = *(const bf16x8*)(bh + 32 * s), wl = *(const bf16x8*)(bl + 32 * s);
                            acc = __builtin_amdgcn_mfma_f32_16x16x32_bf16(fh, wh, acc, 0, 0, 0); acc = __builtin_amdgcn_mfma_f32_16x16x32_bf16(fh, wl, acc, 0, 0, 0); }
                        ss += __shfl_xor(ss, 16); ss += __shfl_xor(ss, 32);
                        accP[(par * 8 + wid) * 64 + lane] = acc; if (q4 == 0) ssP[(par * 8 + wid) * 16 + r16] = ss;
                        __syncthreads();
                        f32x4_ at = {0.f, 0.f, 0.f, 0.f}; float st = 0.f;
#pragma unroll
                        for (int w = 0; w < 8; ++w) { at += accP[(par * 8 + w) * 64 + lane]; st += ssP[(par * 8 + w) * 16 + r16]; }
                        const float rs = rsqrtf(st * (1.0f / DM) + EPS);
                        {   const float* md = MODL + (size_t)mrow * (6 * DM) + c0v; bf16_t* orow = XN + (size_t)(R0 + r16) * DM + c0v;
#pragma unroll
                            for (int s = 0; s < 4; ++s) { f32x4 a, b; pg8::unpack8(xh[s], a, b);
                                const f32x4 g0 = *(const f32x4*)(n2g + c0v + 32 * s), g1 = *(const f32x4*)(n2g + c0v + 32 * s + 4);
                                const f32x4 c0 = *(const f32x4*)(md + 4 * DM + 32 * s), c1 = *(const f32x4*)(md + 4 * DM + 32 * s + 4), h0 = *(const f32x4*)(md + 3 * DM + 32 * s), h1 = *(const f32x4*)(md + 3 * DM + 32 * s + 4);
                                *(u32x4*)(orow + 32 * s) = pg8::pack8(a * rs * g0 * (1.0f + c0) + h0, b * rs * g1 * (1.0f + c1) + h1);
                                if (s & 1) asm volatile("" ::: "memory"); } }
                        par ^= 1;
                        if (REP_G > 1 && rep > 0) continue;
                        if (wid < 4) {
                            const int rg = wid;
                            const float cbe = CB[mrow * NE + r16], rbe = rb[r16];
                            const float arg = rg == 0 ? at[0] : rg == 1 ? at[1] : rg == 2 ? at[2] : at[3];
                            const float rsr = __shfl(rs, 4 * q4 + rg);
                            const float lg = arg * rsr + cbe; const float sc = 1.0f / (1.0f + expf(-lg)); const float sl = sc + rbe;
                            const int qb = lane & ~3, rw16 = lane & ~15;
                            const float a = __shfl(sl, qb), b = __shfl(sl, qb + 1), c = __shfl(sl, qb + 2), d = __shfl(sl, qb + 3);
                            const float h1 = fmaxf(a, b), l1 = fminf(a, b), h2 = fmaxf(c, d), l2 = fminf(c, d); const float gsc = fmaxf(h1, h2) + fmaxf(fminf(h1, h2), fmaxf(l1, l2));
                            const float g0 = __shfl(gsc, rw16), g1 = __shfl(gsc, rw16 + 4), g2 = __shfl(gsc, rw16 + 8), g3 = __shfl(gsc, rw16 + 12);
                            int best = 0; float bv = g0; if (g1 > bv) { bv = g1; best = 1; } if (g2 > bv) { bv = g2; best = 2; } if (g3 > bv) { bv = g3; best = 3; }
                            const int bl4 = rw16 + 4 * best;
                            float s4[4], c4[4];
#pragma unroll
                            for (int i = 0; i < 4; ++i) { s4[i] = __shfl(sl, bl4 + i); c4[i] = __shfl(sc, bl4 + i); }
                            int i1 = 0; float m1 = s4[0];
#pragma unroll
                            for (int i = 1; i < 4; ++i) if (s4[i] > m1) { m1 = s4[i]; i1 = i; }
                            int i2 = -1; float m2 = -3.0e38f;
#pragma unroll
                            for (int i = 0; i < 4; ++i) if (i != i1 && s4[i] > m2) { m2 = s4[i]; i2 = i; }
                            const float w1 = i1 == 0 ? c4[0] : i1 == 1 ? c4[1] : i1 == 2 ? c4[2] : c4[3], w2 = i2 == 0 ? c4[0] : i2 == 1 ? c4[1] : i2 == 2 ? c4[2] : c4[3];
                            const float ws_ = w1 + w2; const int e0 = best * 4 + i1, e1 = best * 4 + i2;
                            if (r16 == 0) { RT[R0 + 4 * q4 + rg] = (u32x4){(unsigned)e0, (unsigned)e1, __float_as_uint(w1 / ws_), __float_as_uint(w2 / ws_)};
                                __hip_atomic_fetch_add((LAS unsigned*)&HC[e0], 1u, __ATOMIC_RELAXED, __HIP_MEMORY_SCOPE_WORKGROUP); __hip_atomic_fetch_add((LAS unsigned*)&HC[e1], 1u, __ATOMIC_RELAXED, __HIP_MEMORY_SCOPE_WORKGROUP); }
                        }
                    }
#undef G_XROW
                }
                __syncthreads();
                if (tid < 16) atomicAdd(ctl + CW_CNT + 64 * l + tid, HC[tid]);
                __syncthreads();
            }
            }
            if (BOTH(pb + 6)) GRID_BAR();
        }
        if (PH_EN(9) && IN(pb + 7)) { PH_BEGIN()
            {
                volatile LAS unsigned* HC = MISC + 64; volatile LAS unsigned* HB = MISC + 96; volatile LAS unsigned* EB = MISC + 128; volatile LAS unsigned* CN = MISC + 160;
                int* TOK = (int*)(ws + WS_TOK);
                const int rpb = Mq / G;
                if (tid < 16) HC[tid] = 0u;
                __syncthreads();
                int e0 = 0, e1 = 0, r0 = 0, r1 = 0; const int row = vcu * rpb + tid;
                if (tid < rpb) { const u32x4 rt = RT[row]; e0 = (int)rt.x; e1 = (int)rt.y;
                    r0 = (int)__hip_atomic_fetch_add((LAS unsigned*)&HC[e0], 1u, __ATOMIC_RELAXED, __HIP_MEMORY_SCOPE_WORKGROUP); r1 = (int)__hip_atomic_fetch_add((LAS unsigned*)&HC[e1], 1u, __ATOMIC_RELAXED, __HIP_MEMORY_SCOPE_WORKGROUP); }
                __syncthreads();
                if (tid < 16) { unsigned base = 0u, mine = 0u;
                    for (int j = 0; j < 16; ++j) { const unsigned c = __hip_atomic_load(ctl + CW_CNT + 64 * l + j, __ATOMIC_RELAXED, __HIP_MEMORY_SCOPE_AGENT); if (j < tid) base += (c + 255u) & ~255u; if (j == tid) mine = c; }
                    EB[tid] = base; CN[tid] = mine; HB[tid] = atomicAdd(ctl + CW_CUR + 64 * l + tid, HC[tid]); }
                __syncthreads();
                if (tid < rpb) { const int p0 = (int)(EB[e0] + HB[e0]) + r0, p1 = (int)(EB[e1] + HB[e1]) + r1; POS[row] = (i32x2){p0, p1}; TOK[p0] = row; TOK[p1] = row; }
                if (vcu < 16) { const unsigned st = EB[vcu] + CN[vcu], en = EB[vcu] + ((CN[vcu] + 255u) & ~255u);
                    for (unsigned i = st + tid; i < en; i += 512) TOK[i] = 0; }
                __syncthreads();
            }
            if (BOTH(pb + 7)) GRID_BAR();
        }
        if ((PH_EN(10) || PH_EN(11)) && (IN(pb + 8) || IN(pb + 9))) { PH_BEGIN()
            int tbv[16], nun; { int t = 0;
#pragma unroll
                for (int j = 0; j < 16; ++j) { tbv[j] = t; const int c = __builtin_amdgcn_readfirstlane((int)__hip_atomic_load(ctl + CW_CNT + 64 * l + j, __ATOMIC_RELAXED, __HIP_MEMORY_SCOPE_AGENT)); t += (c + 255) >> 8; }
                nun = 4 * t; }
            if (PH_EN(10) && IN(pb + 8)) {
                pg8::MoeOrder<true> S; S.tok = (const int*)(ws + WS_TOK); S.G = G; S.c = vcu; S.nunits = nun;
#pragma unroll
                for (int j = 0; j < 16; ++j) S.tb[j] = tbv[j];
                pg8::Gemm g{XN, WGU, DM, DM}; pg8::EpiMoe1 E{ACT};
_Pragma("unroll 1")
                for (int rep = 0; rep < REP_M; ++rep) pg8::gemm_phase(L, tid, g, S, E);
                if (BOTH(pb + 8)) GRID_BAR();
            }
            if (PH_EN(11) && IN(pb + 9)) {
                pg8::MoeOrder<false> S; S.tok = nullptr; S.G = G; S.c = vcu; S.nunits = nun;
#pragma unroll
                for (int j = 0; j < 16; ++j) S.tb[j] = tbv[j];
                pg8::Gemm g{ACT, WDN, DE, DE}; pg8::EpiMoe2 E{XS};
_Pragma("unroll 1")
                for (int rep = 0; rep < REP_M; ++rep) pg8::gemm_phase(L, tid, g, S, E);
                if (BOTH(pb + 9)) GRID_BAR();
            }
        }
        if (PH_EN(12) && IN(pb + 10)) { PH_BEGIN()
_Pragma("unroll 1")
            for (int rep = REP_K - 1; rep >= 0; --rep) {
            {
                const bool last = (l == DEPTH - 1);
#define K_XR(r_) ((r_) < NLAT ? OUT + (size_t)(r_) * DM : XC + (size_t)((r_) - NLAT) * DM)
#define K_LOAD(A_, B_, X_, ps_, r_) do { const bf16_t* y0_ = XS + (size_t)(ps_).x * DM; const bf16_t* y1_ = XS + (size_t)(ps_).y * DM; const bf16_t* xr_ = X1B + (size_t)(r_) * DM; \
        _Pragma("unroll") for (int j = 0; j < 4; ++j) { const int col = 4 * lane + 256 * j; A_[j] = *(const u32x2*)(y0_ + col); B_[j] = *(const u32x2*)(y1_ + col); X_[j] = *(const u32x2*)(xr_ + col); } } while (0)
                u32x4 rt0 = {0u, 0u, 0u, 0u}, rt1 = {0u, 0u, 0u, 0u}; i32x2 ps0 = {0, 0}, ps1 = {0, 0};
                u32x2 ad[4], bd[4], xd[4];
#pragma unroll
                for (int j = 0; j < 4; ++j) { ad[j] = (u32x2){0u, 0u}; bd[j] = (u32x2){0u, 0u}; xd[j] = (u32x2){0u, 0u}; }
                if (gw < Mq) { rt0 = RT[gw]; ps0 = POS[gw]; }
                if (gw + NGW < Mq) { rt1 = RT[gw + NGW]; ps1 = POS[gw + NGW]; }
                if (gw < Mq) K_LOAD(ad, bd, xd, ps0, gw);
                for (int row = gw; row < Mq; row += NGW) {
                    float* xr = K_XR(row); const int mrow = row < NLAT ? (row >> 13) : 4;
                    const float* md = MODL + (size_t)mrow * (6 * DM);
                    const float w0 = __uint_as_float(rt0.z), w1 = __uint_as_float(rt0.w);
                    u32x4 rt2 = {0u, 0u, 0u, 0u}; i32x2 ps2 = {0, 0};
                    if (row + 2 * NGW < Mq) { rt2 = RT[row + 2 * NGW]; ps2 = POS[row + 2 * NGW]; }
                    u32x2 an[4], bn[4], xn[4];
#pragma unroll
                    for (int j = 0; j < 4; ++j) { an[j] = ad[j]; bn[j] = bd[j]; xn[j] = xd[j]; }
                    if (row + NGW < Mq) K_LOAD(an, bn, xn, ps1, row + NGW);
                    f32x4 v[4];
#pragma unroll
                    for (int j = 0; j < 4; ++j) { const int col = 4 * lane + 256 * j;
                        const u32x2 a = ad[j], b = bd[j];
                        f32x4 ya, yb; ya[0] = __uint_as_float(a.x << 16); ya[1] = __uint_as_float(a.x & 0xffff0000u); ya[2] = __uint_as_float(a.y << 16); ya[3] = __uint_as_float(a.y & 0xffff0000u);
                        yb[0] = __uint_as_float(b.x << 16); yb[1] = __uint_as_float(b.x & 0xffff0000u); yb[2] = __uint_as_float(b.y << 16); yb[3] = __uint_as_float(b.y & 0xffff0000u);
                        const f32x4 g2 = *(const f32x4*)(md + 5 * DM + col);
                        f32x4 x1; x1[0] = __uint_as_float(xd[j].x << 16); x1[1] = __uint_as_float(xd[j].x & 0xffff0000u); x1[2] = __uint_as_float(xd[j].y << 16); x1[3] = __uint_as_float(xd[j].y & 0xffff0000u);
                        v[j] = x1 + g2 * (ya * w0 + yb * w1);
                        float* xw = (REP_K > 1 && rep > 0) ? (float*)Kb + (size_t)(row & 8191) * DM : xr; *(f32x4*)(xw + col) = v[j]; }
                    if (!last) { const float* md1 = MOD + (size_t)((l + 1) * 5 + mrow) * (6 * DM); rms_mod_store(v, in[I_N1G] + (l + 1) * DM, md1, md1 + DM, (unsigned char*)XN + (size_t)row * DM, lane); }
                    rt0 = rt1; ps0 = ps1; rt1 = rt2; ps1 = ps2;
#pragma unroll
                    for (int j = 0; j < 4; ++j) { ad[j] = an[j]; bd[j] = bn[j]; xd[j] = xn[j]; }
                }
#undef K_LOAD
#undef K_XR
            }
            }
            if (BOTH(pb + 10)) GRID_BAR();
        }
    }
#undef IN
#undef BOTH
#undef GRID_BAR
}

extern "C" void kernel_launch(void* const* d_in, const int* in_sizes, int n_in, void* d_out, int out_size, void* d_ws, size_t ws_size, hipStream_t stream) {
    static int grid = 0;
    if (grid == 0) {
        if (n_in != 30 || out_size != NLAT * DM || ws_size < WS_END) { fprintf(stderr, "kernel_launch: unexpected shapes: n_in %d out %d ws %zu (need %zu)\n", n_in, out_size, ws_size, (size_t)WS_END); grid = -1; return; }
        int dev = 0, cus = 0;
        if (hipGetDevice(&dev) != hipSuccess || hipDeviceGetAttribute(&cus, hipDeviceAttributeMultiprocessorCount, dev) != hipSuccess) { grid = -1; return; }
        if (hipFuncSetAttribute((const void*)mk_fwd, hipFuncAttributeMaxDynamicSharedMemorySize, LDS_BYTES) != hipSuccess) { fprintf(stderr, "kernel_launch: hipFuncSetAttribute failed\n"); grid = -1; return; }
        int per_cu = 0;
        if (hipOccupancyMaxActiveBlocksPerMultiprocessor(&per_cu, (const void*)mk_fwd, NWAVES * 64, LDS_BYTES) != hipSuccess || per_cu < 1) fprintf(stderr, "kernel_launch: occupancy query says %d per CU\n", per_cu);
        (void)hipGetLastError();
        grid = 256;
        if (cus != 256) fprintf(stderr, "kernel_launch: device has %d CUs, kernel is built for 256\n", cus);
    }
    if (grid < 0) return;
    (void)hipMemsetAsync((char*)d_ws + WS_CTL, 0, CTL_ZERO_BYTES, stream);
    Args a{};
    for (int i = 0; i < 30; ++i) a.in[i] = (const float*)d_in[i];
    a.out = (float*)d_out; a.ws = (unsigned char*)d_ws;
    if (MK_N_LAUNCHES == 1) { a.ph_lo = 0; a.ph_hi = N_PHASES; hipLaunchKernelGGL(mk_fwd, dim3(grid), dim3(NWAVES * 64), LDS_BYTES, stream, a); }
    else for (int p = 0; p < N_PHASES; ++p) { a.ph_lo = p; a.ph_hi = p + 1; hipLaunchKernelGGL(mk_fwd, dim3(grid), dim3(NWAVES * 64), LDS_BYTES, stream, a); }
    const hipError_t le = hipPeekAtLastError();
    if (le != hipSuccess) fprintf(stderr, "kernel_launch: launch failed: %s\n", hipGetErrorName(le));
}
```

```cpp
#include <hip/hip_runtime.h>
#include <cstdio>
#include <cstdint>
#ifndef MOE1_FP8
#define MOE1_FP8 1
#endif
#ifndef XS_FP8
#define XS_FP8 1
#endif
#ifndef MOE2_FP8
#define MOE2_FP8 1
#endif
#ifndef MK_N_LAUNCHES
#define MK_N_LAUNCHES 1
#endif

constexpr int DM = 1024, NB = 4, SEQ = 8192, CTXL = 256, DEPTH = 2;
constexpr int NLAT = NB * SEQ;
constexpr int NCTX = NB * CTXL;
constexpr int MROWS = NLAT + NCTX;
constexpr int NKEY = SEQ + CTXL;
constexpr int NH = 8, QKN = 64, QKR = 32, QKH = 96, VH = 64;
constexpr int QLORA = 384, KVLORA = 256;
constexpr int INW_SRC = 4512, INW = 4608;
constexpr int C_P = 0, C_U = 256, C_V = 512, C_QA = 768, C_KR = 1152, C_PAD = 1184, C_KVA = 1280, C_GATE = 1536, C_ATT = 768;
constexpr int NE = 16, DE = 512;
constexpr float EPS = 1e-6f;
constexpr int MOE_ROWS = 2 * MROWS + 16 * 256;

constexpr size_t MiB = 1u << 20;
constexpr size_t WS_CTL = 0, CTL_ZERO_BYTES = 1 * MiB;
constexpr size_t WS_MOD = 1 * MiB;
constexpr size_t WS_ROPE = 1 * MiB + 256 * 1024;
constexpr size_t WS_RKV = 1 * MiB + 384 * 1024;
constexpr size_t WS_RT = 2 * MiB;
constexpr size_t WS_POS = 2 * MiB + 640 * 1024;
constexpr size_t WS_WR = 3 * MiB;
constexpr size_t WS_CB = 3 * MiB + 704 * 1024;
constexpr size_t WS_GT = 3 * MiB + 720 * 1024;
constexpr size_t WS_XC = 4 * MiB;
constexpr size_t WS_W = 8 * MiB, W_LAYER = 15 * MiB;
constexpr size_t W_IN = 0, W_UQ = W_IN + (size_t)INW * DM * 2, W_UKV = W_UQ + (size_t)768 * QLORA * 2, W_BP = W_UKV + (size_t)1024 * KVLORA * 2,
                 W_BS = W_BP + (size_t)DM * 256 * 2, W_BM = W_BS + (size_t)DM * 256 * 2, W_OUT = W_BM + (size_t)DM * 512 * 2, W_END = W_OUT + (size_t)DM * DM * 2;
static_assert(W_END <= W_LAYER, "weights per layer");
constexpr size_t WS_XN = 38 * MiB;
constexpr size_t WS_K = 104 * MiB;
constexpr size_t WS_V = 154 * MiB;
constexpr size_t WS_PROJ = 188 * MiB;
constexpr size_t WS_XS = WS_PROJ;
constexpr size_t WS_ACT = WS_PROJ + 140 * MiB;
constexpr size_t WS_WGU = WS_PROJ + 210 * MiB;
constexpr size_t WS_WDN = WS_PROJ + 242 * MiB;
constexpr size_t WS_END = WS_PROJ + 297 * MiB;
constexpr int TOKCAP = 34048;
constexpr size_t WS_TOK2 = WS_ACT + 36 * MiB;
static_assert(MOE2_FP8 == 1 && (size_t)MOE_ROWS * DE <= 36 * MiB && 36 * MiB + (size_t)16 * TOKCAP * 4 <= 70 * MiB && TOKCAP % 256 == 0 && TOKCAP >= MROWS + 256, "token lists");
static_assert(WS_K + (size_t)NB * NH * NKEY * 96 * 2 <= WS_V && WS_V + (size_t)NB * NH * NKEY * 64 * 2 <= WS_PROJ && WS_XN + (size_t)MROWS * DM * 2 <= WS_K, "ws map");
static_assert((size_t)MOE_ROWS * DM * 2 <= 140 * MiB && (size_t)MOE_ROWS * DE * 2 <= 70 * MiB && WS_WDN + (size_t)NE * DM * DE * 2 <= WS_END && (size_t)MROWS * INW * 2 <= 297 * MiB, "ws map 2");
constexpr int CW_BAR = 4096;
constexpr int CW_CNT = 1024;
constexpr int CW_CUR = 1536;

constexpr int LDS_BYTES = 147456;
constexpr int MISC_OFF = 141312;
namespace pg8 {
#define PG8_LAS __attribute__((address_space(3)))
typedef unsigned short bf16_t;
typedef short bf16x8 __attribute__((ext_vector_type(8)));
typedef float f32x4 __attribute__((ext_vector_type(4)));
typedef unsigned u32x4 __attribute__((ext_vector_type(4)));
typedef unsigned u32x2 __attribute__((ext_vector_type(2)));
constexpr int BM = 256, BK = 64, HALF = 128, HTB = HALF * BK * 2, STAGE_BYTES = 8 * HTB, NXCD = 8, WGM = 8;

__host__ __device__ __forceinline__ int lds_byte(int r, int c) { const int st = (r >> 4) * 2 + (c >> 5), rr = r & 15, cc = c & 31, ob = rr * 64 + cc * 2; return st * 1024 + (ob ^ (((ob >> 9) & 1) << 5)); }
__host__ __device__ __forceinline__ void stage_rc(int b, int& R, int& C) { const int st = b / 1024, sb = b % 1024, swz = sb ^ (((sb >> 9) & 1) << 5); R = (st >> 1) * 16 + swz / 64; C = (st & 1) * 32 + (swz % 64) / 2; }
__host__ __device__ __forceinline__ int perm32(int rho) { const int n = rho >> 4, i = rho & 15; return 8 * (i >> 2) + 4 * n + (i & 3); }

struct Unit { int pm, pn; };
struct Gemm { const bf16_t* A; const bf16_t* Bt; int lda, K; };

struct StaticOrder {
    static constexpr bool GATHER = false; const int* tok;
    int nM, nN, nwg, G, c;
    __device__ __forceinline__ void init(int M, int N, int G_, int c_) { nM = M / BM; nN = N / BM; nwg = nM * nN; G = G_; c = c_; }
    __device__ __forceinline__ bool next(int i, Unit& u) const {
        const long L = (long)i * G + c; if (L >= nwg) return false;
        int wgid = (int)L; { const int q = nwg / NXCD, r = nwg % NXCD, xcd = wgid % NXCD, off = wgid / NXCD; wgid = (xcd < r ? xcd * (q + 1) : r * (q + 1) + (xcd - r) * q) + off; }
        const int nig = WGM * nN, gid = wgid / nig, fm = gid * WGM, gsz = (nM - fm) < WGM ? (nM - fm) : WGM;
        const int w = wgid % nig;
        if (gsz == WGM) { u.pm = fm + (w & 7); u.pn = w >> 3; } else { u.pm = fm + (w & 3); u.pn = w >> 2; }
        return true;
    }
    __device__ __forceinline__ size_t acol(const Unit&) const { return 0; }
    __device__ __forceinline__ int trow(const Unit& u) const { return u.pm * 256; }
    __device__ __forceinline__ bool keep_acc(const Unit&) const { return false; }
    __device__ __forceinline__ void a_ready(const Unit&) const {}
    __device__ __forceinline__ void done(const Unit&) const {}
};

struct MergeOrder {
    static constexpr bool GATHER = false; const int* tok; StaticOrder base;
    __device__ __forceinline__ bool next(int i, Unit& u) const { Unit b; if (!base.next(i >> 2, b)) return false; u.pm = b.pm; u.pn = (i & 3) * 8 + b.pn; return true; }
    __device__ __forceinline__ size_t acol(const Unit& u) const { return (size_t)(u.pn >> 3) * 512; }
    __device__ __forceinline__ int trow(const Unit& u) const { return u.pm * 256; }
    __device__ __forceinline__ bool keep_acc(const Unit& u) const { return (u.pn >> 3) == 2; }
    __device__ __forceinline__ void a_ready(const Unit&) const {}
    __device__ __forceinline__ void done(const Unit&) const {}
};
template <bool GA> struct MoeOrder {
    static constexpr bool GATHER = GA;
    const int* tok; int G, c, nunits; int tb[16];
    __device__ __forceinline__ bool next(int i, Unit& u) const {
        const int L = i * G + c; if (L >= nunits) return false;
        const int pm = L >> 2, pnl = L & 3; int e = 0;
#pragma unroll
        for (int j = 1; j < 16; ++j) e += (pm >= tb[j]) ? 1 : 0;
        u.pm = pm; u.pn = e * 4 + pnl; return true;
    }
    __device__ __forceinline__ size_t acol(const Unit&) const { return 0; }
    __device__ __forceinline__ int trow(const Unit& u) const {
        int te = 0;
#pragma unroll
        for (int j = 1; j < 16; ++j) te = (u.pm >= tb[j]) ? tb[j] : te;
        return (u.pn >> 2) * TOKCAP + (u.pm - te) * 256; }
    __device__ __forceinline__ bool keep_acc(const Unit&) const { return false; }
    __device__ __forceinline__ void a_ready(const Unit&) const {}
    __device__ __forceinline__ void done(const Unit&) const {}
};

typedef float f32x2_t __attribute__((ext_vector_type(2))); typedef __bf16 bf16x2_t __attribute__((ext_vector_type(2)));
__device__ __forceinline__ unsigned cvt_pk_bf16(float lo, float hi) { const f32x2_t v = {lo, hi}; return __builtin_bit_cast(unsigned, __builtin_convertvector(v, bf16x2_t)); }
__device__ __forceinline__ u32x4 pack8(const f32x4 a, const f32x4 b) { u32x4 w; w.x = cvt_pk_bf16(a[0], a[1]); w.y = cvt_pk_bf16(a[2], a[3]); w.z = cvt_pk_bf16(b[0], b[1]); w.w = cvt_pk_bf16(b[2], b[3]); return w; }
__device__ __forceinline__ u32x2 pack8_f8(const f32x4 a, const f32x4 b, const float s) { int o0 = 0, o1 = 0;
    o0 = __builtin_amdgcn_cvt_pk_fp8_f32(a[0] * s, a[1] * s, o0, false); o0 = __builtin_amdgcn_cvt_pk_fp8_f32(a[2] * s, a[3] * s, o0, true);
    o1 = __builtin_amdgcn_cvt_pk_fp8_f32(b[0] * s, b[1] * s, o1, false); o1 = __builtin_amdgcn_cvt_pk_fp8_f32(b[2] * s, b[3] * s, o1, true);
    return (u32x2){(unsigned)o0, (unsigned)o1}; }
__device__ __forceinline__ void unpack8(const u32x4 w, f32x4& a, f32x4& b) {
    a[0] = __uint_as_float(w.x << 16); a[1] = __uint_as_float(w.x & 0xffff0000u); a[2] = __uint_as_float(w.y << 16); a[3] = __uint_as_float(w.y & 0xffff0000u);
    b[0] = __uint_as_float(w.z << 16); b[1] = __uint_as_float(w.z & 0xffff0000u); b[2] = __uint_as_float(w.w << 16); b[3] = __uint_as_float(w.w & 0xffff0000u); }
__device__ __forceinline__ float sigmoidf_fast(float x) { return __builtin_amdgcn_rcpf(1.0f + __builtin_amdgcn_exp2f(-1.4426950408889634f * x)); }
__device__ __forceinline__ f32x4 sigmoid4(const f32x4 v) { f32x4 o; o[0] = sigmoidf_fast(v[0]); o[1] = sigmoidf_fast(v[1]); o[2] = sigmoidf_fast(v[2]); o[3] = sigmoidf_fast(v[3]); return o; }
__device__ __forceinline__ float dot4(const f32x4 v) { return (v[0] * v[0] + v[1] * v[1]) + (v[2] * v[2] + v[3] * v[3]); }


template <class Epi, class Sched>
__device__ __forceinline__ void gemm_phase(PG8_LAS unsigned char* lds, int tid_in, const Gemm g, const Sched& S, const Epi& E) {
    int tid_ = tid_in; asm volatile("" : "+v"(tid_));
    const int tid = tid_, wid = __builtin_amdgcn_readfirstlane(tid >> 6), lane = tid & 63, wr = wid >> 2, wc = wid & 3, fr = lane & 15, fq = lane >> 4;
    constexpr int NB = Epi::NB;
    const int K = g.K, nt = K / BK, lda = g.lda;
    unsigned voffA[2], voffB[2]; int Rv[2]; unsigned cv2[2];
#pragma unroll
    for (int i = 0; i < 2; ++i) { int R, C; stage_rc(tid * 16 + i * 8192, R, C); const int Rb = Epi::PERM ? ((R & ~31) + perm32(R & 31)) : R;
        voffA[i] = (unsigned)(R * lda + C) * 2u; voffB[i] = (unsigned)(Rb * K + C) * 2u; Rv[i] = R; cv2[i] = (unsigned)C * 2u; }
    unsigned goC[2][2] = {{0u, 0u}, {0u, 0u}}, goN[2][2] = {{0u, 0u}, {0u, 0u}};
#define PG8_LOADGO(go, u) do { if constexpr (Sched::GATHER) { _Pragma("unroll") for (int _h = 0; _h < 2; ++_h) _Pragma("unroll") for (int _i = 0; _i < 2; ++_i) \
        go[_h][_i] = (unsigned)S.tok[S.trow(u) + _h * HALF + Rv[_i]] * (unsigned)(lda * 2) + cv2[_i]; } } while (0)
#define PG8_STAGE_A(bufoff, base, h, go) do { if constexpr (Sched::GATHER) { PG8_STAGE(bufoff, base, go[h]); } else { PG8_STAGE(bufoff, (base) + (h) * hstepA, voffA); } } while (0)
    const size_t kstep = (size_t)(BK * 2);
    const size_t hstepA = (size_t)HALF * lda * 2, hstepB = (size_t)HALF * K * 2;
    const size_t tstepA = 2 * hstepA, tstepB = NB * hstepB;
    const unsigned ldsw = (unsigned)wid * 1024u;
    const int aoff = lds_byte(wr * 64 + fr, fq * 8), boff = lds_byte(wc * 32 + fr, fq * 8);
#define PG8_SA(b, h) (((b) * 2 + (h)) * HTB)
#define PG8_SB(b, h) ((4 + (b) * 2 + (h)) * HTB)
#define PG8_STAGE(bufoff, gbase, voff) do { _Pragma("unroll") for (int _i = 0; _i < 2; ++_i) \
        __builtin_amdgcn_global_load_lds((const unsigned*)((const char*)(gbase) + (voff)[_i]), (PG8_LAS unsigned*)(lds + (bufoff) + ldsw + _i * 8192), 16, 0, 0); } while (0)
#define PG8_LDA(dst, b, h) do { _Pragma("unroll") for (int m = 0; m < 4; ++m) _Pragma("unroll") for (int k = 0; k < 2; ++k) dst[m][k] = *(const PG8_LAS bf16x8*)(lds + PG8_SA(b, h) + aoff + m * 2048 + k * 1024); } while (0)
#define PG8_LDB(dst, b, h) do { _Pragma("unroll") for (int n = 0; n < 2; ++n) _Pragma("unroll") for (int k = 0; k < 2; ++k) dst[n][k] = *(const PG8_LAS bf16x8*)(lds + PG8_SB(b, h) + boff + n * 2048 + k * 1024); } while (0)
    typedef int i32x4_ __attribute__((ext_vector_type(4))); typedef int i32x8_ __attribute__((ext_vector_type(8)));
    const int sclW = Epi::SCLW, sclX = Epi::SCLX;
#define PG8_F8(lo, hi) __builtin_shufflevector(__builtin_bit_cast(i32x4_, lo), __builtin_bit_cast(i32x4_, hi), 0, 1, 2, 3, 4, 5, 6, 7)
#define PG8_MMA(ai, bj, At, Bt) do { __builtin_amdgcn_s_setprio(1); \
    if constexpr (Epi::FP8) { _Pragma("unroll") for (int m = 0; m < 4; ++m) _Pragma("unroll") for (int n = 0; n < 2; ++n) \
        { const i32x8_ a8_ = PG8_F8(Bt[n][0], Bt[n][1]), b8_ = PG8_F8(At[m][0], At[m][1]);     \
          asm volatile("v_mfma_scale_f32_16x16x128_f8f6f4 %0, %1, %2, %0, %3, %4 op_sel_hi:[0,0,0]" : "+v"(acc[ai][bj][m][n]) : "v"(a8_), "v"(b8_), "v"(sclW), "v"(sclX)); } } \
    else { _Pragma("unroll") for (int m = 0; m < 4; ++m) _Pragma("unroll") for (int n = 0; n < 2; ++n) _Pragma("unroll") for (int k = 0; k < 2; ++k) \
        acc[ai][bj][m][n] = __builtin_amdgcn_mfma_f32_16x16x32_bf16(Bt[n][k], At[m][k], acc[ai][bj][m][n], 0, 0, 0); } \
    __builtin_amdgcn_s_setprio(0); } while (0)
#define PG8_WAIT_V(n) asm volatile("s_waitcnt vmcnt(" #n ")" ::: "memory")
#define PG8_WAIT_L(n) asm volatile("s_waitcnt lgkmcnt(" #n ")" ::: "memory")
#define PG8_WAIT_VN() do { if constexpr (NB == 2) PG8_WAIT_V(8); else PG8_WAIT_V(6); } while (0)
#define PG8_BAR __builtin_amdgcn_s_barrier()
#define PG8_SCHED __builtin_amdgcn_sched_barrier(0)
    Unit cur, nxt; int ui = 0;
    if (!S.next(0, cur)) return;
    cur.pm = __builtin_amdgcn_readfirstlane(cur.pm); cur.pn = __builtin_amdgcn_readfirstlane(cur.pn);
    f32x4 acc[2][2][4][2];
#pragma unroll
    for (int a = 0; a < 2; ++a)
#pragma unroll
        for (int b = 0; b < 2; ++b)
#pragma unroll
            for (int m = 0; m < 4; ++m)
#pragma unroll
                for (int n = 0; n < 2; ++n) acc[a][b][m][n] = (f32x4){0.f, 0.f, 0.f, 0.f};
    bf16x8 At[4][2], B0[2][2], B1[2][2];
    const char* cA = (const char*)g.A + (Sched::GATHER ? (size_t)0 : (size_t)cur.pm * tstepA) + S.acol(cur); const char* cB = (const char*)g.Bt + (size_t)cur.pn * tstepB;
    PG8_LOADGO(goC, cur);
    S.a_ready(cur);
    PG8_STAGE(PG8_SB(0, 0), cB, voffB); if constexpr (NB == 2) PG8_STAGE(PG8_SB(0, 1), cB + hstepB, voffB); PG8_STAGE_A(PG8_SA(0, 0), cA, 0, goC); PG8_STAGE_A(PG8_SA(0, 1), cA, 1, goC);
    if (wr == 1) PG8_BAR;
    PG8_WAIT_V(2); PG8_BAR;
    PG8_STAGE(PG8_SB(1, 0), cB + kstep, voffB); PG8_STAGE_A(PG8_SA(1, 0), cA + kstep, 0, goC); if constexpr (NB == 2) PG8_STAGE(PG8_SB(1, 1), cB + hstepB + kstep, voffB);
    if constexpr (NB == 2) PG8_WAIT_V(6); else PG8_WAIT_V(4);
    PG8_BAR;
    for (;;) {
        bool has_next = S.next(ui + 1, nxt);
        has_next = __builtin_amdgcn_readfirstlane((int)has_next) != 0; nxt.pm = __builtin_amdgcn_readfirstlane(nxt.pm); nxt.pn = __builtin_amdgcn_readfirstlane(nxt.pn);
        if constexpr (Sched::GATHER) { if (has_next) { PG8_LOADGO(goN, nxt); } else { _Pragma("unroll") for (int _h = 0; _h < 2; ++_h) _Pragma("unroll") for (int _i = 0; _i < 2; ++_i) goN[_h][_i] = goC[_h][_i]; } }
        const char* nA = Sched::GATHER ? (const char*)g.A : (has_next ? (const char*)g.A + (size_t)nxt.pm * tstepA + S.acol(nxt) : cA); const char* nB = has_next ? (const char*)g.Bt + (size_t)nxt.pn * tstepB : cB;
#pragma unroll 1
        for (int t = 0; t < nt; t += 2) {
            const bool last = (t == nt - 2);
            const char* a1 = cA + (size_t)(t + 1) * kstep;
            const char* a2 = last ? nA : cA + (size_t)(t + 2) * kstep; const char* b2 = last ? nB : cB + (size_t)(t + 2) * kstep;
            const char* a3 = a2 + kstep; const char* b3 = b2 + kstep;
            unsigned s2[2][2];
#pragma unroll
            for (int _h = 0; _h < 2; ++_h)
#pragma unroll
                for (int _i = 0; _i < 2; ++_i) s2[_h][_i] = last ? goN[_h][_i] : goC[_h][_i];
            if (last && has_next) S.a_ready(nxt);
            if constexpr (Epi::HOOKS) { if (t == 4 || t == 8) E.hook(acc, cur, t, wr, wc, fr, fq); }
            PG8_LDB(B0, 0, 0); if constexpr (NB == 2) PG8_LDB(B1, 0, 1); PG8_SCHED; PG8_LDA(At, 0, 0); PG8_STAGE_A(PG8_SA(1, 1), a1, 1, goC);
            PG8_WAIT_VN(); PG8_WAIT_L(0); PG8_BAR; PG8_MMA(0, 0, At, B0); if constexpr (NB == 2) PG8_MMA(0, 1, At, B1); PG8_BAR; PG8_SCHED;
            PG8_LDA(At, 0, 1); PG8_STAGE(PG8_SB(0, 0), b2, voffB); if constexpr (NB == 2) PG8_STAGE(PG8_SB(0, 1), b2 + hstepB, voffB); PG8_STAGE_A(PG8_SA(0, 0), a2, 0, s2);
            PG8_WAIT_VN(); PG8_WAIT_L(0); PG8_BAR; PG8_MMA(1, 0, At, B0); if constexpr (NB == 2) PG8_MMA(1, 1, At, B1); PG8_BAR; PG8_SCHED;
            PG8_LDB(B0, 1, 0); if constexpr (NB == 2) PG8_LDB(B1, 1, 1); PG8_SCHED; PG8_LDA(At, 1, 0); PG8_STAGE_A(PG8_SA(0, 1), a2, 1, s2);
            PG8_WAIT_VN(); PG8_WAIT_L(0); PG8_BAR; PG8_MMA(0, 0, At, B0); if constexpr (NB == 2) PG8_MMA(0, 1, At, B1); PG8_BAR; PG8_SCHED;
            PG8_LDA(At, 1, 1); PG8_STAGE(PG8_SB(1, 0), b3, voffB); if constexpr (NB == 2) PG8_STAGE(PG8_SB(1, 1), b3 + hstepB, voffB); PG8_STAGE_A(PG8_SA(1, 0), a3, 0, s2);
            PG8_WAIT_VN(); PG8_WAIT_L(0); PG8_BAR; PG8_MMA(1, 0, At, B0); if constexpr (NB == 2) PG8_MMA(1, 1, At, B1); PG8_BAR; PG8_SCHED;
        }
        if (wr == 0) PG8_BAR;
        const bool keep = S.keep_acc(cur);
        if (!keep) E(acc, cur, wr, wc, fr, fq);
        S.done(cur);
        if (!has_next) break;
        if (!keep)
#pragma unroll
        for (int a = 0; a < 2; ++a)
#pragma unroll
            for (int b = 0; b < 2; ++b)
#pragma unroll
                for (int m = 0; m < 4; ++m)
#pragma unroll
                    for (int n = 0; n < 2; ++n) acc[a][b][m][n] = (f32x4){0.f, 0.f, 0.f, 0.f};
        cur = nxt; cA = nA; cB = nB; ++ui;
        if constexpr (Sched::GATHER) { _Pragma("unroll") for (int _h = 0; _h < 2; ++_h) _Pragma("unroll") for (int _i = 0; _i < 2; ++_i) goC[_h][_i] = goN[_h][_i]; }
        if (wr == 1) PG8_BAR;
    }
    PG8_WAIT_V(0);
    PG8_BAR;
#undef PG8_SA
#undef PG8_SB
#undef PG8_STAGE
#undef PG8_STAGE_A
#undef PG8_LOADGO
#undef PG8_LDA
#undef PG8_LDB
#undef PG8_MMA
#undef PG8_F8
#undef PG8_WAIT_V
#undef PG8_WAIT_L
#undef PG8_WAIT_VN
#undef PG8_BAR
#undef PG8_SCHED
}
}
namespace pg8 {
constexpr float QSCALE_LOG2 = 0.10206207261596575f * 1.4426950408889634f;
struct EpiNull { static constexpr bool PERM = true, HOOKS = false; static constexpr int NB = 2; static constexpr bool FP8 = false; static constexpr int SCLW = 0x7F7F7F7F, SCLX = 0x7F7F7F7F;
    __device__ __forceinline__ void operator()(const f32x4 (&acc)[2][2][4][2], const Unit&, int, int, int, int) const {
#pragma unroll
        for (int a = 0; a < 2; ++a)
#pragma unroll
            for (int b = 0; b < 2; ++b)
#pragma unroll
                for (int m = 0; m < 4; ++m)
#pragma unroll
                    for (int n = 0; n < 2; ++n) asm volatile("" :: "v"(acc[a][b][m][n])); } };
struct EpiInProj { static constexpr bool PERM = true, HOOKS = false; static constexpr int NB = 2; static constexpr bool FP8 = true; static constexpr int SCLW = 0x7A7A7A7A, SCLX = 0x7F7F7F7F;
    bf16_t* P; const float* bgate; float* RKV; bf16_t* Kb; const float* kng; const float* cosT; const float* sinT;
    __device__ __forceinline__ void operator()(const f32x4 (&acc)[2][2][4][2], const Unit& u, int wr, int wc, int fr, int fq) const {
        asm volatile("" : "+v"(fr), "+v"(fq));
        const int row0 = u.pm * BM + wr * 64 + fr, colt = u.pn * BM + wc * 32 + 8 * fq;
        if (u.pn >= C_GATE / BM) {
            const int gc0 = (u.pn - C_GATE / BM) * BM + wc * 64 + fq * 16;
            f32x4 bv[2][2];
#pragma unroll
            for (int bj = 0; bj < 2; ++bj)
#pragma unroll
                for (int n = 0; n < 2; ++n) bv[bj][n] = *(const f32x4*)(bgate + gc0 + bj * 8 + 4 * n);
            asm volatile("" : "+v"(bv[0][0]), "+v"(bv[0][1]), "+v"(bv[1][0]), "+v"(bv[1][1]));
#pragma unroll
            for (int ai = 0; ai < 2; ++ai)
#pragma unroll
                for (int m = 0; m < 4; ++m) { u32x4 w;
#pragma unroll
                    for (int bj = 0; bj < 2; ++bj)
#pragma unroll
                        for (int n = 0; n < 2; ++n) { const f32x4 s = sigmoid4(acc[ai][bj][m][n] + bv[bj][n]) * 255.0f + 0.5f;
                            w[bj * 2 + n] = (unsigned)s[0] | ((unsigned)s[1] << 8) | ((unsigned)s[2] << 16) | ((unsigned)s[3] << 24); }
                    *(u32x4*)((unsigned char*)P + (size_t)(row0 + ai * HALF + m * 16) * (INW * 2) + C_GATE * 2 + gc0) = w; }
            return;
        }
#pragma unroll
        for (int ai = 0; ai < 2; ++ai)
#pragma unroll
            for (int m = 0; m < 4; ++m) { bf16_t* rowp = P + (size_t)(row0 + ai * HALF + m * 16) * INW + colt;
                if (u.pn == C_KVA / BM) {
                    unsigned char* r8 = (unsigned char*)P + (size_t)(row0 + ai * HALF + m * 16) * (INW * 2) + C_KVA * 2 + wc * 32 + 8 * fq;
#pragma unroll
                    for (int bj = 0; bj < 2; ++bj) *(u32x2*)(r8 + bj * HALF) = pack8_f8(acc[ai][bj][m][0], acc[ai][bj][m][1], 1.0f);
                } else if (u.pn == C_QA / BM || u.pn == C_QA / BM + 1) {
                    unsigned char* r8 = (unsigned char*)P + (size_t)(row0 + ai * HALF + m * 16) * (INW * 2) + C_QA * 2 + (u.pn - C_QA / BM) * BM + wc * 32 + 8 * fq;
                    *(u32x2*)r8 = pack8_f8(acc[ai][0][m][0], acc[ai][0][m][1], 1.0f);
                    *(u32x2*)(r8 + HALF) = (u.pn == C_QA / BM) ? pack8_f8(acc[ai][1][m][0], acc[ai][1][m][1], 1.0f) : (u32x2){0u, 0u};
                } else {
#pragma unroll
                for (int bj = 0; bj < 2; ++bj) *(u32x4*)(rowp + bj * HALF) = pack8(acc[ai][bj][m][0], acc[ai][bj][m][1]); } }
        if (u.pn == C_KVA / BM) {
#pragma unroll
            for (int ai = 0; ai < 2; ++ai)
#pragma unroll
                for (int m = 0; m < 4; ++m) {
                    float ss = (dot4(acc[ai][0][m][0]) + dot4(acc[ai][0][m][1])) + (dot4(acc[ai][1][m][0]) + dot4(acc[ai][1][m][1]));
                    ss += __shfl_xor(ss, 16); ss += __shfl_xor(ss, 32);
                    if (fq == 0) RKV[(size_t)(row0 + ai * HALF + m * 16) * 4 + wc] = ss; }
        }
        if (u.pn == C_KR / BM && wc == 0) {
            const f32x4 g0 = *(const f32x4*)(kng + 8 * fq), g1 = *(const f32x4*)(kng + 8 * fq + 4);
            const bool lat = u.pm < NLAT / BM; const bool first = (fq & 1) == 0;
#pragma unroll
            for (int ai = 0; ai < 2; ++ai)
#pragma unroll
                for (int m = 0; m < 4; ++m) {
                    const int row = row0 + ai * HALF + m * 16;
                    float ss = dot4(acc[ai][1][m][0]) + dot4(acc[ai][1][m][1]);
                    ss += __shfl_xor(ss, 16); ss += __shfl_xor(ss, 32);
                    const float r = rsqrtf(ss * (1.0f / 32.0f) + EPS);
                    f32x4 v0 = acc[ai][1][m][0] * r * g0, v1 = acc[ai][1][m][1] * r * g1, p0, p1;
#pragma unroll
                    for (int e = 0; e < 4; ++e) { p0[e] = __shfl_xor(v0[e], 16); p1[e] = __shfl_xor(v1[e], 16); }
                    if (lat) { const int t = row & (SEQ - 1); const int pos = (fq >> 1) ? (t & 63) : (t >> 6);
                        const f32x4 c0 = *(const f32x4*)(cosT + pos * 8), c1 = *(const f32x4*)(cosT + pos * 8 + 4); f32x4 s0 = *(const f32x4*)(sinT + pos * 8), s1 = *(const f32x4*)(sinT + pos * 8 + 4);
                        if (first) { s0 = -s0; s1 = -s1; }
                        v0 = v0 * c0 + p0 * s0; v1 = v1 * c1 + p1 * s1; }
                    const int b = lat ? (row >> 13) : ((row - NLAT) >> 8), key = lat ? (row & (SEQ - 1)) : (SEQ + ((row - NLAT) & 255));
                    const u32x2 w = pack8_f8(v0, v1, 1.0f);
#pragma unroll
                    for (int h = 0; h < NH; ++h) *(u32x2*)((unsigned char*)Kb + ((unsigned)((b * NH + h) * NKEY + key) * (unsigned)QKH + (unsigned)(64 + 8 * fq))) = w;
                    asm volatile("" ::: "memory"); }
        }
    }
};
struct EpiQ { static constexpr bool PERM = true, HOOKS = false; static constexpr int NB = 2; static constexpr bool FP8 = true; static constexpr int SCLW = 0x7A7A7A7A, SCLX = 0x7F7F7F7F;
    bf16_t* Q; const float* qg; const float* cosT; const float* sinT;
    __device__ __forceinline__ void operator()(const f32x4 (&acc)[2][2][4][2], const Unit& u, int wr, int wc, int fr, int fq) const {
        asm volatile("" : "+v"(fr), "+v"(fq));
        const int row0 = u.pm * BM + wr * 64 + fr;
        if (u.pn < 2) {
            const int head = u.pn * 4 + wc;
            f32x4 g[2][2];
#pragma unroll
            for (int bj = 0; bj < 2; ++bj)
#pragma unroll
                for (int n = 0; n < 2; ++n) g[bj][n] = *(const f32x4*)(qg + 32 * bj + 8 * fq + 4 * n);
#pragma unroll
            for (int ai = 0; ai < 2; ++ai)
#pragma unroll
                for (int m = 0; m < 4; ++m) {
                    float ss = (dot4(acc[ai][0][m][0]) + dot4(acc[ai][0][m][1])) + (dot4(acc[ai][1][m][0]) + dot4(acc[ai][1][m][1]));
                    ss += __shfl_xor(ss, 16); ss += __shfl_xor(ss, 32);
                    const float r = rsqrtf(ss * (1.0f / 64.0f) + EPS) * QSCALE_LOG2;
                    unsigned char* rowp = (unsigned char*)Q + (size_t)(row0 + ai * HALF + m * 16) * 768 + head * QKH + 8 * fq;
#pragma unroll
                    for (int bj = 0; bj < 2; ++bj) *(u32x2*)(rowp + 32 * bj) = pack8_f8(acc[ai][bj][m][0] * r * g[bj][0], acc[ai][bj][m][1] * r * g[bj][1], 8.0f);
                    asm volatile("" ::: "memory");
                }
        } else {
            const f32x4 g0 = *(const f32x4*)(qg + 64 + 8 * fq), g1 = *(const f32x4*)(qg + 64 + 8 * fq + 4);
            const bool rope = u.pm < NLAT / BM; const bool first = (fq & 1) == 0;
#pragma unroll
            for (int ai = 0; ai < 2; ++ai)
#pragma unroll
                for (int m = 0; m < 4; ++m) {
                    const int row = row0 + ai * HALF + m * 16;
                    f32x4 c0 = {1.f, 1.f, 1.f, 1.f}, c1 = c0, s0 = {0.f, 0.f, 0.f, 0.f}, s1 = s0;
                    if (rope) { const int t = row & (SEQ - 1); const int pos = (fq >> 1) ? (t & 63) : (t >> 6);
                        c0 = *(const f32x4*)(cosT + pos * 8); c1 = *(const f32x4*)(cosT + pos * 8 + 4); s0 = *(const f32x4*)(sinT + pos * 8); s1 = *(const f32x4*)(sinT + pos * 8 + 4);
                        if (first) { s0 = -s0; s1 = -s1; } }
#pragma unroll
                    for (int bj = 0; bj < 2; ++bj) {
                        const int head = 4 * bj + wc;
                        float ss = dot4(acc[ai][bj][m][0]) + dot4(acc[ai][bj][m][1]);
                        ss += __shfl_xor(ss, 16); ss += __shfl_xor(ss, 32);
                        const float r = rsqrtf(ss * (1.0f / 32.0f) + EPS) * QSCALE_LOG2;
                        f32x4 v0 = acc[ai][bj][m][0] * r * g0, v1 = acc[ai][bj][m][1] * r * g1, p0, p1;
#pragma unroll
                        for (int e = 0; e < 4; ++e) { p0[e] = __shfl_xor(v0[e], 16); p1[e] = __shfl_xor(v1[e], 16); }
                        v0 = v0 * c0 + p0 * s0; v1 = v1 * c1 + p1 * s1;
                        *(u32x2*)((unsigned char*)Q + (size_t)row * 768 + head * QKH + 64 + 8 * fq) = pack8_f8(v0, v1, 8.0f);
                    }
                    asm volatile("" ::: "memory");
                }
        }
    }
};
struct EpiKV { static constexpr bool PERM = true, HOOKS = false; static constexpr int NB = 2; static constexpr bool FP8 = true; static constexpr int SCLW = 0x7A7A7A7A, SCLX = 0x7F7F7F7F;
    bf16_t* Kb; bf16_t* Vb; const float* kg; const float* RKV;
    __device__ __forceinline__ void operator()(const f32x4 (&acc)[2][2][4][2], const Unit& u, int wr, int wc, int fr, int fq) const {
        asm volatile("" : "+v"(fr), "+v"(fq));
        const int row0 = u.pm * BM + wr * 64 + fr; const int head = 2 * u.pn + (wc & 1);
        const bool lat = u.pm < NLAT / BM;
        if (wc < 2) {
            f32x4 g[2][2];
#pragma unroll
            for (int bj = 0; bj < 2; ++bj) { g[bj][0] = *(const f32x4*)(kg + 32 * bj + 8 * fq); g[bj][1] = *(const f32x4*)(kg + 32 * bj + 8 * fq + 4); }
            asm volatile("" : "+v"(g[0][0]), "+v"(g[0][1]), "+v"(g[1][0]), "+v"(g[1][1]));
#pragma unroll
            for (int ai = 0; ai < 2; ++ai)
#pragma unroll
                for (int m = 0; m < 4; ++m) {
                    const int row = row0 + ai * HALF + m * 16;
                    const int b = lat ? (row >> 13) : ((row - NLAT) >> 8), key = lat ? (row & (SEQ - 1)) : (SEQ + ((row - NLAT) & 255));
                    const unsigned kidx = (unsigned)((b * NH + head) * NKEY + key);
                    float ss = (dot4(acc[ai][0][m][0]) + dot4(acc[ai][0][m][1])) + (dot4(acc[ai][1][m][0]) + dot4(acc[ai][1][m][1]));
                    ss += __shfl_xor(ss, 16); ss += __shfl_xor(ss, 32);
                    const float r = rsqrtf(ss * (1.0f / 64.0f) + EPS);
#pragma unroll
                    for (int bj = 0; bj < 2; ++bj)
                        *(u32x2*)((unsigned char*)Kb + (kidx * (unsigned)QKH + (unsigned)(32 * bj + 8 * fq))) = pack8_f8(acc[ai][bj][m][0] * r * g[bj][0], acc[ai][bj][m][1] * r * g[bj][1], 1.0f);
                }
        } else {
#pragma unroll
            for (int ai = 0; ai < 2; ++ai) {
                f32x4 pr[4];
#pragma unroll
                for (int m = 0; m < 4; ++m) pr[m] = *(const f32x4*)(RKV + (size_t)(row0 + ai * HALF + m * 16) * 4);
                asm volatile("" : "+v"(pr[0]), "+v"(pr[1]), "+v"(pr[2]), "+v"(pr[3]));
#pragma unroll
                for (int m = 0; m < 4; ++m) {
                    const int row = row0 + ai * HALF + m * 16;
                    const int b = lat ? (row >> 13) : ((row - NLAT) >> 8), key = lat ? (row & (SEQ - 1)) : (SEQ + ((row - NLAT) & 255));
                    const unsigned kidx = (unsigned)((b * NH + head) * NKEY + key);
                    const float rk = rsqrtf(((pr[m][0] + pr[m][1]) + (pr[m][2] + pr[m][3])) * (1.0f / 256.0f) + EPS);
#pragma unroll
                    for (int bj = 0; bj < 2; ++bj) *(u32x4*)(Vb + (kidx * (unsigned)VH + (unsigned)(32 * bj + 8 * fq))) = pack8(acc[ai][bj][m][0] * rk, acc[ai][bj][m][1] * rk);
                }
                asm volatile("" ::: "memory");
            }
        }
    }
};
struct EpiMergeF { static constexpr bool PERM = true, HOOKS = false; static constexpr int NB = 1; static constexpr bool FP8 = false; static constexpr int SCLW = 0x7F7F7F7F, SCLX = 0x7F7F7F7F;
    const bf16_t* P; bf16_t* MG; mutable u32x4 run[2][4]; mutable u32x2 gn[8];
    __device__ __forceinline__ void gload(u32x2 (&g)[8], int row0, int colt, int gate) const {
#pragma unroll
        for (int i = 0; i < 8; ++i) g[i] = *(const u32x2*)((const unsigned char*)P + (size_t)(row0 + (i >> 2) * HALF + (i & 3) * 16) * (INW * 2) + C_GATE * 2 + DM * gate + colt);
    }
    __device__ __forceinline__ void operator()(const f32x4 (&acc)[2][2][4][2], const Unit& u, int wr, int wc, int fr, int fq) const {
        asm volatile("" : "+v"(fr), "+v"(fq));
        const int seg = u.pn >> 3, pnl = u.pn & 7;
        const int row0 = u.pm * BM + wr * 64 + fr, colt = pnl * HALF + wc * 32 + 8 * fq;
        u32x2 gw[8];
        if (seg == 0) gload(gw, row0, colt, 1);
        else {
#pragma unroll
            for (int k = 0; k < 8; ++k) gw[k] = gn[k]; }
#pragma unroll
        for (int k = 0; k < 8; ++k) asm volatile("" : "+v"(gw[k]));
        if (seg == 0) gload(gn, row0, colt, 0); else if (seg == 1) gload(gn, row0, colt, 2);
#pragma unroll
        for (int k = 0; k < 8; ++k) { const int ai = k >> 2, m = k & 3; f32x4 g0, g1;
#pragma unroll
            for (int b = 0; b < 4; ++b) { g0[b] = (float)((gw[k].x >> (8 * b)) & 255u) * (1.0f / 255.0f); g1[b] = (float)((gw[k].y >> (8 * b)) & 255u) * (1.0f / 255.0f); }
            f32x4 v0 = acc[ai][0][m][0] * g0, v1 = acc[ai][0][m][1] * g1;
            if (seg != 0) { f32x4 q0, q1; unpack8(run[ai][m], q0, q1); v0 += q0; v1 += q1; }
            const u32x4 w = pack8(v0, v1); run[ai][m] = w;
            if (seg == 3) *(u32x4*)(MG + (size_t)(row0 + ai * HALF + m * 16) * DM + colt) = w; }
        asm volatile("" ::: "memory");
    }
};
struct EpiOut { static constexpr bool PERM = true, HOOKS = false; static constexpr int NB = 2; static constexpr bool FP8 = false; static constexpr int SCLW = 0x7F7F7F7F, SCLX = 0x7F7F7F7F;
    const float* resL; const float* resC; bf16_t* X1; const float* gvec; const bf16_t* resB;
    template <int I0, int N> __device__ __forceinline__ void batch(const f32x4 (&acc)[2][2][4][2], const f32x4 (&gv)[2][2], const float* res, size_t roff0, size_t xoff0) const {
        if (resB) {
            u32x4 xb[N];
#pragma unroll
            for (int k = 0; k < N; ++k) { const int i = I0 + k, ai = i >> 3, m = (i >> 1) & 3, bj = i & 1; xb[k] = *(const u32x4*)(resB + roff0 + (size_t)(ai * HALF + m * 16) * DM + bj * HALF); }
#pragma unroll
            for (int k = 0; k < N; ++k) asm volatile("" : "+v"(xb[k]));
#pragma unroll
            for (int k = 0; k < N; ++k) { const int i = I0 + k, ai = i >> 3, m = (i >> 1) & 3, bj = i & 1; f32x4 xa, xc; unpack8(xb[k], xa, xc);
                *(u32x4*)(X1 + xoff0 + (size_t)(ai * HALF + m * 16) * DM + bj * HALF) = pack8(xa + gv[bj][0] * acc[ai][bj][m][0], xc + gv[bj][1] * acc[ai][bj][m][1]); }
            asm volatile("" ::: "memory");
            return;
        }
        f32x4 xr[N][2];
#pragma unroll
        for (int k = 0; k < N; ++k) { const int i = I0 + k, ai = i >> 3, m = (i >> 1) & 3, bj = i & 1; const float* p = res + roff0 + (size_t)(ai * HALF + m * 16) * DM + bj * HALF;
            xr[k][0] = *(const f32x4*)p; xr[k][1] = *(const f32x4*)(p + 4); }
#pragma unroll
        for (int k = 0; k < N; ++k) { asm volatile("" : "+v"(xr[k][0])); asm volatile("" : "+v"(xr[k][1])); }
#pragma unroll
        for (int k = 0; k < N; ++k) { const int i = I0 + k, ai = i >> 3, m = (i >> 1) & 3, bj = i & 1;
            *(u32x4*)(X1 + xoff0 + (size_t)(ai * HALF + m * 16) * DM + bj * HALF) = pack8(xr[k][0] + gv[bj][0] * acc[ai][bj][m][0], xr[k][1] + gv[bj][1] * acc[ai][bj][m][1]); }
        asm volatile("" ::: "memory");
    }
    __device__ __forceinline__ void operator()(const f32x4 (&acc)[2][2][4][2], const Unit& u, int wr, int wc, int fr, int fq) const {
        asm volatile("" : "+v"(fr), "+v"(fq));
        const bool lat = u.pm < NLAT / BM;
        const float* res = lat ? resL : resC; const int roff = lat ? 0 : NLAT;
        const int col0 = u.pn * BM + wc * 32 + 8 * fq, mrow = lat ? (u.pm >> 5) : 4;
        const float* gp = gvec + (size_t)mrow * (6 * DM) + col0;
        f32x4 gv[2][2];
#pragma unroll
        for (int bj = 0; bj < 2; ++bj)
#pragma unroll
            for (int n = 0; n < 2; ++n) gv[bj][n] = *(const f32x4*)(gp + bj * HALF + 4 * n);
        const int row = u.pm * BM + wr * 64 + fr;
        const size_t roff0 = (size_t)(row - roff) * DM + col0, xoff0 = (size_t)row * DM + col0;
        batch<0, 2>(acc, gv, res, roff0, xoff0); batch<2, 2>(acc, gv, res, roff0, xoff0); batch<4, 4>(acc, gv, res, roff0, xoff0); batch<8, 8>(acc, gv, res, roff0, xoff0);
    }
};
struct EpiMoe1 { static constexpr bool PERM = true, HOOKS = false; static constexpr int NB = 2; static constexpr bool FP8 = MOE1_FP8 != 0; static constexpr int SCLW = MOE1_FP8 ? 0x7A7A7A7A : 0x7F7F7F7F, SCLX = 0x7F7F7F7F;
    bf16_t* ACT;
    __device__ __forceinline__ void operator()(const f32x4 (&acc)[2][2][4][2], const Unit& u, int wr, int wc, int fr, int fq) const {
        asm volatile("" : "+v"(fr), "+v"(fq));
        const int row0 = u.pm * BM + wr * 64 + fr, col = (u.pn & 3) * HALF + wc * 32 + 8 * fq;
#pragma unroll
        for (int ai = 0; ai < 2; ++ai)
#pragma unroll
            for (int m = 0; m < 4; ++m) {
                const f32x4 g0 = acc[ai][0][m][0], g1 = acc[ai][0][m][1];
                const f32x4 a0 = g0 * sigmoid4(g0) * acc[ai][1][m][0], a1 = g1 * sigmoid4(g1) * acc[ai][1][m][1];
                if (MOE2_FP8) *(u32x2*)((unsigned char*)ACT + (size_t)(row0 + ai * HALF + m * 16) * DE + col) = pack8_f8(a0, a1, 16.0f);
                else *(u32x4*)(ACT + (size_t)(row0 + ai * HALF + m * 16) * DE + col) = pack8(a0, a1); }
    }
};
struct EpiMoe2 { static constexpr bool PERM = true, HOOKS = false; static constexpr int NB = 2; static constexpr bool FP8 = MOE2_FP8 != 0; static constexpr int SCLW = MOE2_FP8 ? 0x7A7A7A7A : 0x7F7F7F7F, SCLX = MOE2_FP8 ? 0x7B7B7B7B : 0x7F7F7F7F;
    bf16_t* YS;
    __device__ __forceinline__ void operator()(const f32x4 (&acc)[2][2][4][2], const Unit& u, int wr, int wc, int fr, int fq) const {
        asm volatile("" : "+v"(fr), "+v"(fq));
        const int row0 = u.pm * BM + wr * 64 + fr, col = (u.pn & 3) * BM + wc * 32 + 8 * fq;
#pragma unroll
        for (int ai = 0; ai < 2; ++ai)
#pragma unroll
            for (int m = 0; m < 4; ++m)
                if constexpr (XS_FP8 != 0) {
                    f32x4 a0 = acc[ai][0][m][0], a1 = acc[ai][0][m][1], b0 = acc[ai][1][m][0], b1 = acc[ai][1][m][1];
#pragma unroll
                    for (int t = 0; t < 4; ++t) { a0[t] = __builtin_amdgcn_fmed3f(a0[t], -27.0f, 27.0f); a1[t] = __builtin_amdgcn_fmed3f(a1[t], -27.0f, 27.0f); b0[t] = __builtin_amdgcn_fmed3f(b0[t], -27.0f, 27.0f); b1[t] = __builtin_amdgcn_fmed3f(b1[t], -27.0f, 27.0f); }
                    const u32x2 lo = pack8_f8(a0, a1, 16.0f), hi = pack8_f8(b0, b1, 16.0f);
                    *(u32x4*)((unsigned char*)YS + (size_t)(row0 + ai * HALF + m * 16) * DM + (u.pn & 3) * BM + wc * 64 + 16 * fq) = (u32x4){lo.x, lo.y, hi.x, hi.y};
                } else {
#pragma unroll
                for (int bj = 0; bj < 2; ++bj) *(u32x4*)(YS + (size_t)(row0 + ai * HALF + m * 16) * DM + col + bj * HALF) = pack8(acc[ai][bj][m][0], acc[ai][bj][m][1]);
                }
    }
};
}
namespace attn {
typedef unsigned short bf16_t;
using bf16x8 = __attribute__((ext_vector_type(8))) short;
using s16x4  = __attribute__((ext_vector_type(4))) short;
using f32x16 = __attribute__((ext_vector_type(16))) float;
using u32x4  = __attribute__((ext_vector_type(4))) unsigned;
constexpr int NW = 8, QBLK = 32, KVBLK = 64;
constexpr float QSCALE = 0.10206207261596575f * 1.4426950408889634f;
constexpr int SHM_V = 16384, SHM_K = 16384, SLOTB = 16384, NSLOT = 3,     SHM_ATTN = NSLOT * SHM_V + NSLOT * SHM_K + NW * 64 * 4;
#define KSWZ(row, colB) ((row) * 256 + ((colB) ^ (((row) & 7) << 4)))
#define SBAR() __builtin_amdgcn_sched_barrier(0)
__device__ __forceinline__ int crow(int r, int hi) { return (r & 3) + 8 * (r >> 2) + 4 * hi; }
__device__ __forceinline__ unsigned cvtpk(float lo, float hi) { unsigned r; asm volatile("v_cvt_pk_bf16_f32 %0, %1, %2" : "=v"(r) : "v"(lo), "v"(hi)); return r; }
__device__ __forceinline__ bf16x8 ld8(const bf16_t* p) { return *reinterpret_cast<const bf16x8*>(p); }

constexpr float PSHIFT = 0.0f;
__device__ __forceinline__ void partialSM(f32x16& p0) {
  for (int r = 0; r < 16; ++r) p0[r] = __builtin_amdgcn_exp2f(p0[r]);
}
typedef float f32x2 __attribute__((ext_vector_type(2)));
__device__ __forceinline__ void finishSM(f32x16& p0, f32x16& p1, f32x2& l_reg, bf16x8& pa0, bf16x8& pa1, bf16x8& pa2, bf16x8& pa3) {
  for (int r = 0; r < 16; ++r) p1[r] = __builtin_amdgcn_exp2f(p1[r]);
#define P2(P, i) ((f32x2){P[2 * (i)], P[2 * (i) + 1]})
  const f32x2 a = ((P2(p0, 0) + P2(p0, 1)) + (P2(p0, 2) + P2(p0, 3))) + ((P2(p0, 4) + P2(p0, 5)) + (P2(p0, 6) + P2(p0, 7)));
  const f32x2 b = ((P2(p1, 0) + P2(p1, 1)) + (P2(p1, 2) + P2(p1, 3))) + ((P2(p1, 4) + P2(p1, 5)) + (P2(p1, 6) + P2(p1, 7)));
  l_reg += a + b;
#undef P2
#define PK4(P, BASE, OUT) do { u32x4 w = {cvtpk(P[BASE + 0], P[BASE + 1]), cvtpk(P[BASE + 2], P[BASE + 3]), cvtpk(P[BASE + 4], P[BASE + 5]), cvtpk(P[BASE + 6], P[BASE + 7])}; \
    OUT = *reinterpret_cast<bf16x8*>(&w); } while (0)
  PK4(p0, 0, pa0); PK4(p0, 8, pa1); PK4(p1, 0, pa2); PK4(p1, 8, pa3);
#undef PK4
}
__device__ __forceinline__ void qkt(f32x16& p0, f32x16& p1, const bf16_t* Ks, const bf16x8* qr, int r32, int hi) {
  for (int r = 0; r < 16; ++r) { p0[r] = 0.0f - PSHIFT; p1[r] = 0.0f - PSHIFT; }
#pragma unroll
  for (int d0 = 0; d0 < 6; ++d0) { int cb = (d0 * 16 + hi * 8) * 2;
    bf16x8 b0 = *reinterpret_cast<const bf16x8*>((const char*)Ks + KSWZ(r32, cb));
    bf16x8 b1 = *reinterpret_cast<const bf16x8*>((const char*)Ks + KSWZ(32 + r32, cb));
    p0 = __builtin_amdgcn_mfma_f32_32x32x16_bf16(b0, qr[d0], p0, 0, 0, 0);
    p1 = __builtin_amdgcn_mfma_f32_32x32x16_bf16(b1, qr[d0], p1, 0, 0, 0); }
}
constexpr int VPB = 192;
__device__ __forceinline__ int v_st(int k, int c) { return k * VPB + c * 2; }
__device__ __forceinline__ int v_rd_base(int lane) { const int i = lane & 15, ch = (lane >> 4) & 1, h = lane >> 5; return (4 * h + (i >> 2)) * VPB + (16 * ch + 4 * (i & 3)) * 2; }
constexpr int v_rd_off(int d0, int ks, int half) { return d0 * 64 + ks * 16 * VPB + half * 8 * VPB; }
template <int OFF> __device__ __forceinline__ s16x4 tr_read(int vb) {
  s16x4 r; asm volatile("ds_read_b64_tr_b16 %0, %1 offset:%2" : "=&v"(r) : "v"(vb), "i"(OFF) : "memory"); return r;
}
template <int D0> __device__ __forceinline__ void pv_one(f32x16& od, int vb, bf16x8 pa0, bf16x8 pa1, bf16x8 pa2, bf16x8 pa3) {
  const s16x4 l0 = tr_read<v_rd_off(D0, 0, 0)>(vb), h0 = tr_read<v_rd_off(D0, 0, 1)>(vb), l1 = tr_read<v_rd_off(D0, 1, 0)>(vb), h1 = tr_read<v_rd_off(D0, 1, 1)>(vb);
  const s16x4 l2 = tr_read<v_rd_off(D0, 2, 0)>(vb), h2 = tr_read<v_rd_off(D0, 2, 1)>(vb), l3 = tr_read<v_rd_off(D0, 3, 0)>(vb), h3 = tr_read<v_rd_off(D0, 3, 1)>(vb);
  asm volatile("s_waitcnt lgkmcnt(0)" ::: "memory"); SBAR();
#define PK(L, H) (bf16x8){L[0], L[1], L[2], L[3], H[0], H[1], H[2], H[3]}
  od = __builtin_amdgcn_mfma_f32_32x32x16_bf16(pa0, PK(l0, h0), od, 0, 0, 0);
  od = __builtin_amdgcn_mfma_f32_32x32x16_bf16(pa1, PK(l1, h1), od, 0, 0, 0);
  od = __builtin_amdgcn_mfma_f32_32x32x16_bf16(pa2, PK(l2, h2), od, 0, 0, 0);
  od = __builtin_amdgcn_mfma_f32_32x32x16_bf16(pa3, PK(l3, h3), od, 0, 0, 0);
#undef PK
}
__device__ __forceinline__ void pv_d0(f32x16* o, int vb, bf16x8 pa0, bf16x8 pa1, bf16x8 pa2, bf16x8 pa3) {
  pv_one<0>(o[0], vb, pa0, pa1, pa2, pa3); pv_one<1>(o[1], vb, pa0, pa1, pa2, pa3);
}
#ifndef ATTN_HAND
#define ATTN_HAND 1
#endif
template <int OFF> __device__ __forceinline__ bf16x8 k_read(int a) { bf16x8 r; asm volatile("ds_read_b128 %0, %1 offset:%2" : "=&v"(r) : "v"(a), "i"(OFF) : "memory"); return r; }
__device__ __forceinline__ unsigned cvt2n(float lo, float hi) { const f32x2 v = {lo, hi}; typedef __bf16 bf2 __attribute__((ext_vector_type(2))); return __builtin_bit_cast(unsigned, __builtin_convertvector(v, bf2)); }
__device__ __forceinline__ void attn_dense_body(int tid_in, const bf16_t* __restrict__ Qb, int ldq, const bf16_t* __restrict__ Kh, const bf16_t* __restrict__ Vh,
                                                bf16_t* __restrict__ Ob, int ldo, int NT, char* lds) {
  int tid_ = tid_in; asm volatile("" : "+v"(tid_));
  const int tid = tid_, wid = tid >> 6, lane = tid & 63, r32 = lane & 31, hi = lane >> 5;
  bf16_t* V_lds = (bf16_t*)lds; bf16_t* K_lds = (bf16_t*)(lds + NSLOT * SHM_V);
  float* ws = (float*)(lds + NSLOT * SHM_V + NSLOT * SHM_K) + wid * 64; float* li_l = ws;
  f32x2 l_reg2 = {0.f, 0.f}; f32x16 o[2] = {}; bf16x8 qr[6];
  const bf16_t* Qw = Qb + (long)(wid * QBLK + r32) * ldq + hi * 8;
#pragma unroll
  for (int d0 = 0; d0 < 6; ++d0) qr[d0] = ld8(Qw + d0 * 16);
  const bool two = tid < 256;
  const int kc0 = tid, kc1 = tid + 512;
  const int kst0 = KSWZ(kc0 / 12, (kc0 % 12) * 16), kst1 = KSWZ(kc1 / 12, (kc1 % 12) * 16);
  const int vst0 = v_st(tid >> 3, (tid & 7) * 8);
  const int vb0 = (int)(uintptr_t)V_lds + v_rd_base(lane);
  bf16x8 sv0, sk0, sk1;
#define SLOAD(k0) do { sv0 = ld8(Vh + (long)(k0) * 64 + tid * 8); sk0 = ld8(Kh + (long)(k0) * 96 + kc0 * 8); if (two) sk1 = ld8(Kh + (long)(k0) * 96 + kc1 * 8); } while (0)
#define SWRITE(off) do { *(bf16x8*)((char*)V_lds + (off) + vst0) = sv0; *(bf16x8*)((char*)K_lds + (off) + kst0) = sk0; if (two) *(bf16x8*)((char*)K_lds + (off) + kst1) = sk1; } while (0)
  int o_prev = 0, o_cur = 0, o_next = SLOTB;
#define ROT() do { o_prev = o_cur; o_cur = o_next; o_next = (o_next == (NSLOT - 1) * SLOTB) ? 0 : o_next + SLOTB; } while (0)
  f32x16 pA0, pA1, pB0, pB1; bf16x8 pa0, pa1, pa2, pa3;
  if (__builtin_amdgcn_readfirstlane(wid) >= 4) __builtin_amdgcn_s_setprio(1);
  SLOAD(0); asm volatile("s_waitcnt vmcnt(0)" ::: "memory"); SWRITE(0); SLOAD(KVBLK); __syncthreads();
  qkt(pA0, pA1, K_lds, qr, r32, hi); partialSM(pA0);
  SWRITE(SLOTB); if (2 < NT) SLOAD(2 * KVBLK);
  __syncthreads(); ROT();
#define STEP(PC0, PC1, PP0, PP1, jj) do { \
    SBAR(); qkt(PC0, PC1, (bf16_t*)((char*)K_lds + o_cur), qr, r32, hi); \
    finishSM(PP0, PP1, l_reg2, pa0, pa1, pa2, pa3); SBAR(); \
    if ((jj) + 1 < NT) SWRITE(o_next); \
    if ((jj) + 2 < NT) SLOAD(((jj) + 2) * KVBLK); \
    SBAR(); pv_d0(o, vb0 + o_prev, pa0, pa1, pa2, pa3); partialSM(PC0); \
    __syncthreads(); ROT(); } while (0)
#if ATTN_HAND
  int ka[6];
#pragma unroll
  for (int d0 = 0; d0 < 6; ++d0) ka[d0] = (int)(uintptr_t)K_lds + KSWZ(r32, (d0 * 16 + hi * 8) * 2);
#define LGKM(n) asm volatile("s_waitcnt lgkmcnt(" #n ")" ::: "memory")
#define LGKMK(n, X) asm volatile("s_waitcnt lgkmcnt(" #n ")" : "+v"(X[0]), "+v"(X[1]) :: "memory")
#define LGKMV(n, X) asm volatile("s_waitcnt lgkmcnt(" #n ")" : "+v"(X[0]), "+v"(X[1]), "+v"(X[2]), "+v"(X[3]), "+v"(X[4]), "+v"(X[5]), "+v"(X[6]), "+v"(X[7]) :: "memory")
#define MF(a, b, c) __builtin_amdgcn_mfma_f32_32x32x16_bf16(a, b, c, 0, 0, 0)
#define KRD(X, d) do { const int a_ = ka[d] + o_cur; X[0] = k_read<0>(a_); X[1] = k_read<8192>(a_); } while (0)
#define QK2(X, d, PC0, PC1) do { PC0 = MF(X[0], qr[d], PC0); PC1 = MF(X[1], qr[d], PC1); asm volatile("" : "+v"(PC0), "+v"(PC1)); } while (0)
#define VRD(X, D0) do { X[0] = tr_read<v_rd_off(D0, 0, 0)>(vbp); X[1] = tr_read<v_rd_off(D0, 0, 1)>(vbp); X[2] = tr_read<v_rd_off(D0, 1, 0)>(vbp); X[3] = tr_read<v_rd_off(D0, 1, 1)>(vbp); \
                        X[4] = tr_read<v_rd_off(D0, 2, 0)>(vbp); X[5] = tr_read<v_rd_off(D0, 2, 1)>(vbp); X[6] = tr_read<v_rd_off(D0, 3, 0)>(vbp); X[7] = tr_read<v_rd_off(D0, 3, 1)>(vbp); } while (0)
#define PKV(L, H) (bf16x8){L[0], L[1], L[2], L[3], H[0], H[1], H[2], H[3]}
#define PVM(OD, X) do { OD = MF(pa0, PKV(X[0], X[1]), OD); OD = MF(pa1, PKV(X[2], X[3]), OD); OD = MF(pa2, PKV(X[4], X[5]), OD); OD = MF(pa3, PKV(X[6], X[7]), OD); } while (0)
#define P2(P, i) ((f32x2){P[2 * (i)], P[2 * (i) + 1]})
#define PK4N(P, BASE, OUT) do { u32x4 w = {cvt2n(P[BASE + 0], P[BASE + 1]), cvt2n(P[BASE + 2], P[BASE + 3]), cvt2n(P[BASE + 4], P[BASE + 5]), cvt2n(P[BASE + 6], P[BASE + 7])}; OUT = *reinterpret_cast<bf16x8*>(&w); } while (0)
#define EXPR(P, lo, hi_) do { _Pragma("unroll") for (int r = lo; r < hi_; ++r) P[r] = __builtin_amdgcn_exp2f(P[r]); } while (0)
#define HSTEP(PC0, PC1, PP0, PP1, jj) do { const int vbp = vb0 + o_prev; bf16x8 k0[2], k1[2]; s16x4 va[8], vb[8]; f32x2 t0, t1, t2, t3, sa, sb; \
    SBAR(); KRD(k0, 0); KRD(k1, 1); \
    LGKMK(2, k0); SBAR(); PC0 = MF(k0[0], qr[0], (f32x16)(0.f)); PC1 = MF(k0[1], qr[0], (f32x16)(0.f)); asm volatile("" : "+v"(PC0), "+v"(PC1)); EXPR(PP1, 0, 4); t0 = P2(PP0, 0) + P2(PP0, 1); t1 = P2(PP0, 2) + P2(PP0, 3); SBAR(); \
    KRD(k0, 2); LGKMK(2, k1); SBAR(); QK2(k1, 1, PC0, PC1); EXPR(PP1, 4, 8); t2 = P2(PP0, 4) + P2(PP0, 5); t3 = P2(PP0, 6) + P2(PP0, 7); sa = (t0 + t1) + (t2 + t3); SBAR(); \
    KRD(k1, 3); LGKMK(2, k0); SBAR(); QK2(k0, 2, PC0, PC1); EXPR(PP1, 8, 12); PK4N(PP0, 0, pa0); SBAR(); \
    KRD(k0, 4); LGKMK(2, k1); SBAR(); QK2(k1, 3, PC0, PC1); EXPR(PP1, 12, 16); PK4N(PP0, 8, pa1); SBAR(); \
    KRD(k1, 5); LGKMK(2, k0); SBAR(); QK2(k0, 4, PC0, PC1); \
      sb = ((P2(PP1, 0) + P2(PP1, 1)) + (P2(PP1, 2) + P2(PP1, 3))) + ((P2(PP1, 4) + P2(PP1, 5)) + (P2(PP1, 6) + P2(PP1, 7))); l_reg2 += sa + sb; asm volatile("" : "+v"(l_reg2)); SBAR(); \
    VRD(va, 0); LGKMK(8, k1); SBAR(); QK2(k1, 5, PC0, PC1); PK4N(PP1, 0, pa2); PK4N(PP1, 8, pa3); SBAR(); \
    LGKM(7); VRD(vb, 1); LGKMV(8, va); SBAR(); PVM(o[0], va); EXPR(PC0, 0, 8); asm volatile("" : "+v"(PC0)); SBAR(); \
    LGKMV(0, vb); SBAR(); PVM(o[1], vb); EXPR(PC0, 8, 16); asm volatile("" : "+v"(PC0)); SBAR(); \
    if ((jj) + 1 < NT) SWRITE(o_next); \
    if ((jj) + 2 < NT) SLOAD(((jj) + 2) * KVBLK); \
    __syncthreads(); ROT(); } while (0)
  for (int j = 1; j + 1 < NT; j += 2) { HSTEP(pB0, pB1, pA0, pA1, j); HSTEP(pA0, pA1, pB0, pB1, j + 1); }
  HSTEP(pB0, pB1, pA0, pA1, NT - 1);
#undef HSTEP
#undef EXPR
#undef PK4N
#undef P2
#undef PVM
#undef PKV
#undef VRD
#undef QK2
#undef KRD
#undef MF
#undef LGKM
#undef LGKMK
#undef LGKMV
#else
  for (int j = 1; j + 1 < NT; j += 2) { STEP(pB0, pB1, pA0, pA1, j); STEP(pA0, pA1, pB0, pB1, j + 1); }
  STEP(pB0, pB1, pA0, pA1, NT - 1);
#endif
  finishSM(pB0, pB1, l_reg2, pa0, pa1, pa2, pa3); SBAR();
  pv_d0(o, vb0 + o_prev, pa0, pa1, pa2, pa3);
#undef STEP
#undef ROT
  float l_reg = l_reg2[0] + l_reg2[1];
  { auto rr = __builtin_amdgcn_permlane32_swap(__float_as_uint(l_reg), __float_as_uint(l_reg), false, false); l_reg = __uint_as_float(rr[0]) + __uint_as_float(rr[1]); }
  if (hi == 0) li_l[r32] = l_reg; asm volatile("s_waitcnt lgkmcnt(0)" ::: "memory");
  float rli[16];
#pragma unroll
  for (int r = 0; r < 16; ++r) rli[r] = __builtin_amdgcn_rcpf(li_l[crow(r, hi)]);
  bf16_t* Ow = Ob + (long)(wid * QBLK) * ldo;
#pragma unroll
  for (int r = 0; r < 16; ++r) { int orow = crow(r, hi);
#pragma unroll
    for (int d0 = 0; d0 < 2; ++d0) Ow[(long)orow * ldo + d0 * 32 + r32] = (bf16_t)(cvtpk(o[d0][r] * rli[r], 0.f) & 0xffffu); }
  __builtin_amdgcn_s_setprio(0);
  __syncthreads();
#undef SLOAD
#undef SWRITE
}

typedef int i32x4v __attribute__((ext_vector_type(4))); typedef int i32x8v __attribute__((ext_vector_type(8)));
#define KSW8(row, cb) ((row) * 128 + ((cb) ^ (((row) & 7) << 4)))
#define F8C(lo, hi_) __builtin_shufflevector(__builtin_bit_cast(i32x4v, lo), __builtin_bit_cast(i32x4v, hi_), 0, 1, 2, 3, 4, 5, 6, 7)
#define MF8(a, b, c) __builtin_amdgcn_mfma_scale_f32_32x32x64_f8f6f4(a, b, c, 0, 0, 0, 0x7F7F7F7F, 0, 0x7C7C7C7C)
__device__ __forceinline__ void attn_dense_body8(int tid_in, const unsigned char* __restrict__ Q8, int ldq, const unsigned char* __restrict__ K8, const bf16_t* __restrict__ Vh,
                                                 bf16_t* __restrict__ Ob, int ldo, int NT, char* lds) {
  int tid_ = tid_in; asm volatile("" : "+v"(tid_));
  const int tid = tid_, wid = tid >> 6, lane = tid & 63, r32 = lane & 31, hi = lane >> 5;
  bf16_t* V_lds = (bf16_t*)lds; char* K_lds = lds + NSLOT * SHM_V;
  float* li_l = (float*)(lds + NSLOT * SHM_V + NSLOT * SHM_K) + wid * 64;
  f32x2 l_reg2 = {0.f, 0.f}; f32x16 o[2] = {};
  i32x8v qa, qb;
  { const unsigned char* Qw = Q8 + (long)(wid * QBLK + r32) * ldq + hi * 32;
    const i32x4v a0 = *(const i32x4v*)Qw, a1 = *(const i32x4v*)(Qw + 16); i32x4v b0 = {0, 0, 0, 0}, b1 = {0, 0, 0, 0};
    if (hi == 0) { b0 = *(const i32x4v*)(Qw + 64); b1 = *(const i32x4v*)(Qw + 80); }
    qa = F8C(a0, a1); qb = F8C(b0, b1); }
  const bool kst = tid < 384;
  const int kst0 = KSW8(tid / 6, (tid % 6) * 16);
  const int vst0 = v_st(tid >> 3, (tid & 7) * 8);
  const int vb0 = (int)(uintptr_t)V_lds + v_rd_base(lane);
  int kb[4];
#pragma unroll
  for (int j = 0; j < 4; ++j) kb[j] = (int)(uintptr_t)K_lds + KSW8(r32, 32 * hi + 16 * (j & 1) + 64 * (j >> 1));
  if (kst) { const int sl = tid >> 7, row = (tid & 127) >> 1, cb = 96 + 16 * (tid & 1); *(i32x4v*)(K_lds + sl * SLOTB + KSW8(row, cb)) = (i32x4v){0, 0, 0, 0}; }
  bf16x8 sv0, sk0;
#define SLOAD(k0) do { sv0 = ld8(Vh + (long)(k0) * 64 + tid * 8); if (kst) sk0 = *(const bf16x8*)(K8 + (long)(k0) * 96 + tid * 16); } while (0)
#define SWRITE(off) do { *(bf16x8*)((char*)V_lds + (off) + vst0) = sv0; if (kst) *(bf16x8*)(K_lds + (off) + kst0) = sk0; } while (0)
  int o_prev = 0, o_cur = 0, o_next = SLOTB;
#define ROT() do { o_prev = o_cur; o_cur = o_next; o_next = (o_next == (NSLOT - 1) * SLOTB) ? 0 : o_next + SLOTB; } while (0)
  f32x16 pA0, pA1, pB0, pB1; bf16x8 pa0, pa1, pa2, pa3;
  if (__builtin_amdgcn_readfirstlane(wid) >= 4) __builtin_amdgcn_s_setprio(1);
#define LGKM(n) asm volatile("s_waitcnt lgkmcnt(" #n ")" ::: "memory")
#define LGKM4(n, X) asm volatile("s_waitcnt lgkmcnt(" #n ")" : "+v"(X[0]), "+v"(X[1]), "+v"(X[2]), "+v"(X[3]) :: "memory")
#define LGKMV(n, X) asm volatile("s_waitcnt lgkmcnt(" #n ")" : "+v"(X[0]), "+v"(X[1]), "+v"(X[2]), "+v"(X[3]), "+v"(X[4]), "+v"(X[5]), "+v"(X[6]), "+v"(X[7]) :: "memory")
#define MF(a, b, c) __builtin_amdgcn_mfma_f32_32x32x16_bf16(a, b, c, 0, 0, 0)
#define KRD8(X, g) do { const int a0_ = kb[2 * (g)] + o_cur, a1_ = kb[2 * (g) + 1] + o_cur; X[0] = k_read<0>(a0_); X[1] = k_read<0>(a1_); X[2] = k_read<4096>(a0_); X[3] = k_read<4096>(a1_); } while (0)
#define VRD(X, D0) do { X[0] = tr_read<v_rd_off(D0, 0, 0)>(vbp); X[1] = tr_read<v_rd_off(D0, 0, 1)>(vbp); X[2] = tr_read<v_rd_off(D0, 1, 0)>(vbp); X[3] = tr_read<v_rd_off(D0, 1, 1)>(vbp); \
                        X[4] = tr_read<v_rd_off(D0, 2, 0)>(vbp); X[5] = tr_read<v_rd_off(D0, 2, 1)>(vbp); X[6] = tr_read<v_rd_off(D0, 3, 0)>(vbp); X[7] = tr_read<v_rd_off(D0, 3, 1)>(vbp); } while (0)
#define PKV(L, H) (bf16x8){L[0], L[1], L[2], L[3], H[0], H[1], H[2], H[3]}
#define PVM(OD, X) do { OD = MF(pa0, PKV(X[0], X[1]), OD); OD = MF(pa1, PKV(X[2], X[3]), OD); OD = MF(pa2, PKV(X[4], X[5]), OD); OD = MF(pa3, PKV(X[6], X[7]), OD); } while (0)
#define P2(P, i) ((f32x2){P[2 * (i)], P[2 * (i) + 1]})
#define PK4N(P, BASE, OUT) do { u32x4 w = {cvt2n(P[BASE + 0], P[BASE + 1]), cvt2n(P[BASE + 2], P[BASE + 3]), cvt2n(P[BASE + 4], P[BASE + 5]), cvt2n(P[BASE + 6], P[BASE + 7])}; OUT = *reinterpret_cast<bf16x8*>(&w); } while (0)
#define EXPR(P, lo, hi_) do { _Pragma("unroll") for (int r = lo; r < hi_; ++r) P[r] = __builtin_amdgcn_exp2f(P[r]); } while (0)
  SLOAD(0); asm volatile("s_waitcnt vmcnt(0)" ::: "memory"); SWRITE(0); SLOAD(KVBLK); __syncthreads();
  { bf16x8 x0[4], x1[4]; KRD8(x0, 0); KRD8(x1, 1); LGKM4(0, x0); LGKM4(0, x1); SBAR();
    pA0 = MF8(F8C(x0[0], x0[1]), qa, (f32x16)(0.f)); pA1 = MF8(F8C(x0[2], x0[3]), qa, (f32x16)(0.f)); pA0 = MF8(F8C(x1[0], x1[1]), qb, pA0); pA1 = MF8(F8C(x1[2], x1[3]), qb, pA1); }
  partialSM(pA0);
  SWRITE(SLOTB); if (2 < NT) SLOAD(2 * KVBLK);
  __syncthreads(); ROT();
#define HSTEP8(PC0, PC1, PP0, PP1, jj) do { const int vbp = vb0 + o_prev; bf16x8 k0[4], k1[4]; s16x4 va[8], vb[8]; f32x2 t0, t1, t2, t3, sa, sb; \
    SBAR(); KRD8(k0, 0); KRD8(k1, 1); \
    LGKM4(4, k0); SBAR(); PC0 = MF8(F8C(k0[0], k0[1]), qa, (f32x16)(0.f)); PC1 = MF8(F8C(k0[2], k0[3]), qa, (f32x16)(0.f)); asm volatile("" : "+v"(PC0), "+v"(PC1)); \
      EXPR(PP1, 0, 8); PK4N(PP0, 0, pa0); PK4N(PP0, 8, pa1); SBAR(); \
    VRD(va, 0); LGKM4(8, k1); SBAR(); PC0 = MF8(F8C(k1[0], k1[1]), qb, PC0); PC1 = MF8(F8C(k1[2], k1[3]), qb, PC1); asm volatile("" : "+v"(PC0), "+v"(PC1)); \
      EXPR(PP1, 8, 16); PK4N(PP1, 0, pa2); PK4N(PP1, 8, pa3); SBAR(); \
    LGKM(7); VRD(vb, 1); LGKMV(8, va); SBAR(); PVM(o[0], va); EXPR(PC0, 0, 8); asm volatile("" : "+v"(PC0)); \
      t0 = P2(PP0, 0) + P2(PP0, 1); t1 = P2(PP0, 2) + P2(PP0, 3); t2 = P2(PP0, 4) + P2(PP0, 5); t3 = P2(PP0, 6) + P2(PP0, 7); sa = (t0 + t1) + (t2 + t3); asm volatile("" : "+v"(sa)); SBAR();     \
    LGKMV(0, vb); SBAR(); PVM(o[1], vb); EXPR(PC0, 8, 16); asm volatile("" : "+v"(PC0)); \
      sb = ((P2(PP1, 0) + P2(PP1, 1)) + (P2(PP1, 2) + P2(PP1, 3))) + ((P2(PP1, 4) + P2(PP1, 5)) + (P2(PP1, 6) + P2(PP1, 7))); l_reg2 += sa + sb; asm volatile("" : "+v"(l_reg2)); SBAR(); \
    if ((jj) + 1 < NT) SWRITE(o_next); \
    if ((jj) + 2 < NT) SLOAD(((jj) + 2) * KVBLK); \
    __syncthreads(); ROT(); } while (0)
  for (int j = 1; j + 1 < NT; j += 2) { HSTEP8(pB0, pB1, pA0, pA1, j); HSTEP8(pA0, pA1, pB0, pB1, j + 1); }
  HSTEP8(pB0, pB1, pA0, pA1, NT - 1);
  finishSM(pB0, pB1, l_reg2, pa0, pa1, pa2, pa3); SBAR();
  pv_d0(o, vb0 + o_prev, pa0, pa1, pa2, pa3);
  float l_reg = l_reg2[0] + l_reg2[1];
  { auto rr = __builtin_amdgcn_permlane32_swap(__float_as_uint(l_reg), __float_as_uint(l_reg), false, false); l_reg = __uint_as_float(rr[0]) + __uint_as_float(rr[1]); }
  if (hi == 0) li_l[r32] = l_reg; asm volatile("s_waitcnt lgkmcnt(0)" ::: "memory");
  float rli[16];
#pragma unroll
  for (int r = 0; r < 16; ++r) rli[r] = __builtin_amdgcn_rcpf(li_l[crow(r, hi)]);
  bf16_t* Ow = Ob + (long)(wid * QBLK) * ldo;
#pragma unroll
  for (int r = 0; r < 16; ++r) { int orow = crow(r, hi);
#pragma unroll
    for (int d0 = 0; d0 < 2; ++d0) Ow[(long)orow * ldo + d0 * 32 + r32] = (bf16_t)(cvt2n(o[d0][r] * rli[r], 0.f) & 0xffffu); }
  __builtin_amdgcn_s_setprio(0);
  __syncthreads();
#undef HSTEP8
#undef EXPR
#undef PK4N
#undef P2
#undef PVM
#undef PKV
#undef VRD
#undef KRD8
#undef MF
#undef LGKMV
#undef LGKM4
#undef LGKM
#undef ROT
#undef SWRITE
#undef SLOAD
}
#undef MF8
#undef F8C
#undef KSW8
#undef KSWZ
#undef SBAR
}
namespace attn16 {
typedef unsigned short bf16_t;
using bf16x8 = __attribute__((ext_vector_type(8))) short;
using s16x4  = __attribute__((ext_vector_type(4))) short;
using f32x4  = __attribute__((ext_vector_type(4))) float;
using u32x4  = __attribute__((ext_vector_type(4))) unsigned;
typedef float f32x2_t __attribute__((ext_vector_type(2))); typedef __bf16 bf16x2_t __attribute__((ext_vector_type(2))); typedef short v4i16_t __attribute__((ext_vector_type(4)));
#define A16LAS __attribute__((address_space(3)))
#define A16SBAR() __builtin_amdgcn_sched_barrier(0)
constexpr int KVBLK = 64, NSLOT = 3, KSLOT = 12288, VSLOT = 10240, VPB = 160, LDS_V0 = NSLOT * KSLOT, SHM_ATTN16 = NSLOT * (KSLOT + VSLOT);
constexpr float PSHIFT = 8.0f;
__device__ __forceinline__ unsigned cvtpk(float lo, float hi) { f32x2_t v = {lo, hi}; bf16x2_t b = __builtin_convertvector(v, bf16x2_t); return __builtin_bit_cast(unsigned, b); }
__device__ __forceinline__ bf16x8 pack8(const f32x4 a, const f32x4 b) { u32x4 w = {cvtpk(a[0], a[1]), cvtpk(a[2], a[3]), cvtpk(b[0], b[1]), cvtpk(b[2], b[3])}; return __builtin_bit_cast(bf16x8, w); }
__device__ __forceinline__ s16x4 trd(const A16LAS char* p) { return __builtin_bit_cast(s16x4, __builtin_amdgcn_ds_read_tr16_b64_v4i16((A16LAS v4i16_t*)p)); }
__device__ __forceinline__ bf16x8 ld8(const bf16_t* p) { return *reinterpret_cast<const bf16x8*>(p); }

__device__ __forceinline__ void qk16(f32x4 (&S)[4][2], const A16LAS char* ks, const bf16x8 (&qf)[2][3], int lane) {
#pragma unroll
  for (int kb = 0; kb < 4; ++kb) {
    S[kb][0] = (f32x4){-PSHIFT, -PSHIFT, -PSHIFT, -PSHIFT}; S[kb][1] = S[kb][0];
#pragma unroll
    for (int s = 0; s < 3; ++s) { const bf16x8 kf = *(const A16LAS bf16x8*)(ks + ((kb * 3 + s) * 64 + lane) * 16);
      S[kb][0] = __builtin_amdgcn_mfma_f32_16x16x32_bf16(kf, qf[0][s], S[kb][0], 0, 0, 0);
      S[kb][1] = __builtin_amdgcn_mfma_f32_16x16x32_bf16(kf, qf[1][s], S[kb][1], 0, 0, 0); } }
}
__device__ __forceinline__ void exp_half(f32x4 (&S)[4][2], int kb0) {
#pragma unroll
  for (int kb = 0; kb < 2; ++kb)
#pragma unroll
    for (int qb = 0; qb < 2; ++qb)
#pragma unroll
      for (int r = 0; r < 4; ++r) S[kb0 + kb][qb][r] = __builtin_amdgcn_exp2f(S[kb0 + kb][qb][r]);
}
__device__ __forceinline__ void finish16(f32x4 (&S)[4][2], float (&lsum)[2], bf16x8 (&pf)[2][2]) {
  exp_half(S, 2);
#pragma unroll
  for (int qb = 0; qb < 2; ++qb) { float ps = 0.f;
#pragma unroll
    for (int kb = 0; kb < 4; ++kb) ps += (S[kb][qb][0] + S[kb][qb][1]) + (S[kb][qb][2] + S[kb][qb][3]);
    lsum[qb] += ps;
    pf[qb][0] = pack8(S[0][qb], S[1][qb]); pf[qb][1] = pack8(S[2][qb], S[3][qb]); }
}
__device__ __forceinline__ void pv16(f32x4 (&o)[2][4], const A16LAS char* vp, const bf16x8 (&pf)[2][2]) {
#pragma unroll
  for (int ks = 0; ks < 2; ++ks)
#pragma unroll
    for (int db = 0; db < 4; ++db) { const s16x4 lo = trd(vp + ks * 32 * VPB + db * 32), hi = trd(vp + ks * 32 * VPB + 16 * VPB + db * 32);
      const bf16x8 vf = {lo[0], lo[1], lo[2], lo[3], hi[0], hi[1], hi[2], hi[3]};
      o[0][db] = __builtin_amdgcn_mfma_f32_16x16x32_bf16(pf[0][ks], vf, o[0][db], 0, 0, 0);
      o[1][db] = __builtin_amdgcn_mfma_f32_16x16x32_bf16(pf[1][ks], vf, o[1][db], 0, 0, 0); }
}
__device__ __forceinline__ void attn_body16(int tid_in, const bf16_t* __restrict__ Qb, int ldq, const bf16_t* __restrict__ Kh, const bf16_t* __restrict__ Vh,
                                            bf16_t* __restrict__ Ob, int ldo, int NT, char* lds) {
  int tid_ = tid_in; asm volatile("" : "+v"(tid_));
  const int tid = tid_, wid = tid >> 6, lane = tid & 63, r16 = lane & 15, quad = lane >> 4;
  A16LAS char* L3 = (A16LAS char*)lds;
  const A16LAS char* K3 = L3; const A16LAS char* V3 = L3 + LDS_V0 + (4 * quad + (r16 >> 2)) * VPB + (r16 & 3) * 8;
  bf16x8 qf[2][3];
#pragma unroll
  for (int qb = 0; qb < 2; ++qb)
#pragma unroll
    for (int s = 0; s < 3; ++s) qf[qb][s] = ld8(Qb + (long)(wid * 32 + 16 * qb + r16) * ldq + 32 * s + 8 * quad);
  const bool two = tid < 256;
  const int kc0 = tid, kc1 = tid + 512;
  const int kst0 = ((((kc0 / 12) >> 4) * 3 + ((kc0 % 12) >> 2)) * 64 + ((kc0 / 12) & 15) + 16 * ((kc0 % 12) & 3)) * 16;
  const int kst1 = ((((kc1 / 12) >> 4) * 3 + ((kc1 % 12) >> 2)) * 64 + ((kc1 / 12) & 15) + 16 * ((kc1 % 12) & 3)) * 16;
  const int vst0 = LDS_V0 + (tid >> 3) * VPB + (tid & 7) * 16;
  bf16x8 sv0, sk0, sk1;
#define SLOAD(k0) do { sv0 = ld8(Vh + (long)(k0) * 64 + tid * 8); sk0 = ld8(Kh + (long)(k0) * 96 + kc0 * 8); if (two) sk1 = ld8(Kh + (long)(k0) * 96 + kc1 * 8); } while (0)
#define SWRITE(sl) do { *(A16LAS bf16x8*)(L3 + (sl) * VSLOT + vst0) = sv0; *(A16LAS bf16x8*)(L3 + (sl) * KSLOT + kst0) = sk0; if (two) *(A16LAS bf16x8*)(L3 + (sl) * KSLOT + kst1) = sk1; } while (0)
  int s_prev = 0, s_cur = 0, s_next = 1;
#define ROT() do { s_prev = s_cur; s_cur = s_next; s_next = (s_next == NSLOT - 1) ? 0 : s_next + 1; } while (0)
  f32x4 sA[4][2], sB[4][2], o[2][4]; bf16x8 pf[2][2]; float lsum[2] = {0.f, 0.f};
#pragma unroll
  for (int qb = 0; qb < 2; ++qb)
#pragma unroll
    for (int db = 0; db < 4; ++db) o[qb][db] = (f32x4){0.f, 0.f, 0.f, 0.f};
  SLOAD(0); asm volatile("s_waitcnt vmcnt(0)" ::: "memory"); SWRITE(0); SLOAD(KVBLK); __syncthreads();
  qk16(sA, K3, qf, lane); exp_half(sA, 0);
  SWRITE(1); if (2 < NT) SLOAD(2 * KVBLK);
  __syncthreads(); ROT();
#define STEP(SC, SP, jj) do { \
    A16SBAR(); qk16(SC, K3 + s_cur * KSLOT, qf, lane); finish16(SP, lsum, pf); A16SBAR(); \
    if ((jj) + 1 < NT) SWRITE(s_next); \
    if ((jj) + 2 < NT) SLOAD(((jj) + 2) * KVBLK); \
    A16SBAR(); pv16(o, V3 + s_prev * VSLOT, pf); exp_half(SC, 0); \
    __syncthreads(); ROT(); } while (0)
  for (int j = 1; j + 1 < NT; j += 2) { STEP(sB, sA, j); STEP(sA, sB, j + 1); }
  STEP(sB, sA, NT - 1);
  finish16(sB, lsum, pf); A16SBAR();
  pv16(o, V3 + s_prev * VSLOT, pf);
#undef STEP
#undef ROT
  bf16_t* Ow = Ob + (long)(wid * 32) * ldo;
#pragma unroll
  for (int qb = 0; qb < 2; ++qb) { float l = lsum[qb]; l += __shfl_xor(l, 16); l += __shfl_xor(l, 32);
#pragma unroll
    for (int r = 0; r < 4; ++r) { const float rl = __builtin_amdgcn_rcpf(__shfl(l, 4 * quad + r)); const long orow = 16 * qb + 4 * quad + r;
#pragma unroll
      for (int db = 0; db < 4; ++db) Ow[orow * ldo + 16 * db + r16] = (bf16_t)(cvtpk(o[qb][db][r] * rl, 0.f) & 0xffffu); } }
  __syncthreads();
#undef SLOAD
#undef SWRITE
}
#undef A16SBAR
}
#define GAS __attribute__((address_space(1)))
#define LAS __attribute__((address_space(3)))
typedef unsigned short bf16_t;
typedef float f32x4 __attribute__((ext_vector_type(4)));
typedef unsigned u32x4 __attribute__((ext_vector_type(4)));
typedef unsigned u32x2 __attribute__((ext_vector_type(2)));
typedef int i32x2 __attribute__((ext_vector_type(2)));
typedef short bf16x8 __attribute__((ext_vector_type(8)));
#define LDS_WAIT() asm volatile("s_waitcnt lgkmcnt(0)" ::: "memory")
__device__ __forceinline__ float bf2f(unsigned short h) { return __uint_as_float(((unsigned)h) << 16); }
__device__ __forceinline__ unsigned short f2bf(float f) { return (unsigned short)(pg8::cvt_pk_bf16(f, 0.f) & 0xffffu); }
template <int CTRL, int RM> __device__ __forceinline__ float dpp_f(float v) { return __builtin_bit_cast(float, __builtin_amdgcn_update_dpp(0, __builtin_bit_cast(int, v), CTRL, RM, 0xf, true)); }
__device__ __forceinline__ float wave_sum(float v) {
    v += dpp_f<0xb1, 0xf>(v); v += dpp_f<0x4e, 0xf>(v); v += dpp_f<0x114, 0xf>(v); v += dpp_f<0x118, 0xf>(v); v += dpp_f<0x142, 0xa>(v); v += dpp_f<0x143, 0xc>(v);
    return __builtin_bit_cast(float, __builtin_amdgcn_readlane(__builtin_bit_cast(int, v), 63));
}
__device__ __forceinline__ float gelu_tanh(float x) { const float z = 0.7978845608028654f * (x + 0.044715f * x * x * x); return x / (1.0f + __expf(-2.0f * z)); }

__device__ __forceinline__ int hw_tid(int wid0) { int ln; asm volatile("v_mbcnt_lo_u32_b32 %0, -1, 0\n\tv_mbcnt_hi_u32_b32 %0, -1, %0" : "=v"(ln)); return wid0 * 64 + ln; }
#define XB_TMO      128
#define XB_XCNT(j)  (256  + 64 * (j))
#define XB_XSUB(j)  (1280 + 64 * (j))
#define XB_XGEN(j)  (2304 + 64 * (j))
#define XB_TOP      3328
#define XB_TOPGEN   3392
#define XCD_BAR_WORDS 3456
#define XB_SPIN_CAP (1u << 18)
__device__ __forceinline__ unsigned xb_ld(unsigned* p)              { return __hip_atomic_load(p, __ATOMIC_RELAXED, __HIP_MEMORY_SCOPE_AGENT); }
__device__ __forceinline__ unsigned xb_add(unsigned* p, unsigned v) { return __hip_atomic_fetch_add(p, v, __ATOMIC_RELAXED, __HIP_MEMORY_SCOPE_AGENT); }
__device__ __forceinline__ unsigned xb_xcc_id() { return (unsigned)__builtin_amdgcn_s_getreg((3 << 11) | 20) & 0xFu; }
#define XB_SPIN(cond, bar) do { unsigned _sp = 0; while (cond) { __builtin_amdgcn_s_sleep(1); \
    if ((++_sp & 255u) == 0u) { if (xb_ld(&(bar)[XB_TMO])) break; if (_sp > XB_SPIN_CAP) { atomicAdd(&(bar)[XB_TMO], 1u); break; } } } } while (0)
struct XcdBarrier { unsigned* bar; unsigned x; volatile LAS unsigned* st; };
__device__ __forceinline__ XcdBarrier xcd_barrier_post(unsigned* bar, volatile LAS unsigned* st, bool t0) {
    XcdBarrier b; b.bar = bar; b.x = xb_xcc_id(); b.st = st;
    if (t0) (void)xb_add(&bar[XB_XCNT(b.x)], 1u);
    return b;
}
__device__ __forceinline__ void xcd_barrier_complete(unsigned* bar, unsigned x, unsigned& nloc, unsigned& nx) {
    const unsigned G = gridDim.x * gridDim.y * gridDim.z;
    unsigned sum, cnt, mine, sp = 0u;
    for (;;) {
        sum = 0u; cnt = 0u; mine = 0u;
#pragma unroll
        for (unsigned j = 0; j < 16; ++j) { const unsigned c = xb_ld(&bar[XB_XCNT(j)]); sum += c; cnt += (c > 0u) ? 1u : 0u; mine = (j == x) ? c : mine; }
        if (sum == G) break;
        __builtin_amdgcn_s_sleep(1);
        if ((++sp & 255u) == 0u) { if (xb_ld(&bar[XB_TMO])) break; if (sp > XB_SPIN_CAP) { atomicAdd(&bar[XB_TMO], 1u); break; } }
    }
    nloc = mine > 0u ? mine : 1u; nx = cnt > 0u ? cnt : 1u;
}
__device__ __forceinline__ void xcd_barrier(const XcdBarrier& b, bool t0) {
    asm volatile("s_waitcnt vmcnt(0)" ::: "memory");
    __syncthreads();
    if (t0) {
        unsigned* bar = b.bar;
        __builtin_amdgcn_s_waitcnt(0);
        unsigned nloc = b.st[0], nx = b.st[1];
        if (nloc == 0u) { xcd_barrier_complete(bar, b.x, nloc, nx); b.st[0] = nloc; b.st[1] = nx; }
        const unsigned old = xb_add(&bar[XB_XSUB(b.x)], 1u);
        const unsigned gen = old / nloc;
        if (old + 1u == (gen + 1u) * nloc) {
            __builtin_amdgcn_fence(__ATOMIC_RELEASE, "agent");
            asm volatile("s_waitcnt vmcnt(0)" ::: "memory");
            const unsigned og = xb_add(&bar[XB_TOP], 1u);
            const unsigned tg = og / nx;
            if (og + 1u == (tg + 1u) * nx) xb_add(&bar[XB_TOPGEN], 1u);
            else XB_SPIN(xb_ld(&bar[XB_TOPGEN]) == tg, bar);
            __builtin_amdgcn_fence(__ATOMIC_ACQUIRE, "agent");
            xb_add(&bar[XB_XGEN(b.x)], 1u);
            asm volatile("s_waitcnt vmcnt(0)" ::: "memory");
        } else {
            XB_SPIN(xb_ld(&bar[XB_XGEN(b.x)]) == gen, bar);
            __builtin_amdgcn_fence(__ATOMIC_ACQUIRE, "agent");
            asm volatile("s_waitcnt vmcnt(0)" ::: "memory");
        }
    }
    __syncthreads();
}

constexpr int TR_SCR = 64 * 65 * 4;
template <class MAP>
__device__ __forceinline__ void transpose_item(const float* W, int K, int N, bf16_t* WT, LAS float* scr, int item, int lane, const MAP& map, const float* kscale = nullptr, int ldt = 0, int koff = 0) {
    const int kblk = K / 64, nb = item / kblk, kb = item - nb * kblk, k0 = 64 * kb, n0 = 64 * nb;
    const int kr = lane >> 4, nq = 4 * (lane & 15); const bool ok = n0 + nq < N;
    f32x4 v[16];
#pragma unroll
    for (int i = 0; i < 16; ++i) v[i] = (f32x4){0.f, 0.f, 0.f, 0.f};
    if (ok) {
        const float* src = W + (size_t)(k0 + kr) * N + n0 + nq;
#pragma unroll
        for (int i = 0; i < 16; ++i) v[i] = *(const f32x4*)(src + (size_t)(4 * i) * N);
    }
#pragma unroll
    for (int i = 0; i < 16; ++i) asm volatile("" : "+v"(v[i]));
#pragma unroll
    for (int i = 0; i < 16; ++i) { const int k = 4 * i + kr; f32x4 x = v[i]; if (kscale) x = x * kscale[k0 + k];
        LAS float* d = scr + k * 65 + nq; d[0] = x[0]; d[1] = x[1]; d[2] = x[2]; d[3] = x[3]; }
    LDS_WAIT(); asm volatile("" ::: "memory");
    const int c = lane & 7;
#pragma unroll
    for (int j = 0; j < 8; ++j) { const int n = (lane >> 3) + 8 * j; const LAS float* s = scr + (8 * c) * 65 + n;
        u32x4 o; o.x = pg8::cvt_pk_bf16(s[0 * 65], s[1 * 65]); o.y = pg8::cvt_pk_bf16(s[2 * 65], s[3 * 65]); o.z = pg8::cvt_pk_bf16(s[4 * 65], s[5 * 65]); o.w = pg8::cvt_pk_bf16(s[6 * 65], s[7 * 65]);
        const int dr = (n0 + n < N) ? map(n0 + n) : -1;
        if (dr >= 0) *(u32x4*)(WT + (size_t)dr * (ldt ? ldt : K) + koff + k0 + 8 * c) = o; }
    LDS_WAIT(); asm volatile("" ::: "memory");
}
struct MapId { int off; __device__ __forceinline__ int operator()(int n) const { return n + off; } };
template <class MAP>
__device__ __forceinline__ void transpose_item_f8(const float* W, int K, int N, unsigned char* WT, LAS float* scr, int item, int lane, const MAP& map, const float* kscale = nullptr, int ldt = 0, int koff = 0) {
    const int kblk = K / 64, nb = item / kblk, kb = item - nb * kblk, k0 = 64 * kb, n0 = 64 * nb;
    const int kr = lane >> 4, nq = 4 * (lane & 15); const bool ok = n0 + nq < N;
    f32x4 v[16];
#pragma unroll
    for (int i = 0; i < 16; ++i) v[i] = (f32x4){0.f, 0.f, 0.f, 0.f};
    if (ok) {
        const float* src = W + (size_t)(k0 + kr) * N + n0 + nq;
#pragma unroll
        for (int i = 0; i < 16; ++i) v[i] = *(const f32x4*)(src + (size_t)(4 * i) * N);
    }
#pragma unroll
    for (int i = 0; i < 16; ++i) asm volatile("" : "+v"(v[i]));
#pragma unroll
    for (int i = 0; i < 16; ++i) { const int k = 4 * i + kr; f32x4 x = v[i]; if (kscale) x = x * kscale[k0 + k];
        LAS float* d = scr + k * 65 + nq; d[0] = x[0]; d[1] = x[1]; d[2] = x[2]; d[3] = x[3]; }
    LDS_WAIT(); asm volatile("" ::: "memory");
    const int c = lane & 7;
#pragma unroll
    for (int j = 0; j < 8; ++j) { const int n = (lane >> 3) + 8 * j; const LAS float* s = scr + (8 * c) * 65 + n;
        int o0 = 0, o1 = 0;
        o0 = __builtin_amdgcn_cvt_pk_fp8_f32(s[0 * 65] * 32.0f, s[1 * 65] * 32.0f, o0, false); o0 = __builtin_amdgcn_cvt_pk_fp8_f32(s[2 * 65] * 32.0f, s[3 * 65] * 32.0f, o0, true);
        o1 = __builtin_amdgcn_cvt_pk_fp8_f32(s[4 * 65] * 32.0f, s[5 * 65] * 32.0f, o1, false); o1 = __builtin_amdgcn_cvt_pk_fp8_f32(s[6 * 65] * 32.0f, s[7 * 65] * 32.0f, o1, true);
        const int dr = (n0 + n < N) ? map(n0 + n) : -1;
        if (dr >= 0) *(i32x2*)(WT + (size_t)dr * (ldt ? ldt : K) + koff + k0 + 8 * c) = (i32x2){o0, o1}; }
    LDS_WAIT(); asm volatile("" ::: "memory");
}
struct MapIn { __device__ __forceinline__ int operator()(int n) const { if (n < 1440) return n < 1152 ? n : n < 1408 ? n + 128 : n - 256;
    const int g = n - 1440, c = g & 255; return 1536 + (g & ~255) + ((c >> 3) & 1) * 128 + (c >> 6) * 32 + ((c >> 4) & 3) * 8 + (c & 7); } };
struct MapDn { int base; __device__ __forceinline__ int operator()(int n) const { const int c = n & 255; return base + (n & ~255) + ((c >> 3) & 1) * 128 + (c >> 6) * 32 + ((c >> 4) & 3) * 8 + (c & 7); } };
struct MapUq { __device__ __forceinline__ int operator()(int n) const { const int h = n / 96, d = n - h * 96;
    return d < 64 ? 256 * (h >> 2) + 128 * (d >> 5) + 32 * (h & 3) + (d & 31) : 512 + 128 * (h >> 2) + 32 * (h & 3) + (d - 64); } };
struct MapUkv { __device__ __forceinline__ int operator()(int n) const { const int h = n >> 7, d = n & 127;
    return d < 64 ? 256 * (h >> 1) + 128 * (d >> 5) + 32 * (h & 1) + (d & 31) : 256 * (h >> 1) + 128 * ((d - 64) >> 5) + 32 * (2 + (h & 1)) + ((d - 64) & 31); } };
struct MapGU { int base; __device__ __forceinline__ int operator()(int d) const { return base + 256 * (d >> 7) + (d & 127); } };

__device__ __forceinline__ void rms_mod_store(const f32x4 (&v)[4], const float* g, const float* sh, const float* sc, unsigned char* orow, int lane) {
    float ss = 0.f;
#pragma unroll
    for (int j = 0; j < 4; ++j) ss += pg8::dot4(v[j]);
    const float r = rsqrtf(wave_sum(ss) * (1.0f / DM) + EPS);
#pragma unroll
    for (int j = 0; j < 4; ++j) { const int col = 4 * lane + 256 * j;
        const f32x4 gg = *(const f32x4*)(g + col), s1 = *(const f32x4*)(sc + col), s0 = *(const f32x4*)(sh + col);
        const f32x4 h = v[j] * r * gg * (1.0f + s1) + s0;
        int w = 0; w = __builtin_amdgcn_cvt_pk_fp8_f32(h[0], h[1], w, false); w = __builtin_amdgcn_cvt_pk_fp8_f32(h[2], h[3], w, true);
        *(int*)(orow + col) = w; }
}
constexpr int NWAVES = 8;
#ifndef MK_N_LAUNCHES
#define MK_N_LAUNCHES 1
#endif
constexpr int N_PHASES = 24;
#ifndef ATTN_SHAPE16
#define ATTN_SHAPE16 0
#endif
#if ATTN_SHAPE16
#define ATTN_BODY attn16::attn_body16
#else
#define ATTN_BODY attn::attn_dense_body8
#endif
#ifndef REP_A
#define REP_A 1
#endif
#ifndef REP_D
#define REP_D 1
#endif
#ifndef REP_M
#define REP_M 1
#endif
#ifndef REP_E
#define REP_E 1
#endif
#ifndef REP_C
#define REP_C 1
#endif
#ifndef REP_F
#define REP_F 1
#endif
#ifndef REP_P
#define REP_P 1
#endif
#ifndef REP_B
#define REP_B 1
#endif
#ifndef REP_G
#define REP_G 1
#endif
#ifndef REP_H
#define REP_H 1
#endif
#ifndef REP_K
#define REP_K 1
#endif
#ifndef PHM
#define PHM 0xffff
#endif
#define PH_EN(k) (((PHM) >> (k)) & 1)
struct Args { const float* in[30]; float* out; unsigned char* ws; int ph_lo, ph_hi; int tail_ok, rsv; };
static_assert(sizeof(Args) == 30 * 8 + 8 + 8 + 8 + 8, "Args has no padding");
enum { I_X = 0, I_C, I_CTX, I_CCTX, I_WMOD, I_BMOD, I_N1G, I_N2G, I_WIN, I_POOLW, I_POOLS, I_SGUNG, I_SGUWS, I_SGUB, I_QANG, I_WUQ, I_KVANG, I_WUKV, I_QNG, I_KNG,
       I_WBP, I_WBS, I_WBM, I_BGATE, I_WOUT, I_RW, I_RB, I_WEG, I_WEU, I_WED };


constexpr int WI_IN = 16 * 71, WI_UQ = 6 * 12, WI_UKV = 4 * 16, WI_BP = 4 * 16, WI_BS = 4 * 16, WI_BM = 8 * 16, WI_OUT = 16 * 16, WI_L = WI_IN + WI_UQ + WI_UKV + WI_BP + WI_BS + WI_BM + WI_OUT;
constexpr int WI_G = 16 * 8, WI_D = 8 * 16, WI_X = NE * (2 * WI_G + WI_D);
constexpr size_t WS_TAIL_GU = WS_END, WS_TAIL_DN = WS_END + ((size_t)16 << 20), WS_TAIL_END = WS_END + ((size_t)24 << 20);
#define NONEXPERT_ITEM(l2_, r0_) do { const int l2 = (l2_); int r = (r0_); unsigned char* wl2 = ws + WS_W + (size_t)l2 * W_LAYER; \
    if (r < WI_IN) transpose_item_f8(in[I_WIN] + (size_t)l2 * DM * INW_SRC, DM, INW_SRC, wl2 + W_IN, scr, r, lane, MapIn{});     \
    else if ((r -= WI_IN) < WI_UQ) transpose_item_f8(in[I_WUQ] + (size_t)l2 * QLORA * 768, QLORA, 768, wl2 + W_UQ, scr, r, lane, MapUq{}, in[I_QANG] + l2 * QLORA, 512, 0);     \
    else if ((r -= WI_UQ) < WI_UKV) transpose_item_f8(in[I_WUKV] + (size_t)l2 * KVLORA * 1024, KVLORA, 1024, wl2 + W_UKV, scr, r, lane, MapUkv{}, in[I_KVANG] + l2 * KVLORA);     \
    else if ((r -= WI_UKV) < WI_BP) transpose_item(in[I_WBP] + (size_t)l2 * 256 * DM, 256, DM, (bf16_t*)(wl2 + W_BP) + (size_t)1 * DM * 256, scr, r, lane, MapId{0}); \
    else if ((r -= WI_BP) < WI_BS) transpose_item(in[I_WBS] + (size_t)l2 * 256 * DM, 256, DM, (bf16_t*)(wl2 + W_BP), scr, r, lane, MapId{0}); \
    else if ((r -= WI_BS) < WI_BM) { const int hf = r >= WI_BM / 2 ? 1 : 0; transpose_item(in[I_WBM] + (size_t)l2 * 512 * DM + (size_t)hf * 256 * DM, 256, DM, (bf16_t*)(wl2 + W_BP) + (size_t)(2 + hf) * DM * 256, scr, r - hf * (WI_BM / 2), lane, MapId{0}); } \
    else { r -= WI_BM; transpose_item(in[I_WOUT] + (size_t)l2 * DM * DM, DM, DM, (bf16_t*)(wl2 + W_OUT), scr, r, lane, MapId{0}); } } while (0)
#define NONEXPERT_ZERO(l2_, t0_, nt_) do { unsigned char* wl2 = ws + WS_W + (size_t)(l2_) * W_LAYER; \
    for (int i = (t0_); i < 768 * 8; i += (nt_)) *(u32x4*)(wl2 + W_UQ + (size_t)(i >> 3) * 512 + 384 + (size_t)(i & 7) * 16) = (u32x4){0u, 0u, 0u, 0u}; \
    for (int i = (t0_); i < 96 * 64; i += (nt_)) *(u32x4*)(wl2 + W_IN + (size_t)C_PAD * DM + (size_t)i * 16) = (u32x4){0u, 0u, 0u, 0u}; } while (0)
#define EXPERT_ITEM(ly_, WGU_, WDN_, it_) do { const int ly = (ly_); const int e = (it_) / (2 * WI_G + WI_D); int r = (it_) - e * (2 * WI_G + WI_D); \
    if (r < WI_G) { if (MOE1_FP8) transpose_item_f8(in[I_WEG] + ((size_t)ly * NE + e) * DM * DE, DM, DE, (unsigned char*)(WGU_), scr, r, lane, MapGU{e * 1024}); else transpose_item(in[I_WEG] + ((size_t)ly * NE + e) * DM * DE, DM, DE, (bf16_t*)(WGU_), scr, r, lane, MapGU{e * 1024}); } \
    else if ((r -= WI_G) < WI_G) { if (MOE1_FP8) transpose_item_f8(in[I_WEU] + ((size_t)ly * NE + e) * DM * DE, DM, DE, (unsigned char*)(WGU_), scr, r, lane, MapGU{e * 1024 + 128}); else transpose_item(in[I_WEU] + ((size_t)ly * NE + e) * DM * DE, DM, DE, (bf16_t*)(WGU_), scr, r, lane, MapGU{e * 1024 + 128}); } \
    else { r -= WI_G; if (MOE2_FP8 && XS_FP8) transpose_item_f8(in[I_WED] + ((size_t)ly * NE + e) * DE * DM, DE, DM, (unsigned char*)(WDN_), scr, r, lane, MapDn{e * 1024}); else if (MOE2_FP8) transpose_item_f8(in[I_WED] + ((size_t)ly * NE + e) * DE * DM, DE, DM, (unsigned char*)(WDN_), scr, r, lane, MapId{e * 1024}); else transpose_item(in[I_WED] + ((size_t)ly * NE + e) * DE * DM, DE, DM, (bf16_t*)(WDN_), scr, r, lane, MapId{e * 1024}); } } while (0)

__device__ __forceinline__ void row_bk(int row, int& b, int& key) { if (row < NLAT) { b = row >> 13; key = row & (SEQ - 1); } else { const int r2 = row - NLAT; b = r2 >> 8; key = SEQ + (r2 & 255); } }

__global__ void __launch_bounds__(NWAVES * 64, 2) mk_fwd(Args args) {
    extern __shared__ __attribute__((aligned(16))) unsigned char lds[];
    LAS unsigned char* L = (LAS unsigned char*)lds;
    volatile LAS unsigned* MISC = (volatile LAS unsigned*)(L + MISC_OFF);
    const int wid0 = __builtin_amdgcn_readfirstlane((int)threadIdx.x >> 6);
    const int G = gridDim.x, bx = blockIdx.x;
    const int vcu = (G % 8 == 0) ? (bx % 8) * (G / 8) + bx / 8 : bx;
    const int NGW = G * NWAVES;
    const bool EARLY1 = (G == 256) && args.tail_ok != 0;
#define PH_BEGIN() \
    int tid = hw_tid(wid0); int zs = 0; asm volatile("" : "+v"(tid), "+s"(zs)); \
    const int lane = tid & 63, wid = __builtin_amdgcn_readfirstlane(tid >> 6), gw = vcu * NWAVES + wid; (void)lane; (void)gw; \
    const float* const* in = args.in + zs; unsigned char* ws = args.ws + zs; float* OUT = args.out + zs; (void)in; (void)OUT; \
    unsigned* ctl = (unsigned*)(ws + WS_CTL); (void)ctl; \
    float* MOD = (float*)(ws + WS_MOD); float* cosT = (float*)(ws + WS_ROPE); float* sinT = cosT + 1024; (void)MOD; (void)sinT; \
    u32x4* RT = (u32x4*)(ws + WS_RT); i32x2* POS = (i32x2*)(ws + WS_POS); float* XC = (float*)(ws + WS_XC); (void)RT; (void)POS; (void)XC; \
    bf16_t* XN = (bf16_t*)(ws + WS_XN); bf16_t* Qb = XN; bf16_t* MG = XN; (void)Qb; (void)MG; \
    bf16_t* Kb = (bf16_t*)(ws + WS_K); bf16_t* Vb = (bf16_t*)(ws + WS_V); (void)Kb; (void)Vb; \
    bf16_t* PROJ = (bf16_t*)(ws + WS_PROJ); bf16_t* XS = (bf16_t*)(ws + WS_XS); bf16_t* ACT = (bf16_t*)(ws + WS_ACT); (void)PROJ; (void)XS; (void)ACT; \
    bf16_t* X1B = (bf16_t*)(ws + WS_K); (void)X1B;     \
    bf16_t* WGU = (bf16_t*)(ws + ((l == 1 && EARLY1) ? WS_TAIL_GU : (size_t)WS_WGU)); bf16_t* WDN = (bf16_t*)(ws + ((l == 1 && EARLY1) ? WS_TAIL_DN : (size_t)WS_WDN)); (void)WGU; (void)WDN; \
    unsigned char* wl = ws + WS_W + (size_t)l * W_LAYER; (void)wl; \
    const float* MODL = MOD + (size_t)l * 5 * 6 * DM; (void)MODL;
    for (int u = hw_tid(wid0); u < (LDS_BYTES - MISC_OFF) / 4; u += NWAVES * 64) MISC[u] = 0u;
    __syncthreads();
    unsigned* const barw = (unsigned*)(args.ws + WS_CTL) + CW_BAR;
    XcdBarrier bar; bar.bar = barw; bar.x = 0; bar.st = nullptr;
    if (MK_N_LAUNCHES == 1) bar = xcd_barrier_post(barw, MISC + 8, hw_tid(wid0) == 0);
#define GRID_BAR() do { if (MK_N_LAUNCHES == 1) xcd_barrier(bar, hw_tid(wid0) == 0); } while (0)
    const int lo = args.ph_lo, hi = args.ph_hi;
#define IN(k) (lo <= (k) && (k) < hi)
#define BOTH(k) (IN(k) && IN((k) + 1))

    if (PH_EN(0) && IN(0)) { const int l = 0; PH_BEGIN()
_Pragma("unroll 1")
      for (int rep = 0; rep < REP_P; ++rep) {
        {
            LAS float* SC = (LAS float*)L; LAS float* RED = (LAS float*)(L + 32768);
            for (int i = tid; i < 5 * DM; i += 512) { const int r = i >> 10, k = i & 1023; const float cv = r < 4 ? in[I_C][r * DM + k] : in[I_CCTX][k]; SC[i] = cv / (1.0f + __expf(-cv)); }
            __syncthreads();
            for (int it = vcu; it < 192; it += G) {
                const int l2 = it / 96, cb = it % 96, col = 64 * cb + lane; const float* W = in[I_WMOD] + (size_t)l2 * DM * 6 * DM;
                float a0 = 0.f, a1 = 0.f, a2 = 0.f, a3 = 0.f, a4 = 0.f;
#pragma unroll 8
                for (int kk = 0; kk < 128; ++kk) { const int k = wid * 128 + kk; const float w = W[(size_t)k * (6 * DM) + col];
                    a0 += SC[k] * w; a1 += SC[DM + k] * w; a2 += SC[2 * DM + k] * w; a3 += SC[3 * DM + k] * w; a4 += SC[4 * DM + k] * w; }
                RED[(wid * 5 + 0) * 64 + lane] = a0; RED[(wid * 5 + 1) * 64 + lane] = a1; RED[(wid * 5 + 2) * 64 + lane] = a2; RED[(wid * 5 + 3) * 64 + lane] = a3; RED[(wid * 5 + 4) * 64 + lane] = a4;
                __syncthreads();
                if (tid < 320) { const int r = tid >> 6, cl = tid & 63; float s = 0.f;
#pragma unroll
                    for (int w = 0; w < 8; ++w) s += RED[(w * 5 + r) * 64 + cl];
                    MOD[(size_t)(l2 * 5 + r) * (6 * DM) + 64 * cb + cl] = s + in[I_BMOD][l2 * 6 * DM + 64 * cb + cl]; }
                __syncthreads();
            }
        }
        if (bx == 0) { for (int i = tid; i < 1024; i += 512) { const int p = i >> 3, f = i & 7; const float inv = powf(10000.0f, -((float)f * 2.0f / 16.0f)); const float ang = (float)p * inv; cosT[i] = cosf(ang); sinT[i] = sinf(ang); } }
        {
            __syncthreads();
            LAS float* scr = (LAS float*)(L + wid * TR_SCR);
            const int nl = (G == 256) ? 1 : 2;
            for (int it = gw; it < nl * WI_L; it += NGW) { const int lq = it / WI_L; NONEXPERT_ITEM(lq, it - lq * WI_L); }
            for (int lq = 0; lq < nl; ++lq) NONEXPERT_ZERO(lq, bx * 512 + tid, G * 512);
        }
      }
        if (BOTH(0)) GRID_BAR();
    }
    if (PH_EN(1) && IN(1)) { const int l = 0; PH_BEGIN()
_Pragma("unroll 1")
      for (int rep = 0; rep < REP_P; ++rep)
      {
        f32x4 vn[4];
#pragma unroll
        for (int j = 0; j < 4; ++j) vn[j] = (f32x4){0.f, 0.f, 0.f, 0.f};
#define P1_XR(r_) ((r_) < NLAT ? in[I_X] + (size_t)(r_) * DM : in[I_CTX] + (size_t)((r_) - NLAT) * DM)
        if (gw < MROWS) { const float* xr = P1_XR(gw);
#pragma unroll
            for (int j = 0; j < 4; ++j) vn[j] = *(const f32x4*)(xr + 4 * lane + 256 * j); }
        for (int row = gw; row < MROWS; row += NGW) {
            const int mrow = row < NLAT ? (row >> 13) : 4;
            f32x4 v[4];
#pragma unroll
            for (int j = 0; j < 4; ++j) v[j] = vn[j];
            if (row + NGW < MROWS) { const float* xr = P1_XR(row + NGW);
#pragma unroll
                for (int j = 0; j < 4; ++j) vn[j] = *(const f32x4*)(xr + 4 * lane + 256 * j); }
            const float* md = MOD + (size_t)mrow * (6 * DM);
            rms_mod_store(v, in[I_N1G], md, md + DM, (unsigned char*)XN + (size_t)row * DM, lane);
        }
#undef P1_XR
      }
        {
            bf16_t* WRH = (bf16_t*)(ws + WS_WR); bf16_t* WRL = WRH + 2 * 5 * NE * DM; float* CB = (float*)(ws + WS_CB);
            for (int i = bx * 512 + tid; i < 2 * 5 * NE * DM; i += G * 512) { const int k = i & (DM - 1), e = (i >> 10) & 15, lb = i >> 14, l2 = lb / 5;
                const float w = in[I_N2G][l2 * DM + k] * (1.0f + MOD[(size_t)lb * (6 * DM) + 4 * DM + k]) * in[I_RW][k * NE + e];
                const unsigned short h = f2bf(w); WRH[i] = h; WRL[i] = f2bf(w - bf2f(h)); }
            for (int it = gw; it < 2 * 5 * NE; it += NGW) { const int e = it & 15, lb = it >> 4; float p = 0.f;
#pragma unroll 4
                for (int j = 0; j < 16; ++j) { const int k = lane + 64 * j; p += MOD[(size_t)lb * (6 * DM) + 3 * DM + k] * in[I_RW][k * NE + e]; }
                p = wave_sum(p); if (lane == 0) CB[it] = p; }
            bf16_t* GT = (bf16_t*)(ws + WS_GT);
            for (int i = bx * 512 + tid; i < 2 * 5 * DM; i += G * 512) { const int k = i & (DM - 1), lb = i >> 10, l2 = lb / 5;
                GT[(size_t)lb * 2 * DM + k] = f2bf(in[I_N2G][l2 * DM + k] * (1.0f + MOD[(size_t)lb * (6 * DM) + 4 * DM + k]));
                GT[(size_t)lb * 2 * DM + DM + k] = f2bf(MOD[(size_t)lb * (6 * DM) + 3 * DM + k]); }
        }
        if (BOTH(1)) GRID_BAR();
    }

    for (int l = 0; l < DEPTH; ++l) {
        const int pb = 2 + 11 * l;
        const int Mq = (l == 0) ? MROWS : NLAT;
        if (PH_EN(2) && IN(pb + 0)) { PH_BEGIN()
            pg8::Gemm g{XN, (const bf16_t*)(wl + W_IN), DM / 2, DM / 2}; pg8::StaticOrder S; S.init(MROWS, INW, G, bx);
            pg8::EpiInProj E{PROJ, in[I_BGATE] + l * 3 * DM, (float*)(ws + WS_RKV), Kb, in[I_KNG] + l * QKH + 64, cosT, sinT};
_Pragma("unroll 1")
            for (int rep = 0; rep < REP_A; ++rep) pg8::gemm_phase(L, tid, g, S, E);
#if defined(REP_ANULL)
            { pg8::EpiNull EN; pg8::gemm_phase(L, tid, g, S, EN); }
#endif
            if (BOTH(pb + 0)) GRID_BAR();
        }
        if (PH_EN(3) && IN(pb + 1)) { PH_BEGIN()
_Pragma("unroll 1")
            for (int rep = REP_B - 1; rep >= 0; --rep) {
            {
                typedef float f32x16 __attribute__((ext_vector_type(16)));
                const int nchunks = 256 + (l == 0 ? 8 : 0);
                const int ch_ = tid & 255, half = __builtin_amdgcn_readfirstlane(wid >> 2), g4 = __builtin_amdgcn_readfirstlane(wid & 3);
                constexpr int VTP = 136, DBP = 264;
                LAS unsigned short* VT = (LAS unsigned short*)L;
                LAS float* PART = (LAS float*)(L + MISC_OFF + 1024);
                LAS float* RS = (LAS float*)(L + MISC_OFF + 3072);
                LAS unsigned short* PT = (LAS unsigned short*)L;
                LAS unsigned short* DB = (LAS unsigned short*)(L + 73728);
                const float* sgn = in[I_SGUNG] + l * 256; const float* swp = in[I_SGUWS] + (size_t)l * 4 * 128 * 128 + (size_t)g4 * 128 * 128; const float* sbp = in[I_SGUB] + l * 4 * 128 + g4 * 128;
                const float* pwp = in[I_POOLW] + (size_t)l * 4 * 64 * 64 + (size_t)g4 * 64 * 64;
                const int r32 = lane & 31, hi = lane >> 5;
                for (int ck = vcu; ck < nchunks; ck += G) {
                    int ch = ch_; asm volatile("" : "+v"(ch));
                    int row0, seq0, n, t0;
                    if (ck < 256) { row0 = ck * 128; seq0 = (ck >> 6) * SEQ; n = SEQ; t0 = (ck & 63) * 128; }
                    else { const int cc = ck - 256, b_ = cc >> 1; seq0 = NLAT + b_ * CTXL; n = CTXL; t0 = (cc & 1) * 128; row0 = seq0 + t0; }
                    __syncthreads();
                    {
                        float gv[64];
#pragma unroll
                        for (int jj = 0; jj < 64; ++jj) gv[jj] = gelu_tanh(bf2f(PROJ[(size_t)(row0 + half * 64 + jj) * INW + C_V + ch]));
#pragma unroll
                        for (int jj = 0; jj < 64; ++jj) { const float s = wave_sum(gv[jj] * gv[jj]); if (lane == 0) PART[g4 * 128 + half * 64 + jj] = s; }
                        __syncthreads();
                        if (tid < 128) RS[tid] = rsqrtf(((PART[tid] + PART[128 + tid]) + (PART[256 + tid] + PART[384 + tid])) * (1.0f / 256.0f) + EPS);
                        __syncthreads();
                        const float gn = sgn[ch];
#pragma unroll
                        for (int q = 0; q < 8; ++q) { f32x4 a, b;
#pragma unroll
                            for (int e = 0; e < 4; ++e) { a[e] = gv[8 * q + e] * RS[half * 64 + 8 * q + e] * gn; b[e] = gv[8 * q + 4 + e] * RS[half * 64 + 8 * q + 4 + e] * gn; }
                            *(LAS u32x4*)(VT + ch * VTP + half * 64 + 8 * q) = pg8::pack8(a, b); }
                    }
                    __syncthreads();
                    {
#pragma unroll 1
                        for (int it = 0; it < 2; ++it) { const int i0 = half * 64 + it * 32;
                            bf16x8 af[8];
#pragma unroll
                            for (int s8 = 0; s8 < 8; s8 += 4) {
                                f32x4 wa[4], wb[4];
#pragma unroll
                                for (int q = 0; q < 4; ++q) { const float* ap = swp + (i0 + r32) * 128 + 16 * (s8 + q) + 8 * hi; wa[q] = *(const f32x4*)ap; wb[q] = *(const f32x4*)(ap + 4); }
#pragma unroll
                                for (int q = 0; q < 4; ++q) { asm volatile("" : "+v"(wa[q])); asm volatile("" : "+v"(wb[q])); }
#pragma unroll
                                for (int q = 0; q < 4; ++q) { const u32x4 w = pg8::pack8(wa[q], wb[q]); af[s8 + q] = __builtin_bit_cast(bf16x8, w); } }
#pragma unroll 1
                            for (int ct = 0; ct < 2; ++ct) { const int c0 = ct * 32; f32x16 acc = {};
#pragma unroll
                                for (int s8 = 0; s8 < 8; ++s8) { const bf16x8 bfr = *(const LAS bf16x8*)(VT + (g4 * 64 + c0 + r32) * VTP + 16 * s8 + 8 * hi); acc = __builtin_amdgcn_mfma_f32_32x32x16_bf16(af[s8], bfr, acc, 0, 0, 0); }
                                LAS float* T = (LAS float*)(L + 73728 + wid * 4608);
#pragma unroll
                                for (int rg = 0; rg < 16; ++rg) T[((rg & 3) + 8 * (rg >> 2) + 4 * hi) * 36 + r32] = acc[rg];
#pragma unroll
                                for (int q = 0; q < 2; ++q) { const int chk = q * 64 + lane, rowl = chk >> 2, c8 = (chk & 3) * 8, i = i0 + rowl;
                                    const f32x4 m0 = *(const LAS f32x4*)(T + rowl * 36 + c8), m1 = *(const LAS f32x4*)(T + rowl * 36 + c8 + 4); const float bs = sbp[i];
                                    bf16_t* up = PROJ + (size_t)(row0 + i) * INW + C_U + g4 * 64 + c0 + c8; bf16_t* uw = (REP_B > 1 && rep > 0) ? XN + (size_t)(row0 + i) * DM + 640 + g4 * 64 + c0 + c8 : up;
                                    f32x4 u0, u1; pg8::unpack8(*(const u32x4*)up, u0, u1);
#pragma unroll
                                    for (int e = 0; e < 4; ++e) { u0[e] = gelu_tanh(u0[e]) * (m0[e] + bs); u1[e] = gelu_tanh(u1[e]) * (m1[e] + bs); }
                                    *(u32x4*)uw = pg8::pack8(u0, u1); }
                            }
                        }
                    }
                    __syncthreads();
                    {   u32x4 pv[9];
#pragma unroll
                        for (int q = 0; q < 9; ++q) { const int chk = q * 512 + tid, rr = chk >> 5, c = (chk & 31) * 8, t = t0 - 8 + rr; const int tc = t < 0 ? 0 : (t < n ? t : n - 1);
                            pv[q] = *(const u32x4*)(PROJ + (size_t)(seq0 + tc) * INW + C_P + c); }
#pragma unroll
                        for (int q = 0; q < 9; ++q) asm volatile("" : "+v"(pv[q]));
#pragma unroll
                        for (int q = 0; q < 9; ++q) { const int chk = q * 512 + tid, rr = chk >> 5, c = (chk & 31) * 8, t = t0 - 8 + rr;
                            *(LAS u32x4*)(PT + rr * 256 + c) = (t >= 0 && t < n) ? pv[q] : (u32x4){0u, 0u, 0u, 0u}; } }
                    __syncthreads();
                    {
                        const int w2 = 1 << g4, i0 = half * 64; float s = 0.f;
                        for (int k = -w2; k < w2; ++k) s += bf2f(PT[(i0 + 8 + k) * 256 + ch]);
#pragma unroll 16
                        for (int jj = 0; jj < 64; ++jj) { const int i = i0 + jj, t = t0 + i; const int tlo = (t - w2 > 0) ? t - w2 : 0, thi = (t + w2 < n) ? t + w2 : n;
                            DB[i * DBP + ch] = f2bf(s / (float)(thi - tlo) - bf2f(PT[(i + 8) * 256 + ch]));
                            s += bf2f(PT[(i + 8 + w2) * 256 + ch]) - bf2f(PT[(i + 8 - w2) * 256 + ch]); }
                    }
                    __syncthreads();
                    {
#pragma unroll 1
                        for (int dt = 0; dt < 2; ++dt) { const int d0 = dt * 32; const float psc = in[I_POOLS][l * 256 + g4 * 64 + d0 + r32];
                            bf16x8 bfr[4];
#pragma unroll
                            for (int s4 = 0; s4 < 4; ++s4) { f32x4 a, b;
#pragma unroll
                                for (int e = 0; e < 4; ++e) { a[e] = pwp[(16 * s4 + 8 * hi + e) * 64 + d0 + r32]; b[e] = pwp[(16 * s4 + 8 * hi + 4 + e) * 64 + d0 + r32]; }
                                const u32x4 w = pg8::pack8(a, b); bfr[s4] = __builtin_bit_cast(bf16x8, w); }
#pragma unroll 1
                            for (int it = 0; it < 2; ++it) { const int i0 = half * 64 + it * 32; f32x16 acc = {};
#pragma unroll
                                for (int s4 = 0; s4 < 4; ++s4) { const bf16x8 afr = *(const LAS bf16x8*)(DB + (i0 + r32) * DBP + g4 * 64 + 16 * s4 + 8 * hi); acc = __builtin_amdgcn_mfma_f32_32x32x16_bf16(afr, bfr[s4], acc, 0, 0, 0); }
                                LAS float* T = (LAS float*)(L + wid * 4608);
#pragma unroll
                                for (int rg = 0; rg < 16; ++rg) T[((rg & 3) + 8 * (rg >> 2) + 4 * hi) * 36 + r32] = acc[rg] * psc;
#pragma unroll
                                for (int q = 0; q < 2; ++q) { const int chk = q * 64 + lane, rowl = chk >> 2, c8 = (chk & 3) * 8, i = i0 + rowl;
                                    const f32x4 m0 = *(const LAS f32x4*)(T + rowl * 36 + c8), m1 = *(const LAS f32x4*)(T + rowl * 36 + c8 + 4);
                                    bf16_t* vw = (REP_B > 1 && rep > 0) ? XN + (size_t)(row0 + i) * DM + g4 * 64 + d0 + c8 : PROJ + (size_t)(row0 + i) * INW + C_V + g4 * 64 + d0 + c8;
                                    *(u32x4*)vw = pg8::pack8(m0, m1); }
                            }
                        }
                    }
                }
                __syncthreads();
            }
            }
        }
        if (PH_EN(4) && IN(pb + 2)) { PH_BEGIN()
_Pragma("unroll 1")
            for (int rep = 0; rep < REP_C; ++rep) {
            { pg8::Gemm g{PROJ + C_QA, (const bf16_t*)(wl + W_UQ), INW, 256}; pg8::StaticOrder S; S.init(Mq, 768, G, bx);
              pg8::EpiQ E{Qb, in[I_QNG] + l * QKH, cosT, sinT}; pg8::gemm_phase(L, tid, g, S, E); }
            { pg8::Gemm g{PROJ + C_KVA, (const bf16_t*)(wl + W_UKV), INW, KVLORA / 2}; pg8::StaticOrder S; S.init(MROWS, 1024, G, (bx + 112) % G);
              pg8::EpiKV E{Kb, Vb, in[I_KNG] + l * QKH, (const float*)(ws + WS_RKV)}; pg8::gemm_phase(L, tid, g, S, E); }
            }
            if (BOTH(pb + 2)) GRID_BAR();
        }
        if (PH_EN(5) && IN(pb + 3)) { PH_BEGIN()
_Pragma("unroll 1")
            for (int rep = 0; rep < REP_D; ++rep)
            for (int U = vcu; U < NB * NH * (SEQ / 256); U += G) {
                const int bh = U >> 5, qb = U & 31, b = bh >> 3, h = bh & 7; const size_t row0 = (size_t)b * SEQ + qb * 256;
                ATTN_BODY(tid, (const unsigned char*)Qb + row0 * 768 + h * QKH, 768, (const unsigned char*)Kb + (size_t)bh * NKEY * QKH, Vb + (size_t)bh * NKEY * VH, PROJ + row0 * INW + C_ATT + h * VH, INW, NKEY / 64, (char*)lds);
            }
            if (l == 0) for (int U = vcu; U < NB * NH; U += G) {
                const int bh = U, b = bh >> 3, h = bh & 7; const size_t row0 = (size_t)NLAT + b * CTXL;
                ATTN_BODY(tid, (const unsigned char*)Qb + row0 * 768 + h * QKH, 768, (const unsigned char*)Kb + ((size_t)bh * NKEY + SEQ) * QKH, Vb + ((size_t)bh * NKEY + SEQ) * VH, PROJ + row0 * INW + C_ATT + h * VH, INW, CTXL / 64, (char*)lds);
            }
            if (BOTH(pb + 3)) GRID_BAR();
        }
        if (PH_EN(6) && IN(pb + 4)) { PH_BEGIN()
            pg8::MergeOrder S; S.base.init(Mq, 2 * DM, G, bx);
_Pragma("unroll 1")
            for (int rep = 0; rep < REP_E; ++rep) {
            { pg8::Gemm g{PROJ + C_U, (const bf16_t*)(wl + W_BP), INW, 256}; pg8::EpiMergeF E{PROJ, MG}; pg8::gemm_phase(L, tid, g, S, E); }
            }
            if (l == 0 && G == 256 && bx >= 32) {
                LAS float* scr = (LAS float*)(L + wid * TR_SCR);
                const int nit = WI_L + (EARLY1 ? WI_X : 0);
                for (int it = (bx - 32) * NWAVES + wid; it < nit; it += 224 * NWAVES) {
                    if (it < WI_L) NONEXPERT_ITEM(1, it); else EXPERT_ITEM(1, ws + WS_TAIL_GU, ws + WS_TAIL_DN, it - WI_L);
                }
                NONEXPERT_ZERO(1, (bx - 32) * 512 + tid, 224 * 512);
            }
            if (BOTH(pb + 4)) GRID_BAR();
        }
        if (PH_EN(7) && IN(pb + 5)) { PH_BEGIN()
            { u32x4* tz = (u32x4*)(ws + WS_TOK2);
              for (int i = bx * 512 + tid; i < NE * TOKCAP / 4; i += G * 512) tz[i] = (u32x4){0u, 0u, 0u, 0u}; }
            pg8::Gemm g{MG, (const bf16_t*)(wl + W_OUT), DM, DM}; pg8::StaticOrder S; S.init(Mq, DM, G, bx);
            pg8::EpiOut E{l == 0 ? in[I_X] : OUT, l == 0 ? in[I_CTX] : XC, X1B, MODL + 2 * DM, l == 0 ? (const bf16_t*)nullptr : (const bf16_t*)OUT};
_Pragma("unroll 1")
            for (int rep = 0; rep < (l == 0 ? REP_F : 1); ++rep) pg8::gemm_phase(L, tid, g, S, E);
            if (l == 0 && G == 256 && bx >= 16) {
                LAS float* scr = (LAS float*)(L + wid * TR_SCR);
                for (int it = (bx - 16) * NWAVES + wid; it < WI_X; it += 240 * NWAVES) EXPERT_ITEM(l, WGU, WDN, it);
            }
            if (BOTH(pb + 5)) GRID_BAR();
        }
        if (PH_EN(8) && IN(pb + 6)) { PH_BEGIN()
_Pragma("unroll 1")
            for (int rep = REP_G - 1; rep >= 0; --rep) {
            {
                volatile LAS unsigned* HC = MISC + 64;
                volatile LAS unsigned* HB = MISC + 96; volatile LAS unsigned* LR = MISC + 512;
                __syncthreads();
                {
                    LAS float* scr = (LAS float*)(L + wid * TR_SCR);
                    for (int it = ((l == 0 && G == 256) || (l == 1 && EARLY1)) ? WI_X : gw; it < WI_X; it += NGW) EXPERT_ITEM(l, WGU, WDN, it);
                }
                __syncthreads();
                if (tid < 16) HC[tid] = 0u;
                __syncthreads();
                {
                    typedef float f32x4_ __attribute__((ext_vector_type(4)));
                    const bf16_t* WRH = (const bf16_t*)(ws + WS_WR); const float* CB = (const float*)(ws + WS_CB) + l * 5 * NE;
                    const float* rb = in[I_RB];
                    const int r16 = lane & 15, q4 = lane >> 4, c0w = 128 * wid + 8 * q4;
                    LAS f32x4_* accP = (LAS f32x4_*)L; LAS float* ssP = (LAS float*)(L + 16384);
                    const int NGRP = Mq / 16; int par = 0;
                    u32x4 xh[4];
#define G_XROW(grp_) (X1B + (size_t)((grp_) * 16 + r16) * DM + c0w)
                    LAS unsigned char* xsl = L + 20480 + wid * 8192;
                    if (vcu < NGRP) { const bf16_t* xr = G_XROW(vcu);
#pragma unroll
                        for (int s = 0; s < 4; ++s) __builtin_amdgcn_global_load_lds((const unsigned*)(xr + 32 * s), (LAS unsigned*)(xsl + s * 1024), 16, 0, 0); }
                    bf16x8 wh[4], wl[4];
#define G_WLOAD(grp_) do { const int R_ = (grp_) * 16; const int mr_ = R_ < NLAT ? (R_ >> 13) : 4; const bf16_t* bh_ = WRH + ((size_t)((l * 5 + mr_) * NE + r16)) * DM + c0w; const bf16_t* bl_ = bh_ + 2 * 5 * NE * DM; \
        _Pragma("unroll") for (int s = 0; s < 4; ++s) { wh[s] = *(const bf16x8*)(bh_ + 32 * s); wl[s] = *(const bf16x8*)(bl_ + 32 * s); } } while (0)
#pragma unroll
                    for (int s = 0; s < 4; ++s) { wh[s] = (bf16x8){0, 0, 0, 0, 0, 0, 0, 0}; wl[s] = (bf16x8){0, 0, 0, 0, 0, 0, 0, 0}; }
                    if (vcu < NGRP) G_WLOAD(vcu);
                    for (int grp = vcu; grp < NGRP; grp += G) {
                        const int R0 = grp * 16; const bool lat = R0 < NLAT; const int mrow = lat ? (R0 >> 13) : 4;
                        int c0v = c0w; asm volatile("" : "+v"(c0v));
                        asm volatile("s_waitcnt vmcnt(0)" ::: "memory");
#pragma unroll
                        for (int s = 0; s < 4; ++s) xh[s] = *(const LAS u32x4*)(xsl + s * 1024 + lane * 16);
                        asm volatile("s_waitcnt lgkmcnt(0)" ::: "memory");
                        if (grp + G < NGRP) { const bf16_t* xr = G_XROW(grp + G);
#pragma unroll
                            for (int s = 0; s < 4; ++s) __builtin_amdgcn_global_load_lds((const unsigned*)(xr + 32 * s), (LAS unsigned*)(xsl + s * 1024), 16, 0, 0); }
                        u32x4 tg[4], th[4];
                        {   const bf16_t* gt = (const bf16_t*)(ws + WS_GT) + (size_t)((l * 5 + mrow) * 2) * DM + c0v;
#pragma unroll
                            for (int s = 0; s < 4; ++s) { tg[s] = *(const u32x4*)(gt + 32 * s); th[s] = *(const u32x4*)(gt + DM + 32 * s); } }
                        f32x4_ acc = {0.f, 0.f, 0.f, 0.f}; float ss = 0.f;
#pragma unroll
                        for (int s = 0; s < 4; ++s) { f32x4 a, b; pg8::unpack8(xh[s], a, b); ss += pg8::dot4(a) + pg8::dot4(b);
                            const bf16x8 fh = __builtin_bit_cast(bf16x8, xh[s]);
                            acc = __builtin_amdgcn_mfma_f32_16x16x32_bf16(fh, wh[s], acc, 0, 0, 0); acc = __builtin_amdgcn_mfma_f32_16x16x32_bf16(fh, wl[s], acc, 0, 0, 0); }
                        if (grp + G < NGRP) G_WLOAD(grp + G);
                        ss += __shfl_xor(ss, 16); ss += __shfl_xor(ss, 32);
                        accP[(par * 8 + wid) * 64 + lane] = acc; if (q4 == 0) ssP[(par * 8 + wid) * 16 + r16] = ss;
                        __syncthreads();
                        f32x4_ at = {0.f, 0.f, 0.f, 0.f}; float st = 0.f;
#pragma unroll
                        for (int w = 0; w < 8; ++w) { at += accP[(par * 8 + w) * 64 + lane]; st += ssP[(par * 8 + w) * 16 + r16]; }
                        const float rs = rsqrtf(st * (1.0f / DM) + EPS);
                        {   bf16_t* orow = XN + (size_t)(R0 + r16) * DM + c0v;
#pragma unroll
                            for (int s = 0; s < 4; ++s) { asm volatile("" : "+v"(tg[s]), "+v"(th[s]));
                                f32x4 a, b, g0, g1, h0, h1; pg8::unpack8(xh[s], a, b); pg8::unpack8(tg[s], g0, g1); pg8::unpack8(th[s], h0, h1);
                                if (MOE1_FP8) *(u32x2*)((unsigned char*)XN + (size_t)(R0 + r16) * DM + c0v + 32 * s) = pg8::pack8_f8(a * rs * g0 + h0, b * rs * g1 + h1, 1.0f);
                                else *(u32x4*)(orow + 32 * s) = pg8::pack8(a * rs * g0 + h0, b * rs * g1 + h1); } }
                        par ^= 1;
                        if (REP_G > 1 && rep > 0) continue;
                        if (wid < 4) {
                            const int rg = wid;
                            const float cbe = CB[mrow * NE + r16], rbe = rb[r16];
                            const float arg = rg == 0 ? at[0] : rg == 1 ? at[1] : rg == 2 ? at[2] : at[3];
                            const float rsr = __shfl(rs, 4 * q4 + rg);
                            const float lg = arg * rsr + cbe; const float sc = 1.0f / (1.0f + expf(-lg)); const float sl = sc + rbe;
                            const int qb = lane & ~3, rw16 = lane & ~15;
                            const float a = __shfl(sl, qb), b = __shfl(sl, qb + 1), c = __shfl(sl, qb + 2), d = __shfl(sl, qb + 3);
                            const float h1 = fmaxf(a, b), l1 = fminf(a, b), h2 = fmaxf(c, d), l2 = fminf(c, d); const float gsc = fmaxf(h1, h2) + fmaxf(fminf(h1, h2), fmaxf(l1, l2));
                            const float g0 = __shfl(gsc, rw16), g1 = __shfl(gsc, rw16 + 4), g2 = __shfl(gsc, rw16 + 8), g3 = __shfl(gsc, rw16 + 12);
                            int best = 0; float bv = g0; if (g1 > bv) { bv = g1; best = 1; } if (g2 > bv) { bv = g2; best = 2; } if (g3 > bv) { bv = g3; best = 3; }
                            const int bl4 = rw16 + 4 * best;
                            float s4[4], c4[4];
#pragma unroll
                            for (int i = 0; i < 4; ++i) { s4[i] = __shfl(sl, bl4 + i); c4[i] = __shfl(sc, bl4 + i); }
                            int i1 = 0; float m1 = s4[0];
#pragma unroll
                            for (int i = 1; i < 4; ++i) if (s4[i] > m1) { m1 = s4[i]; i1 = i; }
                            int i2 = -1; float m2 = -3.0e38f;
#pragma unroll
                            for (int i = 0; i < 4; ++i) if (i != i1 && s4[i] > m2) { m2 = s4[i]; i2 = i; }
                            const float w1 = i1 == 0 ? c4[0] : i1 == 1 ? c4[1] : i1 == 2 ? c4[2] : c4[3], w2 = i2 == 0 ? c4[0] : i2 == 1 ? c4[1] : i2 == 2 ? c4[2] : c4[3];
                            const float ws_ = w1 + w2; const int e0 = best * 4 + i1, e1 = best * 4 + i2;
                            if (r16 == 0) { RT[R0 + 4 * q4 + rg] = (u32x4){(unsigned)e0, (unsigned)e1, __float_as_uint(w1 / ws_), __float_as_uint(w2 / ws_)};
                                const unsigned k0 = __hip_atomic_fetch_add((LAS unsigned*)&HC[e0], 1u, __ATOMIC_RELAXED, __HIP_MEMORY_SCOPE_WORKGROUP), k1 = __hip_atomic_fetch_add((LAS unsigned*)&HC[e1], 1u, __ATOMIC_RELAXED, __HIP_MEMORY_SCOPE_WORKGROUP);
                                LR[((grp - vcu) / G) * 16 + 4 * q4 + rg] = (unsigned)e0 | ((unsigned)e1 << 4) | (k0 << 8) | (k1 << 20); }
                        }
                    }
#undef G_XROW
#undef G_WLOAD
                }
                __syncthreads();
                if (tid < 16) HB[tid] = atomicAdd(ctl + CW_CNT + 64 * l + tid, HC[tid]);
                __syncthreads();
                {   const int np = (Mq / 16 - vcu + G - 1) / G; int* TOK = (int*)(ws + WS_TOK2);
                    if (tid < np * 16) { const unsigned lr = LR[tid]; const int e0 = (int)(lr & 15u), e1 = (int)((lr >> 4) & 15u), i0 = (int)(HB[e0] + ((lr >> 8) & 0xfffu)), i1 = (int)(HB[e1] + (lr >> 20));
                        const int row = (vcu + (tid >> 4) * G) * 16 + (tid & 15);
                        POS[row] = (i32x2){(e0 << 16) | i0, (e1 << 16) | i1}; TOK[e0 * TOKCAP + i0] = row; TOK[e1 * TOKCAP + i1] = row; } }
                __syncthreads();
            }
            }
            if (BOTH(pb + 6)) GRID_BAR();
        }
        if ((PH_EN(10) || PH_EN(11)) && (IN(pb + 8) || IN(pb + 9))) { PH_BEGIN()
            int tbv[16], nun; { int t = 0;
#pragma unroll
                for (int j = 0; j < 16; ++j) { tbv[j] = t; const int c = __builtin_amdgcn_readfirstlane((int)__hip_atomic_load(ctl + CW_CNT + 64 * l + j, __ATOMIC_RELAXED, __HIP_MEMORY_SCOPE_AGENT)); t += (c + 255) >> 8; }
                nun = 4 * t; }
            if (PH_EN(10) && IN(pb + 8)) {
                pg8::MoeOrder<true> S; S.tok = (const int*)(ws + WS_TOK2); S.G = G; S.c = vcu; S.nunits = nun;
#pragma unroll
                for (int j = 0; j < 16; ++j) S.tb[j] = tbv[j];
                pg8::Gemm g{XN, WGU, MOE1_FP8 ? DM / 2 : DM, MOE1_FP8 ? DM / 2 : DM}; pg8::EpiMoe1 E{ACT};
_Pragma("unroll 1")
                for (int rep = 0; rep < REP_M; ++rep) pg8::gemm_phase(L, tid, g, S, E);
                if (BOTH(pb + 8)) GRID_BAR();
            }
            if (PH_EN(11) && IN(pb + 9)) {
                pg8::MoeOrder<false> S; S.tok = nullptr; S.G = G; S.c = vcu; S.nunits = nun;
#pragma unroll
                for (int j = 0; j < 16; ++j) S.tb[j] = tbv[j];
                pg8::Gemm g{ACT, WDN, MOE2_FP8 ? DE / 2 : DE, MOE2_FP8 ? DE / 2 : DE}; pg8::EpiMoe2 E{XS};
_Pragma("unroll 1")
                for (int rep = 0; rep < REP_M; ++rep) pg8::gemm_phase(L, tid, g, S, E);
                if (BOTH(pb + 9)) GRID_BAR();
            }
        }
        if (PH_EN(12) && IN(pb + 10)) { PH_BEGIN()
_Pragma("unroll 1")
            for (int rep = REP_K - 1; rep >= 0; --rep) {
            {
                const bool last = (l == DEPTH - 1);
                volatile LAS unsigned* EBK = MISC + 128;
                if (tid < 16) { unsigned base = 0u;
                    for (int j = 0; j < 16; ++j) { const unsigned c = __hip_atomic_load(ctl + CW_CNT + 64 * l + j, __ATOMIC_RELAXED, __HIP_MEMORY_SCOPE_AGENT); if (j < tid) base += (c + 255u) & ~255u; }
                    EBK[tid] = base; }
                __syncthreads();
#define K_XR(r_) ((r_) < NLAT ? OUT + (size_t)(r_) * DM : XC + (size_t)((r_) - NLAT) * DM)
#if XS_FP8
#define K_LOAD(A_, B_, X_, ps_, r_) do { const unsigned char* y0_ = (const unsigned char*)XS + (size_t)(EBK[(unsigned)(ps_).x >> 16] + ((unsigned)(ps_).x & 0xffffu)) * DM; const unsigned char* y1_ = (const unsigned char*)XS + (size_t)(EBK[(unsigned)(ps_).y >> 16] + ((unsigned)(ps_).y & 0xffffu)) * DM; const bf16_t* xr_ = X1B + (size_t)(r_) * DM; \
        _Pragma("unroll") for (int j = 0; j < 4; ++j) { const int col = 4 * lane + 256 * j; A_[j].x = *(const unsigned*)(y0_ + col); B_[j].x = *(const unsigned*)(y1_ + col); X_[j] = *(const u32x2*)(xr_ + col); } } while (0)
#else
#define K_LOAD(A_, B_, X_, ps_, r_) do { const bf16_t* y0_ = XS + (size_t)(EBK[(unsigned)(ps_).x >> 16] + ((unsigned)(ps_).x & 0xffffu)) * DM; const bf16_t* y1_ = XS + (size_t)(EBK[(unsigned)(ps_).y >> 16] + ((unsigned)(ps_).y & 0xffffu)) * DM; const bf16_t* xr_ = X1B + (size_t)(r_) * DM; \
        _Pragma("unroll") for (int j = 0; j < 4; ++j) { const int col = 4 * lane + 256 * j; A_[j] = *(const u32x2*)(y0_ + col); B_[j] = *(const u32x2*)(y1_ + col); X_[j] = *(const u32x2*)(xr_ + col); } } while (0)
#endif
                u32x4 rt0 = {0u, 0u, 0u, 0u}, rt1 = {0u, 0u, 0u, 0u}; i32x2 ps0 = {0, 0}, ps1 = {0, 0};
                u32x2 ad[4], bd[4], xd[4];
#pragma unroll
                for (int j = 0; j < 4; ++j) { ad[j] = (u32x2){0u, 0u}; bd[j] = (u32x2){0u, 0u}; xd[j] = (u32x2){0u, 0u}; }
                if (gw < Mq) { rt0 = RT[gw]; ps0 = POS[gw]; }
                if (gw + NGW < Mq) { rt1 = RT[gw + NGW]; ps1 = POS[gw + NGW]; }
                if (gw < Mq) K_LOAD(ad, bd, xd, ps0, gw);
                for (int row = gw; row < Mq; row += NGW) {
                    float* xr = K_XR(row); const int mrow = row < NLAT ? (row >> 13) : 4;
                    const float* md = MODL + (size_t)mrow * (6 * DM);
                    const float w0 = __uint_as_float(rt0.z) * (XS_FP8 ? 0.0625f : 1.0f), w1 = __uint_as_float(rt0.w) * (XS_FP8 ? 0.0625f : 1.0f);
                    u32x4 rt2 = {0u, 0u, 0u, 0u}; i32x2 ps2 = {0, 0};
                    if (row + 2 * NGW < Mq) { rt2 = RT[row + 2 * NGW]; ps2 = POS[row + 2 * NGW]; }
                    u32x2 an[4], bn[4], xn[4];
#pragma unroll
                    for (int j = 0; j < 4; ++j) { an[j] = ad[j]; bn[j] = bd[j]; xn[j] = xd[j]; }
                    if (row + NGW < Mq) K_LOAD(an, bn, xn, ps1, row + NGW);
                    f32x4 v[4];
#pragma unroll
                    for (int j = 0; j < 4; ++j) { const int col = 4 * lane + 256 * j;
                        const u32x2 a = ad[j], b = bd[j];
                        f32x4 ya, yb;
#if XS_FP8
                        {   typedef float f32x2_ __attribute__((ext_vector_type(2)));
                            const f32x2_ a01 = __builtin_amdgcn_cvt_pk_f32_fp8((int)a.x, false), a23 = __builtin_amdgcn_cvt_pk_f32_fp8((int)a.x, true), b01 = __builtin_amdgcn_cvt_pk_f32_fp8((int)b.x, false), b23 = __builtin_amdgcn_cvt_pk_f32_fp8((int)b.x, true);
                            ya[0] = a01[0]; ya[1] = a01[1]; ya[2] = a23[0]; ya[3] = a23[1]; yb[0] = b01[0]; yb[1] = b01[1]; yb[2] = b23[0]; yb[3] = b23[1]; }
#else
                        f32x4 ya, yb; ya[0] = __uint_as_float(a.x << 16); ya[1] = __uint_as_float(a.x & 0xffff0000u); ya[2] = __uint_as_float(a.y << 16); ya[3] = __uint_as_float(a.y & 0xffff0000u);
                        yb[0] = __uint_as_float(b.x << 16); yb[1] = __uint_as_float(b.x & 0xffff0000u); yb[2] = __uint_as_float(b.y << 16); yb[3] = __uint_as_float(b.y & 0xffff0000u);
#endif
                        const f32x4 g2 = *(const f32x4*)(md + 5 * DM + col);
                        f32x4 x1; x1[0] = __uint_as_float(xd[j].x << 16); x1[1] = __uint_as_float(xd[j].x & 0xffff0000u); x1[2] = __uint_as_float(xd[j].y << 16); x1[3] = __uint_as_float(xd[j].y & 0xffff0000u);
                        v[j] = x1 + g2 * (ya * w0 + yb * w1);
                        if (!last && row < NLAT) *(u32x2*)((bf16_t*)OUT + (size_t)row * DM + col) = (u32x2){pg8::cvt_pk_bf16(v[j][0], v[j][1]), pg8::cvt_pk_bf16(v[j][2], v[j][3])};
                        else *(f32x4*)(xr + col) = v[j]; }
                    if (!last) { const float* md1 = MOD + (size_t)((l + 1) * 5 + mrow) * (6 * DM); rms_mod_store(v, in[I_N1G] + (l + 1) * DM, md1, md1 + DM, (unsigned char*)XN + (size_t)row * DM, lane); }
                    rt0 = rt1; ps0 = ps1; rt1 = rt2; ps1 = ps2;
#pragma unroll
                    for (int j = 0; j < 4; ++j) { ad[j] = an[j]; bd[j] = bn[j]; xd[j] = xn[j]; }
                }
#undef K_LOAD
#undef K_XR
            }
            }
            if (BOTH(pb + 10)) GRID_BAR();
        }
    }
#undef IN
#undef BOTH
#undef GRID_BAR
}

extern "C" void kernel_launch(void* const* d_in, const int* in_sizes, int n_in, void* d_out, int out_size, void* d_ws, size_t ws_size, hipStream_t stream) {
    static int grid = 0;
    if (grid == 0) {
        if (n_in != 30 || out_size != NLAT * DM || ws_size < WS_END) { fprintf(stderr, "kernel_launch: unexpected shapes: n_in %d out %d ws %zu (need %zu)\n", n_in, out_size, ws_size, (size_t)WS_END); grid = -1; return; }
        int dev = 0, cus = 0;
        if (hipGetDevice(&dev) != hipSuccess || hipDeviceGetAttribute(&cus, hipDeviceAttributeMultiprocessorCount, dev) != hipSuccess) { grid = -1; return; }
        if (hipFuncSetAttribute((const void*)mk_fwd, hipFuncAttributeMaxDynamicSharedMemorySize, LDS_BYTES) != hipSuccess) { fprintf(stderr, "kernel_launch: hipFuncSetAttribute failed\n"); grid = -1; return; }
        int per_cu = 0;
        if (hipOccupancyMaxActiveBlocksPerMultiprocessor(&per_cu, (const void*)mk_fwd, NWAVES * 64, LDS_BYTES) != hipSuccess || per_cu < 1) fprintf(stderr, "kernel_launch: occupancy query says %d per CU\n", per_cu);
        (void)hipGetLastError();
        grid = 256;
        if (cus != 256) fprintf(stderr, "kernel_launch: device has %d CUs, kernel is built for 256\n", cus);
    }
    if (grid < 0) return;
    (void)hipMemsetAsync((char*)d_ws + WS_CTL, 0, CTL_ZERO_BYTES, stream);
    Args a{};
    for (int i = 0; i < 30; ++i) a.in[i] = (const float*)d_in[i];
    a.out = (float*)d_out; a.ws = (unsigned char*)d_ws; a.tail_ok = ws_size >= WS_TAIL_END ? 1 : 0;
    if (MK_N_LAUNCHES == 1) { a.ph_lo = 0; a.ph_hi = N_PHASES; hipLaunchKernelGGL(mk_fwd, dim3(grid), dim3(NWAVES * 64), LDS_BYTES, stream, a); }
    else for (int p = 0; p < N_PHASES; ++p) { a.ph_lo = p; a.ph_hi = p + 1; hipLaunchKernelGGL(mk_fwd, dim3(grid), dim3(NWAVES * 64), LDS_BYTES, stream, a); }
    const hipError_t le = hipPeekAtLastError();
    if (le != hipSuccess) fprintf(stderr, "kernel_launch: launch failed: %s\n", hipGetErrorName(le));
}
```
